# Optimizing an MI355X kernel written in HIP

```python
import jax, jax.numpy as jnp
from jax import lax
import numpy as np


D_MODEL = 2048
BATCH = 1
SEQ = 8192
DEPTH = 2

EPS = 1e-6
NEG = -1e30
QB = 128

MLA_HEADS = 8
MLA_Q_RANK = 384
MLA_KV_RANK = 128
MLA_NOPE = 64
MLA_ROPE = 32
MLA_V = 64
MLA_QK = MLA_NOPE + MLA_ROPE
ROPE_THETA = 10000.0

DIL_HEADS = 12
DIL_HD = 64
DIL_W = DIL_HEADS * DIL_HD
DIL_PATTERNS = ((128, 1), (512, 4), (2048, 16))
N_BUCKETS = 32
BUCKET_MAX_DIST = 1024

ML_HEADS = 4
ML_HD = 192
ML_W = ML_HEADS * ML_HD
ML_CONV = 5
ML_CHUNK = 128
ML_F_BIAS_LO = 3.0
ML_F_BIAS_HI = 6.0

N_GROUPS = 4
EXPERTS_PER_GROUP = 4
N_EXPERTS = N_GROUPS * EXPERTS_PER_GROUP
MOE_TOPK = 2
D_EXPERT = 512

IN_SIZES = (MLA_Q_RANK, MLA_KV_RANK, MLA_ROPE, DIL_W, DIL_W, DIL_W, ML_W, ML_W, ML_W, 4 * ML_HEADS)
C_IN = sum(IN_SIZES)
D_MIX = MLA_HEADS * MLA_V + DIL_W + ML_W

kernel_name = 'hybrid_mla_dilated_mlstm_hmoe_encoder'


def rms_norm(x, g):
    xf = x.astype(jnp.float32)
    y = xf * lax.rsqrt(jnp.mean(xf * xf, axis=-1, keepdims=True) + EPS)
    return (y * g.astype(jnp.float32)).astype(x.dtype)


def rope_cos_sin(positions):
    half = MLA_ROPE // 2
    inv_freq = ROPE_THETA ** (-jnp.arange(half, dtype=jnp.float32) / half)
    ang = positions.astype(jnp.float32)[..., None] * inv_freq
    return jnp.cos(ang), jnp.sin(ang)


def apply_rope(x, cos, sin):
    xf = x.astype(jnp.float32)
    x1, x2 = jnp.split(xf, 2, axis=-1)
    return jnp.concatenate([x1 * cos - x2 * sin, x1 * sin + x2 * cos], axis=-1).astype(x.dtype)


def blocks_to_seq(out):
    nb, B, H, L, d = out.shape
    return out.transpose(1, 0, 3, 2, 4).reshape(B, nb * L, H * d)


def dense_block_attention(q, k, v):
    S = q.shape[2]
    scale = q.shape[-1] ** -0.5

    def one_block(start):
        qb = lax.dynamic_slice_in_dim(q, start, QB, axis=2)
        s = jnp.einsum('bhqd,bhkd->bhqk', qb, k, preferred_element_type=jnp.float32) * scale
        p = jax.nn.softmax(s, axis=-1)
        return jnp.einsum('bhqk,bhkd->bhqd', p.astype(v.dtype), v)

    return blocks_to_seq(lax.map(one_block, jnp.arange(S // QB, dtype=jnp.int32) * QB))


def mla_mixer(c_q, c_kv, k_rope, cos, sin, g_cq, w_uq, g_ckv, w_ukv, g_q, g_k):
    B, S, _ = c_q.shape
    q = (rms_norm(c_q, g_cq) @ w_uq).reshape(B, S, MLA_HEADS, MLA_QK)
    kv = (rms_norm(c_kv, g_ckv) @ w_ukv).reshape(B, S, MLA_HEADS, MLA_NOPE + MLA_V)
    q_rot = apply_rope(q[..., MLA_NOPE:], cos[:, :, None], sin[:, :, None])
    k_rot = apply_rope(k_rope, cos, sin)
    q = jnp.concatenate([q[..., :MLA_NOPE], q_rot], axis=-1)
    k = jnp.concatenate([kv[..., :MLA_NOPE],
                         jnp.broadcast_to(k_rot[:, :, None, :], (B, S, MLA_HEADS, MLA_ROPE))], axis=-1)
    v = kv[..., MLA_NOPE:]
    q = rms_norm(q, g_q).transpose(0, 2, 1, 3)
    k = rms_norm(k, g_k).transpose(0, 2, 1, 3)
    return dense_block_attention(q, k, v.transpose(0, 2, 1, 3))


def dilation_offsets():
    offs = []
    for w, d in DIL_PATTERNS:
        r = w // (2 * d)
        offs.append(np.arange(-r, r + 1) * d)
    return np.stack(offs)


def t5_buckets(rel):
    half = N_BUCKETS // 2
    max_exact = half // 2
    n = np.abs(rel)
    large = max_exact + (np.log(np.maximum(n, 1) / max_exact) / np.log(BUCKET_MAX_DIST / max_exact)
                         * (half - max_exact)).astype(np.int32)
    large = np.minimum(large, half - 1)
    return (rel > 0).astype(np.int32) * half + np.where(n < max_exact, n, large).astype(np.int32)


def dilated_mixer(q, k, v, rel_bias, g_q, g_k):
    B, S, _ = q.shape
    q = rms_norm(q.reshape(B, S, DIL_HEADS, DIL_HD), g_q).transpose(0, 2, 1, 3)
    k = rms_norm(k.reshape(B, S, DIL_HEADS, DIL_HD), g_k).transpose(0, 2, 1, 3)
    v = v.reshape(B, S, DIL_HEADS, DIL_HD).transpose(0, 2, 1, 3)
    offs = dilation_offsets()
    P, K = offs.shape
    flat = jnp.asarray(offs.reshape(-1), jnp.int32)
    bias = rel_bias.astype(jnp.float32)[jnp.asarray(t5_buckets(offs.reshape(-1)))].T
    scale = DIL_HD ** -0.5

    def one_block(start):
        qb = lax.dynamic_slice_in_dim(q, start, QB, axis=2)
        idx = start + jnp.arange(QB, dtype=jnp.int32)[:, None] + flat[None, :]
        valid = (idx >= 0) & (idx < S)
        idx = jnp.clip(idx, 0, S - 1)
        kg = k[:, :, idx]
        vg = v[:, :, idx].reshape(B, DIL_HEADS, QB, P, K, DIL_HD).astype(jnp.float32)
        s = jnp.einsum('bhqd,bhqkd->bhqk', qb, kg, preferred_element_type=jnp.float32) * scale
        s = jnp.where(valid[None, None], s + bias[None, :, None, :], NEG).reshape(B, DIL_HEADS, QB, P, K)
        m = jnp.max(s, axis=-1)
        p = jnp.exp(s - m[..., None])
        den = jnp.sum(p, axis=-1)
        o = jnp.einsum('bhqpk,bhqpkd->bhqpd', p, vg) / den[..., None]
        alpha = jax.nn.softmax(jnp.log(den) + m, axis=-1)
        return jnp.einsum('bhqp,bhqpd->bhqd', alpha, o).astype(v.dtype)

    return blocks_to_seq(lax.map(one_block, jnp.arange(S // QB, dtype=jnp.int32) * QB))


def mlstm_scan(q, k, v, log_i, log_f):
    B, H, S, d = q.shape
    L = ML_CHUNK
    nc = S // L

    def to_chunks(a):
        return jnp.moveaxis(a.reshape(B, H, nc, L, *a.shape[3:]), 2, 0)

    xs = (to_chunks(q), to_chunks(k), to_chunks(v), to_chunks(log_i), to_chunks(log_f))
    tril = jnp.tril(jnp.ones((L, L), dtype=bool))

    def step(carry, inp):
        C, n, m_prev = carry
        qc, kc, vc, li, lf = inp
        b = jnp.cumsum(lf, axis=-1)
        logw = jnp.where(tril, b[..., :, None] - b[..., None, :] + li[..., None, :], NEG)
        inter = b + m_prev[..., None]
        m = jnp.maximum(jnp.max(logw, axis=-1), inter)
        a = jnp.exp(logw - m[..., None]) * jnp.einsum('bhtd,bhsd->bhts', qc, kc)
        decay = jnp.exp(inter - m)
        num = jnp.einsum('bhts,bhsv->bhtv', a, vc) + decay[..., None] * jnp.einsum('bhtd,bhdv->bhtv', qc, C)
        den = jnp.sum(a, axis=-1) + decay * jnp.einsum('bhtd,bhd->bht', qc, n)
        h = num / jnp.maximum(jnp.abs(den), jnp.exp(-m))[..., None]
        m_new = m[..., -1]
        g = jnp.exp(b[..., -1:] - b + li - m_new[..., None])
        cd = jnp.exp(b[..., -1] + m_prev - m_new)
        C = cd[..., None, None] * C + jnp.einsum('bhs,bhsd,bhsv->bhdv', g, kc, vc)
        n = cd[..., None] * n + jnp.einsum('bhs,bhsd->bhd', g, kc)
        return (C, n, m_new), h

    init = (jnp.zeros((B, H, d, d), jnp.float32), jnp.zeros((B, H, d), jnp.float32),
            jnp.zeros((B, H), jnp.float32))
    _, hs = lax.scan(step, init, xs)
    return jnp.moveaxis(hs, 0, 2).reshape(B, H, S, d)


def mlstm_mixer(u, v, o_pre, gate_pre, conv_w, conv_b, w_q, w_k, gate_bias, g_out):
    B, S, _ = u.shape
    f32 = jnp.float32
    uc = lax.conv_general_dilated(u, conv_w[:, None, :].astype(u.dtype), window_strides=(1,),
                                  padding=((ML_CONV // 2, ML_CONV // 2),),
                                  dimension_numbers=('NWC', 'WIO', 'NWC'), feature_group_count=ML_W)
    uc = jax.nn.silu(uc + conv_b).reshape(B, S, ML_HEADS, ML_HD)
    q = jnp.einsum('bshd,hde->bhse', uc, w_q).astype(f32)
    k = jnp.einsum('bshd,hde->bhse', uc, w_k).astype(f32) * (ML_HD ** -0.5)
    vv = v.reshape(B, S, ML_HEADS, ML_HD).transpose(0, 2, 1, 3).astype(f32)
    pre = gate_pre.astype(f32).reshape(B, S, 2, 2, ML_HEADS) + gate_bias.astype(f32)
    log_i = jnp.transpose(pre[:, :, :, 0], (2, 0, 3, 1))
    log_f = jnp.transpose(jax.nn.log_sigmoid(pre[:, :, :, 1]), (2, 0, 3, 1))
    h_fwd = mlstm_scan(q, k, vv, log_i[0], log_f[0])
    rev = lambda a: jnp.flip(a, axis=2)
    h_bwd = rev(mlstm_scan(rev(q), rev(k), rev(vv), rev(log_i[1]), rev(log_f[1])))
    h = (h_fwd + h_bwd).transpose(0, 2, 1, 3)
    h = rms_norm(h, g_out.reshape(ML_HEADS, ML_HD)) * jax.nn.sigmoid(o_pre.astype(f32)).reshape(B, S, ML_HEADS, ML_HD)
    return h.reshape(B, S, ML_W).astype(u.dtype)


def hier_moe(x, wg, bg, we, be, w_gate, w_up, w_down):
    B, S, _ = x.shape
    f32 = jnp.float32
    g_logits = (x @ wg).astype(f32) + bg.astype(f32)
    grp = jnp.argmax(g_logits, axis=-1)
    p_grp = jnp.max(jax.nn.softmax(g_logits, axis=-1), axis=-1)
    e_logits = ((x @ we).astype(f32) + be.astype(f32)).reshape(B, S, N_GROUPS, EXPERTS_PER_GROUP)
    e_sel = jnp.take_along_axis(e_logits, grp[..., None, None], axis=2)[..., 0, :]
    top_v, top_i = lax.top_k(e_sel, MOE_TOPK)
    w = jax.nn.softmax(top_v, axis=-1) * p_grp[..., None]
    eid = grp[..., None] * EXPERTS_PER_GROUP + top_i
    comb = jnp.sum(jax.nn.one_hot(eid, N_EXPERTS, dtype=f32) * w[..., None], axis=-2)
    h = jax.nn.silu(jnp.einsum('bsd,edf->bsef', x, w_gate)) * jnp.einsum('bsd,edf->bsef', x, w_up)
    h = h * comb[..., None].astype(h.dtype)
    return jnp.einsum('bsef,efd->bsd', h, w_down)


def setup_inputs(seed: int = 0) -> dict:
    key = jax.random.key(seed)
    ks = jax.random.split(key, 32)
    f32 = jnp.float32
    L = DEPTH

    def nrm(k, shape, scale):
        return jax.random.normal(k, shape, f32) * scale

    def gain(k, shape):
        return 1.0 + 0.05 * jax.random.normal(k, shape, f32)

    i_bias = nrm(ks[16], (L, 2, 1, ML_HEADS), 0.1)
    f_bias = jnp.linspace(ML_F_BIAS_LO, ML_F_BIAS_HI, ML_HEADS, dtype=f32) + nrm(ks[17], (L, 2, 1, ML_HEADS), 0.1)
    return {
        'x': nrm(ks[0], (BATCH, SEQ, D_MODEL), 1.0),
        'positions': jnp.arange(SEQ, dtype=jnp.int32)[None, :]
                     + jax.random.randint(ks[1], (BATCH, 1), 0, 4096, dtype=jnp.int32),
        'rel_bias': nrm(ks[2], (N_BUCKETS, DIL_HEADS), 0.2),
        'norm_mix': gain(ks[3], (L, D_MODEL)),
        'w_in': nrm(ks[4], (L, D_MODEL, C_IN), D_MODEL ** -0.5),
        'mla_norm_cq': gain(ks[5], (L, MLA_Q_RANK)),
        'mla_w_uq': nrm(ks[6], (L, MLA_Q_RANK, MLA_HEADS * MLA_QK), MLA_Q_RANK ** -0.5),
        'mla_norm_ckv': gain(ks[7], (L, MLA_KV_RANK)),
        'mla_w_ukv': nrm(ks[8], (L, MLA_KV_RANK, MLA_HEADS * (MLA_NOPE + MLA_V)), MLA_KV_RANK ** -0.5),
        'mla_q_norm': gain(ks[9], (L, MLA_QK)),
        'mla_k_norm': gain(ks[10], (L, MLA_QK)),
        'dil_q_norm': gain(ks[11], (L, DIL_HD)),
        'dil_k_norm': gain(ks[12], (L, DIL_HD)),
        'ml_conv_w': nrm(ks[13], (L, ML_CONV, ML_W), ML_CONV ** -0.5),
        'ml_conv_b': nrm(ks[14], (L, ML_W), 0.02),
        'ml_w_q': nrm(ks[15], (L, ML_HEADS, ML_HD, ML_HD), ML_HD ** -0.5),
        'ml_w_k': nrm(ks[18], (L, ML_HEADS, ML_HD, ML_HD), ML_HD ** -0.5),
        'ml_gate_bias': jnp.concatenate([i_bias, f_bias], axis=2),
        'ml_out_norm': gain(ks[19], (L, ML_W)),
        'w_out': nrm(ks[20], (L, D_MIX, D_MODEL), D_MIX ** -0.5),
        'norm_ffn': gain(ks[21], (L, D_MODEL)),
        'router_group_w': nrm(ks[22], (L, D_MODEL, N_GROUPS), D_MODEL ** -0.5),
        'router_group_b': nrm(ks[23], (L, N_GROUPS), 0.01),
        'router_expert_w': nrm(ks[24], (L, D_MODEL, N_EXPERTS), D_MODEL ** -0.5),
        'router_expert_b': nrm(ks[25], (L, N_EXPERTS), 0.01),
        'moe_w_gate': nrm(ks[26], (L, N_EXPERTS, D_MODEL, D_EXPERT), D_MODEL ** -0.5),
        'moe_w_up': nrm(ks[27], (L, N_EXPERTS, D_MODEL, D_EXPERT), D_MODEL ** -0.5),
        'moe_w_down': nrm(ks[28], (L, N_EXPERTS, D_EXPERT, D_MODEL), D_EXPERT ** -0.5),
    }


def reference(x, positions, rel_bias, norm_mix, w_in, mla_norm_cq, mla_w_uq, mla_norm_ckv, mla_w_ukv,
              mla_q_norm, mla_k_norm, dil_q_norm, dil_k_norm, ml_conv_w, ml_conv_b, ml_w_q, ml_w_k,
              ml_gate_bias, ml_out_norm, w_out, norm_ffn, router_group_w, router_group_b,
              router_expert_w, router_expert_b, moe_w_gate, moe_w_up, moe_w_down):
    cos, sin = rope_cos_sin(positions)
    split_at = np.cumsum(IN_SIZES)[:-1].tolist()
    for l in range(DEPTH):
        xn = rms_norm(x, norm_mix[l])
        c_q, c_kv, k_rope, dq, dk, dv, mu, mv, mo, mg = jnp.split(xn @ w_in[l], split_at, axis=-1)
        y_mla = mla_mixer(c_q, c_kv, k_rope, cos, sin, mla_norm_cq[l], mla_w_uq[l], mla_norm_ckv[l],
                          mla_w_ukv[l], mla_q_norm[l], mla_k_norm[l])
        y_dil = dilated_mixer(dq, dk, dv, rel_bias, dil_q_norm[l], dil_k_norm[l])
        y_ml = mlstm_mixer(mu, mv, mo, mg, ml_conv_w[l], ml_conv_b[l], ml_w_q[l], ml_w_k[l],
                           ml_gate_bias[l], ml_out_norm[l])
        x = x + jnp.concatenate([y_mla, y_dil, y_ml], axis=-1) @ w_out[l]
        x = x + hier_moe(rms_norm(x, norm_ffn[l]), router_group_w[l], router_group_b[l],
                         router_expert_w[l], router_expert_b[l], moe_w_gate[l], moe_w_up[l], moe_w_down[l])
    return x
```

```cpp
#include <hip/hip_runtime.h>
#include <cstdio>
#include <cstdint>

#ifndef MK_MULTI
#define MK_MULTI 0
#endif

#ifndef DUP_K
#define DUP_K -1
#endif
#define DEV __device__ __forceinline__
#define LAS __attribute__((address_space(3)))
typedef unsigned short bf16_t;
typedef short bf16x8 __attribute__((ext_vector_type(8)));
typedef short s16x4 __attribute__((ext_vector_type(4)));
typedef float f32x4 __attribute__((ext_vector_type(4)));
typedef float f32x2 __attribute__((ext_vector_type(2)));
__device__ __forceinline__ f32x2 mk2(float a, float b) { f32x2 r; r[0] = a; r[1] = b; return r; }
typedef float f32x16 __attribute__((ext_vector_type(16)));
typedef unsigned u32x4 __attribute__((ext_vector_type(4)));
typedef unsigned u32x2 __attribute__((ext_vector_type(2)));

constexpr int S_ = 8192, DM = 2048, CIN = 5168, CINP = 5376, NL = 2;
constexpr int OFF_CQ = 0, OFF_CKV = 384, OFF_KR = 512, OFF_DQ = 544, OFF_DK = 1312, OFF_DV = 2080, OFF_MU = 2848, OFF_MG = 4000, OFF_MO = 4480, N_EARLY = 4096, N_LATE = 1280;
__host__ __device__ constexpr int off_mv(int hd) { return hd < 2 ? 3616 + hd * 192 : 4096 + (hd - 2) * 192; }
__host__ __device__ constexpr int win_src_col(int n) { return n < 4000 ? n : (n < 4016 ? n + 1152 : (n < 4096 ? -1 : (n < 5248 ? n - 96 : -1))); }
constexpr float EPS = 1e-6f;
constexpr float LOG2E = 1.4426950408889634f, LN2 = 0.6931471805599453f;
constexpr int MAXSLOT = 20480;

constexpr size_t al256(size_t x) { return (x + 255) / 256 * 256; }
constexpr size_t WS_CTL = 0, CTL_BYTES = 65536;
constexpr size_t WS_XB = WS_CTL + CTL_BYTES;
constexpr size_t WS_XN = WS_XB + (size_t)S_ * DM * 4;
constexpr size_t WS_COS = WS_XN + (size_t)S_ * DM * 2;
constexpr size_t WS_SIN = WS_COS + (size_t)S_ * 16 * 4;
constexpr size_t WS_KR = WS_SIN + (size_t)S_ * 16 * 4;
constexpr size_t WS_GLI = WS_KR + (size_t)S_ * 32 * 4;
constexpr size_t WS_GLF = WS_GLI + (size_t)8 * S_ * 4;
constexpr size_t WS_EID = WS_GLF + (size_t)8 * S_ * 4;
constexpr size_t WS_WGT = WS_EID + (size_t)S_ * 8;
constexpr size_t WS_SLOTOF = WS_WGT + (size_t)S_ * 8;
constexpr size_t WS_PERM = WS_SLOTOF + (size_t)S_ * 8;
constexpr size_t WS_SLOTW = WS_PERM + (size_t)MAXSLOT * 4;
constexpr size_t WS_TSTART = WS_SLOTW + (size_t)MAXSLOT * 4;
constexpr size_t WS_TILES = WS_TSTART + 256;
constexpr size_t WS_CD = WS_TILES + 3 * 96 * 4;
constexpr size_t WS_WR3 = al256(WS_CD + 2 * 4 * 64 * 4);
constexpr size_t WS_ARENA = al256(WS_WR3 + (size_t)8 * 20 * 64 * 16);
constexpr size_t A_WIN = WS_ARENA;
constexpr size_t A_WOUT = A_WIN + (size_t)CINP * DM * 2;
constexpr size_t A_BD1 = A_WOUT + (size_t)DM * DM * 2;
constexpr size_t A_BD2 = A_BD1 + (size_t)1792 * 512 * 2;
constexpr size_t A_PROJ = A_BD2 + (size_t)1536 * 768 * 2;
constexpr size_t A_CQKV = A_PROJ + (size_t)S_ * CINP * 2;
constexpr size_t A_UC = A_CQKV + (size_t)S_ * 512 * 2;
constexpr size_t A_RAW = A_UC + (size_t)S_ * 768 * 2;
constexpr size_t A_MLQK = A_RAW + (size_t)S_ * 1792 * 2;
constexpr size_t A_QM = A_MLQK + (size_t)S_ * 1536 * 2;
constexpr size_t A_KM = A_QM + (size_t)S_ * 768 * 2;
constexpr size_t A_DPART = A_KM + (size_t)S_ * 768 * 2;
constexpr size_t A_DLSE = A_DPART + (size_t)3 * S_ * 768 * 2;
constexpr size_t A_DS = A_DLSE + (size_t)3 * S_ * 12 * 4;
constexpr size_t A_DN = A_DS + (size_t)512 * 36864 * 4;
constexpr size_t A_ST = A_DN + (size_t)512 * 192 * 4;
constexpr size_t A_SN = A_ST + (size_t)512 * 36864 * 2;
constexpr size_t A_YMIX = A_SN + (size_t)512 * 192 * 4;
constexpr size_t A_END = A_YMIX + (size_t)S_ * DM * 2;
constexpr size_t B_W1 = WS_ARENA;
constexpr size_t B_W2 = B_W1 + (size_t)16384 * 2048 * 2;
constexpr size_t B_APERM = B_W2 + (size_t)32768 * 512 * 2;
constexpr size_t B_H = B_APERM + (size_t)MAXSLOT * 2048 * 2;
constexpr size_t B_YS = B_H + (size_t)MAXSLOT * 512 * 2;
constexpr size_t B_END = B_YS + (size_t)MAXSLOT * 2048 * 2;
static_assert(B_YS >= A_PROJ, "YS must not overlap the next layer's converted weights (written while YS is still read)");
constexpr size_t WS_END = (A_END > B_END ? A_END : B_END);

constexpr int LDS_BYTES = 147456;
constexpr int LDS_BARW = LDS_BYTES - 64;

DEV int lane_id() { return (int)__builtin_amdgcn_mbcnt_hi(~0u, __builtin_amdgcn_mbcnt_lo(~0u, 0u)); }
DEV float bf2f(bf16_t b) { return __uint_as_float(((unsigned)b) << 16); }
DEV bf16_t f2bf(float f) { unsigned u = __float_as_uint(f); u += 0x7FFFu + ((u >> 16) & 1u); return (bf16_t)(u >> 16); }
DEV unsigned cvtpk(float lo, float hi) { unsigned r; asm volatile("v_cvt_pk_bf16_f32 %0, %1, %2" : "=v"(r) : "v"(lo), "v"(hi)); return r; }
DEV f32x4 ld_h4(const float* resid, const bf16_t* delta, size_t off) { f32x4 v = *(const f32x4*)(resid + off); const u32x2 d = *(const u32x2*)(delta + off);
    v[0] += __uint_as_float(d.x << 16); v[1] += __uint_as_float(d.x & 0xffff0000u); v[2] += __uint_as_float(d.y << 16); v[3] += __uint_as_float(d.y & 0xffff0000u); return v; }
DEV f32x4 ld_h4nt(const float* resid, const bf16_t* delta, size_t off) { f32x4 v = __builtin_nontemporal_load((const f32x4*)(resid + off)); const u32x2 d = __builtin_nontemporal_load((const u32x2*)(delta + off));
    v[0] += __uint_as_float(d.x << 16); v[1] += __uint_as_float(d.x & 0xffff0000u); v[2] += __uint_as_float(d.y << 16); v[3] += __uint_as_float(d.y & 0xffff0000u); return v; }
DEV float2 ld_bf2(const bf16_t* p) { const unsigned u = *(const unsigned*)p; return make_float2(__uint_as_float(u << 16), __uint_as_float(u & 0xffff0000u)); }
DEV void st_bf2(bf16_t* p, float a, float b) { *(unsigned*)p = cvtpk(a, b); }
DEV float wave_sum(float v) {
#pragma unroll
    for (int o = 1; o < 64; o <<= 1) v += __shfl_xor(v, o);
    return v;
}
DEV int otid(int wv) { (void)wv; int t = threadIdx.x; asm volatile("" : "+v"(t)); return t; }
DEV u32x4 zero4() { unsigned z = 0u; asm volatile("" : "+v"(z)); return (u32x4){z, z, z, z}; }
DEV int obid_(int v) { asm volatile("" : "+s"(v)); return v; }
DEV int crow(int r, int hi) { return (r & 3) + 8 * (r >> 2) + 4 * hi; }
DEV int ld_agent_i(const int* p) { return __hip_atomic_load(p, __ATOMIC_RELAXED, __HIP_MEMORY_SCOPE_AGENT); }
#define MFMA32(a, b, c) __builtin_amdgcn_mfma_f32_32x32x16_bf16((a), (b), (c), 0, 0, 0)
#define SBAR() __builtin_amdgcn_sched_barrier(0)
#define PK4(P, BASE, OUT) do { unsigned a0_ = cvtpk(P[BASE + 0], P[BASE + 1]), a1_ = cvtpk(P[BASE + 2], P[BASE + 3]);   \
    unsigned b0_ = cvtpk(P[BASE + 4], P[BASE + 5]), b1_ = cvtpk(P[BASE + 6], P[BASE + 7]);                              \
    auto r0_ = __builtin_amdgcn_permlane32_swap(a0_, b0_, false, false); auto r1_ = __builtin_amdgcn_permlane32_swap(a1_, b1_, false, false); \
    u32x4 w_ = {r0_[0], r1_[0], r0_[1], r1_[1]}; OUT = __builtin_bit_cast(bf16x8, w_); } while (0)

#define XB_TMO      128
#define XB_XCNT(j)  (256  + 64 * (j))
#define XB_XSUB(j)  (1280 + 64 * (j))
#define XB_XGEN(j)  (2304 + 64 * (j))
#define XB_TOP      3328
#define XB_TOPGEN   3392
#define XCD_BAR_WORDS 3456
#define XB_SPIN_CAP (1u << 18)
__device__ __forceinline__ unsigned xb_ld(unsigned* p)              { return __hip_atomic_load(p, __ATOMIC_RELAXED, __HIP_MEMORY_SCOPE_AGENT); }
__device__ __forceinline__ unsigned xb_add(unsigned* p, unsigned v) { return __hip_atomic_fetch_add(p, v, __ATOMIC_RELAXED, __HIP_MEMORY_SCOPE_AGENT); }
__device__ __forceinline__ unsigned xb_xcc_id() { return (unsigned)__builtin_amdgcn_s_getreg((3 << 11) | 20) & 0xFu; }
#define XB_SPIN(cond, bar) do { unsigned _sp = 0; while (cond) { __builtin_amdgcn_s_sleep(1); \
    if ((++_sp & 255u) == 0u) { if (xb_ld(&(bar)[XB_TMO])) break; if (_sp > XB_SPIN_CAP) { atomicAdd(&(bar)[XB_TMO], 1u); break; } } } } while (0)
struct XcdBarrier { unsigned* bar; unsigned x; volatile LAS unsigned* st; int wv; };
__device__ __forceinline__ XcdBarrier xcd_barrier_post(unsigned* bar, volatile LAS unsigned* st, int wv) {
    XcdBarrier b; b.bar = bar; b.x = xb_xcc_id(); b.st = st; b.wv = wv;
    if (threadIdx.x == 0) (void)xb_add(&bar[XB_XCNT(b.x)], 1u);
    return b;
}
__device__ __forceinline__ void xcd_barrier_complete(unsigned* bar, unsigned x, unsigned& nloc, unsigned& nx) {
    const unsigned G = gridDim.x * gridDim.y * gridDim.z;
    unsigned sum, cnt, mine, sp = 0u;
    for (;;) {
        sum = 0u; cnt = 0u; mine = 0u;
#pragma unroll
        for (unsigned j = 0; j < 16; ++j) { const unsigned c = xb_ld(&bar[XB_XCNT(j)]); sum += c; cnt += (c > 0u) ? 1u : 0u; mine = (j == x) ? c : mine; }
        if (sum == G) break;
        __builtin_amdgcn_s_sleep(1);
        if ((++sp & 255u) == 0u) { if (xb_ld(&bar[XB_TMO])) break; if (sp > XB_SPIN_CAP) { atomicAdd(&bar[XB_TMO], 1u); break; } }
    }
    nloc = mine > 0u ? mine : 1u; nx = cnt > 0u ? cnt : 1u;
}
__device__ __forceinline__ void xcd_barrier(const XcdBarrier& b) {
    asm volatile("s_waitcnt vmcnt(0)" ::: "memory");
    __syncthreads();
    if (threadIdx.x == 0) {
        unsigned* bar = b.bar;
        __builtin_amdgcn_s_waitcnt(0);
        unsigned nloc = b.st[0], nx = b.st[1];
        if (nloc == 0u) { xcd_barrier_complete(bar, b.x, nloc, nx); b.st[0] = nloc; b.st[1] = nx; }
        const unsigned old = xb_add(&bar[XB_XSUB(b.x)], 1u);
        const unsigned gen = old / nloc;
        if (old + 1u == (gen + 1u) * nloc) {
            __builtin_amdgcn_fence(__ATOMIC_RELEASE, "agent");
            asm volatile("s_waitcnt vmcnt(0)" ::: "memory");
            const unsigned og = xb_add(&bar[XB_TOP], 1u);
            const unsigned tg = og / nx;
            if (og + 1u == (tg + 1u) * nx) xb_add(&bar[XB_TOPGEN], 1u);
            else XB_SPIN(xb_ld(&bar[XB_TOPGEN]) == tg, bar);
            __builtin_amdgcn_fence(__ATOMIC_ACQUIRE, "agent");
            xb_add(&bar[XB_XGEN(b.x)], 1u);
            asm volatile("s_waitcnt vmcnt(0)" ::: "memory");
        } else {
            XB_SPIN(xb_ld(&bar[XB_XGEN(b.x)]) == gen, bar);
            __builtin_amdgcn_fence(__ATOMIC_ACQUIRE, "agent");
            asm volatile("s_waitcnt vmcnt(0)" ::: "memory");
        }
    }
    __syncthreads();
}

namespace pg8 {
constexpr int BM = 256, BK = 64, HALF = 128, HTB = HALF * BK * 2, STAGE_BYTES = 8 * HTB, NXCD = 8, WGM = 8;
__host__ __device__ __forceinline__ int lds_byte(int r, int c) { const int st = (r >> 4) * 2 + (c >> 5), rr = r & 15, cc = c & 31, ob = rr * 64 + cc * 2; return st * 1024 + (ob ^ (((ob >> 9) & 1) << 5)); }
__host__ __device__ __forceinline__ void stage_rc(int b, int& R, int& C) { const int st = b / 1024, sb = b % 1024, swz = sb ^ (((sb >> 9) & 1) << 5); R = (st >> 1) * 16 + swz / 64; C = (st & 1) * 32 + (swz % 64) / 2; }
__host__ __device__ __forceinline__ int perm32(int rho) { const int n = rho >> 4, i = rho & 15; return 8 * (i >> 2) + 4 * n + (i & 3); }
struct Unit { int pm, pn; int half; };
struct Gemm { const bf16_t* A; const bf16_t* Bt; int lda, ldb, K; int kmod, kstride; };
struct StaticOrder {
    int nM, nN, nwg, G, c, l0, maxi;
    __device__ void init(int M, int N, int G_, int c_, int l0_ = 0, int maxi_ = 0x7fffffff) { nM = M / BM; nN = N / BM; nwg = nM * nN; G = G_; c = c_; l0 = l0_; maxi = maxi_; }
    __device__ bool next(int i, Unit& u) const {
        if (i >= maxi || c < 0) return false;
        const long L = (long)l0 + (long)i * G + c; if (L >= nwg) return false;
        int wgid = (int)L; { const int q = nwg / NXCD, r = nwg % NXCD, xcd = wgid % NXCD, off = wgid / NXCD; wgid = (xcd < r ? xcd * (q + 1) : r * (q + 1) + (xcd - r) * q) + off; }
        const int nig = WGM * nN, gid = wgid / nig, fm = gid * WGM, gsz = (nM - fm) < WGM ? (nM - fm) : WGM;
        u.pm = fm + ((wgid % nig) % gsz); u.pn = (wgid % nig) / gsz; u.half = 0; return true;
    }
    __device__ __forceinline__ void a_ready(const Unit&) const {}
};
struct MoeOrder {
    const int* tstart; const int* tiles; int nct, G, c;
    __device__ bool next(int i, Unit& u) const {
        const int total = ld_agent_i(tstart + 16);
        const long L = (long)i * G + c; if (L >= (long)total * nct) return false;
        const int q = (int)(L / nct), ct = (int)(L % nct), p = ld_agent_i(tiles + q), e = ld_agent_i(tiles + 96 + p);
        u.pm = p; u.pn = e * nct + ct; u.half = ld_agent_i(tiles + 192 + p); return true;
    }
    __device__ __forceinline__ void a_ready(const Unit&) const {}
};
struct MoeOrder2 {
    const int* tstart; const int* tiles; unsigned* cnt; unsigned* tmo; int G, c;
    __device__ bool next(int i, Unit& u) const {
        const int T = ld_agent_i(tstart + 16); const int n1 = 4 * T, nh = n1 > G ? (n1 - G < G ? n1 - G : G - 1) : 0;
        if (c < nh) return false;
        const long L = (long)i * (G - nh) + (c - nh); if (L >= (long)T * 8) return false;
        const int q = (int)(L >> 3), ct = (int)(L & 7), p = ld_agent_i(tiles + q), e = ld_agent_i(tiles + 96 + p);
        u.pm = p; u.pn = e * 8 + ct; u.half = ld_agent_i(tiles + 192 + p); return true;
    }
    __device__ __forceinline__ void a_ready(const Unit& u) const {
        if (threadIdx.x < 64) {
            unsigned sp = 0;
            while ((unsigned)__builtin_amdgcn_readfirstlane(__hip_atomic_load(cnt + 64 * u.pm, __ATOMIC_RELAXED, __HIP_MEMORY_SCOPE_AGENT)) < 32u) {
                __builtin_amdgcn_s_sleep(2);
                if ((++sp & 255u) == 0u) { if (__hip_atomic_load(tmo, __ATOMIC_RELAXED, __HIP_MEMORY_SCOPE_AGENT)) break; if (sp > (1u << 20)) { atomicAdd(tmo, 1u); break; } } }
            __builtin_amdgcn_fence(__ATOMIC_ACQUIRE, "agent");
            asm volatile("s_waitcnt vmcnt(0)" ::: "memory");
        }
        asm volatile("" ::: "memory"); __builtin_amdgcn_s_barrier(); asm volatile("" ::: "memory");
    }
};
struct EpiBf16 {
    static constexpr bool PERM = true;
    __device__ __forceinline__ void done(const Unit&) const {}
    bf16_t* O; int ldc; int pnmask;
    __device__ __forceinline__ void operator()(const f32x4 (&acc)[2][2][4][2], const Unit& u, int wr, int wc, int fr, int fq) const {
        const int row0 = u.pm * BM + wr * 64 + fr; const int col0 = (u.pn & pnmask) * BM + wc * 32 + 8 * fq;
#pragma unroll
        for (int ai = 0; ai < 2; ++ai)
#pragma unroll
            for (int m = 0; m < 4; ++m) { bf16_t* rowp = O + (size_t)(row0 + ai * HALF + m * 16) * ldc + col0;
#pragma unroll
                for (int bj = 0; bj < 2; ++bj) { const f32x4 v0 = acc[ai][bj][m][0], v1 = acc[ai][bj][m][1];
                    u32x4 w; w.x = cvtpk(v0[0], v0[1]); w.y = cvtpk(v0[2], v0[3]); w.z = cvtpk(v1[0], v1[1]); w.w = cvtpk(v1[2], v1[3]);
                    *(u32x4*)(rowp + bj * HALF) = w; } }
    }
};
struct EpiResid {
    static constexpr bool PERM = false;
    __device__ __forceinline__ void done(const Unit&) const {}
    float* C; const float* R; int ldc;
    __device__ __forceinline__ void operator()(const f32x4 (&acc)[2][2][4][2], const Unit& u, int wr, int wc, int fr, int fq) const {
        const int row0 = u.pm * BM + wr * 64 + fr, col0 = u.pn * BM + wc * 32 + 4 * fq;
#pragma unroll
        for (int ai = 0; ai < 2; ++ai)
#pragma unroll
            for (int m = 0; m < 4; ++m) { const size_t off = (size_t)(row0 + ai * HALF + m * 16) * ldc + col0;
#pragma unroll
                for (int bj = 0; bj < 2; ++bj)
#pragma unroll
                    for (int n = 0; n < 2; ++n) { const f32x4 rv = *(const f32x4*)(R + off + bj * HALF + n * 16); *(f32x4*)(C + off + bj * HALF + n * 16) = acc[ai][bj][m][n] + rv; } }
    }
};
struct EpiMoe1 {
    static constexpr bool PERM = false;
    bf16_t* H; const float* slotw; unsigned* cnt;
    __device__ __forceinline__ void done(const Unit& u) const {
        if (cnt) { asm volatile("s_waitcnt vmcnt(0)" ::: "memory"); if (lane_id() == 0) __hip_atomic_fetch_add(cnt + 64 * u.pm, 1u, __ATOMIC_RELAXED, __HIP_MEMORY_SCOPE_AGENT); } }
    __device__ __forceinline__ void operator()(const f32x4 (&acc)[2][2][4][2], const Unit& u, int wr, int wc, int fr, int fq) const {
        const int row0 = u.pm * BM + wr * 64 + fr; const int ct = u.pn & 3;
        const __amdgpu_buffer_rsrc_t rsrc = __builtin_amdgcn_make_buffer_rsrc((void*)H, (short)0, MAXSLOT * 512 * 2, 0x00020000);
#pragma unroll
        for (int ai = 0; ai < 2; ++ai)
#pragma unroll
            for (int m = 0; m < 4; ++m) { const int row = row0 + ai * HALF + m * 16; const float w = slotw[row]; u32x4 o;
#pragma unroll
                for (int bj = 0; bj < 2; ++bj) { const f32x4 g = acc[ai][bj][m][0], up = acc[ai][bj][m][1]; float hv[4];
#pragma unroll
                    for (int j = 0; j < 4; ++j) hv[j] = g[j] / (1.0f + __expf(-g[j])) * up[j] * w;
                    o[2 * bj] = cvtpk(hv[0], hv[1]); o[2 * bj + 1] = cvtpk(hv[2], hv[3]); }
                __builtin_amdgcn_raw_buffer_store_b128(o, rsrc, (row * 512 + ct * 128 + wc * 32 + 8 * fq) * 2, 0, 16); }
    }
};

template <bool GATHER = false, bool HALFSKIP = false, class Epi, class Sched>
__device__ __forceinline__ void gemm_phase(LAS unsigned char* lds, const Gemm g, const Sched& S, const Epi& E, int wv, const int* perm = nullptr) {
    const int tid = otid(wv), wid = __builtin_amdgcn_readfirstlane(tid >> 6), lane = tid & 63, wr = wid >> 2, wc = wid & 3, fr = lane & 15, fq = lane >> 4;
    const int K = g.K, nt = K / BK;
    unsigned voffA[2], voffB[2]; int rA[2], cA2[2];
#pragma unroll
    for (int i = 0; i < 2; ++i) { int R, C; stage_rc(tid * 16 + i * 8192, R, C); const int Rb = Epi::PERM ? ((R & ~31) + perm32(R & 31)) : R; rA[i] = R; cA2[i] = C * 2;
        voffA[i] = (unsigned)(R * g.lda + C) * 2u; voffB[i] = (unsigned)(Rb * g.ldb + C) * 2u; }
    const size_t kstep = (size_t)(BK * 2);
    const size_t hstepA = (size_t)HALF * g.lda * 2, hstepB = (size_t)HALF * g.ldb * 2;
    const size_t tstepA = 2 * hstepA, tstepB = 2 * hstepB;
    const unsigned ldsw = (unsigned)wid * 1024u;
    const int aoff = lds_byte(wr * 64 + fr, fq * 8), boff = lds_byte(wc * 32 + fr, fq * 8);
#define PG8_SA(b, h) (((b) * 2 + (h)) * HTB)
#define PG8_SB(b, h) ((4 + (b) * 2 + (h)) * HTB)
#define PG8_STAGE(bufoff, gbase, voff) do { _Pragma("unroll") for (int _i = 0; _i < 2; ++_i) \
        __builtin_amdgcn_global_load_lds((const unsigned*)((const char*)(gbase) + (voff)[_i]), (LAS unsigned*)(lds + (bufoff) + ldsw + _i * 8192), 16, 0, 0); } while (0)
#define PG8_STAGE_A(bufoff, h, kb, nx) do { if constexpr (GATHER) { _Pragma("unroll") for (int _i = 0; _i < 2; ++_i) \
        __builtin_amdgcn_global_load_lds((const unsigned*)((const char*)g.A + (kb) + ((nx) ? vN[h][_i] : vC[h][_i])), (LAS unsigned*)(lds + (bufoff) + ldsw + _i * 8192), 16, 0, 0); } \
        else { PG8_STAGE(bufoff, ((nx) ? nA : cA) + (h) * hstepA + (kb), voffA); } } while (0)
#define PG8_VOFF(v, u) do { _Pragma("unroll") for (int _h = 0; _h < 2; ++_h) _Pragma("unroll") for (int _i = 0; _i < 2; ++_i) \
        v[_h][_i] = (unsigned)perm[(u).pm * BM + _h * HALF + rA[_i]] * (unsigned)(g.lda * 2) + (unsigned)cA2[_i]; } while (0)
#define PG8_LDA(dst, b, h) do { _Pragma("unroll") for (int m = 0; m < 4; ++m) _Pragma("unroll") for (int k = 0; k < 2; ++k) dst[m][k] = *(const LAS bf16x8*)(lds + PG8_SA(b, h) + aoff + m * 2048 + k * 1024); } while (0)
#define PG8_LDB(dst, b, h) do { _Pragma("unroll") for (int n = 0; n < 2; ++n) _Pragma("unroll") for (int k = 0; k < 2; ++k) dst[n][k] = *(const LAS bf16x8*)(lds + PG8_SB(b, h) + boff + n * 2048 + k * 1024); } while (0)
#define PG8_MMA(ai, bj, At, Bt) do { __builtin_amdgcn_s_setprio(1); _Pragma("unroll") for (int m = 0; m < 4; ++m) _Pragma("unroll") for (int n = 0; n < 2; ++n) _Pragma("unroll") for (int k = 0; k < 2; ++k) \
        acc[ai][bj][m][n] = __builtin_amdgcn_mfma_f32_16x16x32_bf16(Bt[n][k], At[m][k], acc[ai][bj][m][n], 0, 0, 0); __builtin_amdgcn_s_setprio(0); } while (0)
#define PG8_WAIT_V(n) asm volatile("s_waitcnt vmcnt(" #n ")" ::: "memory")
#define PG8_WAIT_L(n) asm volatile("s_waitcnt lgkmcnt(" #n ")" ::: "memory")
#define PG8_BAR __builtin_amdgcn_s_barrier()
#define PG8_SCHED __builtin_amdgcn_sched_barrier(0)
    Unit cur, nxt; int ui = 0;
    if (!S.next(0, cur)) return;
    f32x4 acc[2][2][4][2];
#pragma unroll
    for (int a = 0; a < 2; ++a)
#pragma unroll
        for (int b = 0; b < 2; ++b)
#pragma unroll
            for (int m = 0; m < 4; ++m)
#pragma unroll
                for (int n = 0; n < 2; ++n) acc[a][b][m][n] = (f32x4){0.f, 0.f, 0.f, 0.f};
    bf16x8 At[4][2], B0[2][2], B1[2][2];
    unsigned vC[2][2] = {{0u, 0u}, {0u, 0u}}, vN[2][2] = {{0u, 0u}, {0u, 0u}};
    S.a_ready(cur);
    if constexpr (GATHER) PG8_VOFF(vC, cur);
    const char* cA = (const char*)g.A + (GATHER ? (size_t)0 : (size_t)cur.pm * tstepA) + (size_t)((cur.pn % g.kmod) * g.kstride) * 2; const char* cB = (const char*)g.Bt + (size_t)cur.pn * tstepB + (size_t)((cur.pn % g.kmod) * g.kstride) * 2; const char* nA = cA;
    PG8_STAGE(PG8_SB(0, 0), cB, voffB); PG8_STAGE_A(PG8_SA(0, 0), 0, (size_t)0, false); PG8_STAGE(PG8_SB(0, 1), cB + hstepB, voffB); PG8_STAGE_A(PG8_SA(0, 1), 1, (size_t)0, false);
    if (wr == 1) PG8_BAR;
    PG8_WAIT_V(4); PG8_BAR;
    PG8_STAGE(PG8_SB(1, 0), cB + kstep, voffB); PG8_STAGE_A(PG8_SA(1, 0), 0, kstep, false); PG8_STAGE(PG8_SB(1, 1), cB + hstepB + kstep, voffB);
    PG8_WAIT_V(6); PG8_BAR;
    for (;;) {
        const bool has_next = S.next(ui + 1, nxt);
        if constexpr (GATHER) { if (has_next) PG8_VOFF(vN, nxt); else { vN[0][0] = vC[0][0]; vN[0][1] = vC[0][1]; vN[1][0] = vC[1][0]; vN[1][1] = vC[1][1]; } }
        const size_t nko = has_next ? (size_t)((nxt.pn % g.kmod) * g.kstride) * 2 : 0;
        nA = (has_next && !GATHER) ? (const char*)g.A + (size_t)nxt.pm * tstepA + nko : cA; const char* nB = has_next ? (const char*)g.Bt + (size_t)nxt.pn * tstepB + nko : cB;
        for (int t = 0; t < nt; t += 2) {
            const bool last = (t == nt - 2);
            if (last && has_next) S.a_ready(nxt);
            const size_t k1 = (size_t)(t + 1) * kstep, k2 = last ? (size_t)0 : (size_t)(t + 2) * kstep, k3 = k2 + kstep;
            const char* b2 = last ? nB : cB + (size_t)(t + 2) * kstep; const char* b3 = b2 + kstep;
            PG8_LDB(B0, 0, 0); PG8_SCHED; PG8_LDA(At, 0, 0); PG8_STAGE_A(PG8_SA(1, 1), 1, k1, false);
            PG8_WAIT_L(8); PG8_BAR; PG8_WAIT_L(0); PG8_MMA(0, 0, At, B0); PG8_BAR; PG8_SCHED;
            PG8_LDB(B1, 0, 1); PG8_STAGE(PG8_SB(0, 0), b2, voffB);
            PG8_BAR; PG8_WAIT_L(0); PG8_MMA(0, 1, At, B1); PG8_BAR;
            PG8_LDA(At, 0, 1); PG8_STAGE_A(PG8_SA(0, 0), 0, k2, last);
            PG8_BAR; PG8_WAIT_L(0); if (!(HALFSKIP && cur.half)) PG8_MMA(1, 0, At, B0); PG8_BAR; PG8_SCHED;
            PG8_STAGE(PG8_SB(0, 1), b2 + hstepB, voffB);
            PG8_WAIT_V(6); PG8_BAR; if (!(HALFSKIP && cur.half)) PG8_MMA(1, 1, At, B1); PG8_BAR;
            PG8_LDB(B0, 1, 0); PG8_SCHED; PG8_LDA(At, 1, 0); PG8_STAGE_A(PG8_SA(0, 1), 1, k2, last);
            PG8_WAIT_L(8); PG8_BAR; PG8_WAIT_L(0); PG8_MMA(0, 0, At, B0); PG8_BAR; PG8_SCHED;
            PG8_LDB(B1, 1, 1); PG8_STAGE(PG8_SB(1, 0), b3, voffB);
            PG8_BAR; PG8_WAIT_L(0); PG8_MMA(0, 1, At, B1); PG8_BAR;
            PG8_LDA(At, 1, 1); PG8_STAGE_A(PG8_SA(1, 0), 0, k3, last);
            PG8_BAR; PG8_WAIT_L(0); if (!(HALFSKIP && cur.half)) PG8_MMA(1, 0, At, B0); PG8_BAR; PG8_SCHED;
            PG8_STAGE(PG8_SB(1, 1), b3 + hstepB, voffB);
            PG8_WAIT_V(6); PG8_BAR; if (!(HALFSKIP && cur.half)) PG8_MMA(1, 1, At, B1); PG8_BAR;
        }
        E(acc, cur, wr, wc, fr, fq); E.done(cur);
        if (!has_next) break;
#pragma unroll
        for (int a = 0; a < 2; ++a)
#pragma unroll
            for (int b = 0; b < 2; ++b)
#pragma unroll
                for (int m = 0; m < 4; ++m)
#pragma unroll
                    for (int n = 0; n < 2; ++n) acc[a][b][m][n] = (f32x4){0.f, 0.f, 0.f, 0.f};
        cur = nxt; cA = nA; cB = nB; ++ui;
        if constexpr (GATHER) { vC[0][0] = vN[0][0]; vC[0][1] = vN[0][1]; vC[1][0] = vN[1][0]; vC[1][1] = vN[1][1]; }
    }
    PG8_WAIT_V(0);
    if (wr == 0) PG8_BAR;
    PG8_BAR;
#undef PG8_SA
#undef PG8_SB
#undef PG8_STAGE
#undef PG8_STAGE_A
#undef PG8_VOFF
#undef PG8_LDA
#undef PG8_LDB
#undef PG8_MMA
#undef PG8_WAIT_V
#undef PG8_WAIT_L
#undef PG8_BAR
#undef PG8_SCHED
}
}

struct Args {
    const float* x; const int* pos; const float* rel_bias; const float* norm_mix; const float* w_in; const float* g_cq; const float* w_uq; const float* g_ckv; const float* w_ukv;
    const float* g_q; const float* g_k; const float* dg_q; const float* dg_k; const float* conv_w; const float* conv_b; const float* ml_wq; const float* ml_wk; const float* gate_bias;
    const float* g_out; const float* w_out; const float* norm_ffn; const float* wg; const float* bg; const float* we; const float* be; const float* w_gate; const float* w_up; const float* w_down;
    float* out; unsigned char* ws; int ph_lo, ph_hi;
};
typedef __attribute__((address_space(1))) unsigned char gchar_t;
DEV gchar_t* ows(const Args& a) { gchar_t* p = (gchar_t*)a.ws; asm volatile("" : "+s"(p)); return p; }
#define WSP(T, off) ((T*)(ows(a) + (off)))

__constant__ unsigned char c_bucket[3][129] = {
{11,11,11,11,11,11,11,11,11,11,11,11,11,11,11,10,10,10,10,10,10,10,10,10,10,10,10,10,10,10,10,10,10,10,10,10,10,10,9,9,9,9,9,9,9,9,9,9,9,9,8,8,8,8,8,8,8,7,6,5,4,3,2,1,0,17,18,19,20,21,22,23,24,24,24,24,24,24,24,25,25,25,25,25,25,25,25,25,25,25,25,26,26,26,26,26,26,26,26,26,26,26,26,26,26,26,26,26,26,26,26,26,26,26,27,27,27,27,27,27,27,27,27,27,27,27,27,27,27},
{13,13,13,13,13,13,13,13,13,13,13,13,13,13,13,13,13,13,13,13,13,13,13,12,12,12,12,12,12,12,12,12,12,12,12,12,12,12,12,12,12,12,11,11,11,11,11,11,11,11,11,11,10,10,10,10,10,10,9,9,9,8,8,4,0,20,24,24,25,25,25,26,26,26,26,26,26,27,27,27,27,27,27,27,27,27,27,28,28,28,28,28,28,28,28,28,28,28,28,28,28,28,28,28,28,28,29,29,29,29,29,29,29,29,29,29,29,29,29,29,29,29,29,29,29,29,29,29,29},
{15,15,15,15,15,15,15,15,15,15,15,15,15,15,15,15,15,15,15,15,15,15,15,15,15,15,15,15,15,15,14,14,14,14,14,14,14,14,14,14,14,14,14,14,14,13,13,13,13,13,13,13,13,13,12,12,12,12,12,11,11,10,10,9,0,25,26,26,27,27,28,28,28,28,28,29,29,29,29,29,29,29,29,29,30,30,30,30,30,30,30,30,30,30,30,30,30,30,30,31,31,31,31,31,31,31,31,31,31,31,31,31,31,31,31,31,31,31,31,31,31,31,31,31,31,31,31,31,31}};

DEV void cvt_item(const float* src, size_t ldsrc, int k0, int n0, int nvalid, bf16_t* dst, size_t lddst, int drow0, int dcol0, bool mode16, float scale, LAS float* scr, int lane, bool remap = false) {
    if (src) {
        f32x4 v[16];
        const int c4 = lane & 15, rq = lane >> 4; const int sn = remap ? win_src_col(n0 + c4 * 4) : n0 + c4 * 4; const bool ok = sn >= 0 && sn < nvalid;
#pragma unroll
        for (int i = 0; i < 16; ++i) v[i] = ok ? __builtin_nontemporal_load((const f32x4*)(src + (size_t)(k0 + i * 4 + rq) * ldsrc + sn)) : __builtin_bit_cast(f32x4, zero4());
#pragma unroll
        for (int i = 0; i < 16; ++i) { LAS float* d = scr + (i * 4 + rq) * 65 + c4 * 4; d[0] = v[i][0] * scale; d[1] = v[i][1] * scale; d[2] = v[i][2] * scale; d[3] = v[i][3] * scale; }
    }
    asm volatile("s_waitcnt lgkmcnt(0)" ::: "memory");
    const int c = lane & 7;
#pragma unroll
    for (int j = 0; j < 8; ++j) { const int n = (lane >> 3) + 8 * j; const LAS float* s = scr + (8 * c) * 65 + n;
        u32x4 o = zero4();
        if (src) { o.x = cvtpk(s[0 * 65], s[1 * 65]); o.y = cvtpk(s[2 * 65], s[3 * 65]); o.z = cvtpk(s[4 * 65], s[5 * 65]); o.w = cvtpk(s[6 * 65], s[7 * 65]); }
        const int dr = drow0 + (mode16 ? (((n >> 2) & 1) * 128 + (n >> 5) * 32 + ((n >> 3) & 3) * 4 + (n & 3)) : n);
        *(u32x4*)(dst + (size_t)dr * lddst + dcol0 + 8 * c) = o; }
    asm volatile("s_waitcnt lgkmcnt(0)" ::: "memory");
}
DEV void phase_cvt_a(const Args& a, int l, LAS unsigned char* lds, int wv) {
    const int wid = __builtin_amdgcn_readfirstlane(otid(wv) >> 6), lane = otid(wv) & 63;
    LAS float* scr = (LAS float*)(lds + wid * 16640);
    const int gw = blockIdx.x * 8 + wid, NGW = gridDim.x * 8;
    constexpr int I_IN = 84 * 32, I_OUT = 32 * 32, I_BD1 = 28 * 8, I_BD2 = 24 * 12, NIT = I_IN + I_OUT + I_BD1 + I_BD2;
    bf16_t* WinT = WSP(bf16_t, A_WIN); bf16_t* WoutT = WSP(bf16_t, A_WOUT); bf16_t* BD1 = WSP(bf16_t, A_BD1); bf16_t* BD2 = WSP(bf16_t, A_BD2);
    for (int it = gw; it < NIT; it += NGW) {
        int r = it;
        if (r < I_IN) { const int nb = r % 84, kb = r / 84;
            cvt_item(a.w_in + (size_t)l * DM * CIN, CIN, kb * 64, nb * 64, CIN, WinT, DM, nb * 64, kb * 64, false, 1.f, scr, lane, true); continue; } r -= I_IN;
        if (r < I_OUT) { const int nb = r % 32, kb = r / 32;
            cvt_item(a.w_out + (size_t)l * DM * DM, DM, kb * 64, nb * 64, DM, WoutT, DM, nb * 64, kb * 64, false, 1.f, scr, lane); continue; } r -= I_OUT;
        if (r < I_BD1) { const int nb = r % 28, kb = r / 28;
            const float* src = nullptr; size_t lds_ = 0; int k0 = 0, n0 = 0, nv = 0;
            if (nb < 12) { if (kb < 6) { src = a.w_uq + (size_t)l * 384 * 768; lds_ = 768; k0 = kb * 64; n0 = nb * 64; nv = 768; } }
            else { if (kb >= 6) { src = a.w_ukv + (size_t)l * 128 * 1024; lds_ = 1024; k0 = (kb - 6) * 64; n0 = (nb - 12) * 64; nv = 1024; } }
            cvt_item(src, lds_, k0, n0, nv, BD1, 512, nb * 64, kb * 64, false, 1.f, scr, lane); continue; } r -= I_BD1;
        { const int nb = r % 24, kb = r / 24;
            const int n = nb * 64, which = n / 768, np = n % 768, hd = np / 192, e0 = np % 192, hk = kb / 3;
            const float* src = nullptr; int k0 = 0;
            if (hk == hd) { src = (which ? a.ml_wk : a.ml_wq) + ((size_t)l * 4 + hd) * 192 * 192; k0 = (kb % 3) * 64; }
            cvt_item(src, 192, k0, e0, 192, BD2, 768, nb * 64, kb * 64, false, which ? 0.07216878364870322f : 1.f, scr, lane); }
    }
}
DEV void phase_cvt_router(const Args& a, int l, int wv) {
    f32x4* WR3 = WSP(f32x4, WS_WR3); const float* wg = a.wg + (size_t)l * DM * 4; const float* we = a.we + (size_t)l * DM * 16;
    for (int it = blockIdx.x * 512 + otid(wv); it < 8 * 20 * 64; it += gridDim.x * 512) { const int ln = it & 63, q = (it >> 6) % 20, i = it / (64 * 20), c = q / 5, qq = q % 5, e = (i * 64 + ln) * 4 + c;
        WR3[it] = (qq == 0) ? *(const f32x4*)(wg + (size_t)e * 4) : *(const f32x4*)(we + (size_t)e * 16 + (qq - 1) * 4); }
}
DEV void phase_cvt_b(const Args& a, int l, LAS unsigned char* lds, int b0, int wv) {
    const int wid = __builtin_amdgcn_readfirstlane(otid(wv) >> 6), lane = otid(wv) & 63;
    LAS float* scr = (LAS float*)(lds + wid * 16640);
    if ((int)blockIdx.x < b0) return;
    const int gw = ((int)blockIdx.x - b0) * 8 + wid, NGW = ((int)gridDim.x - b0) * 8;
    constexpr int I_W1 = 16 * 2 * 8 * 32, I_W2 = 16 * 32 * 8;
    bf16_t* W1 = WSP(bf16_t, B_W1); bf16_t* W2 = WSP(bf16_t, B_W2);
    for (int it = gw; it < I_W1 + I_W2; it += NGW) {
        int r = it;
        if (r < I_W1) { const int fb = r % 8; r /= 8; const int kb = r % 32; r /= 32; const int mat = r % 2, e = r / 2;
            const float* src = (mat ? a.w_up : a.w_gate) + ((size_t)l * 16 + e) * 2048 * 512;
            cvt_item(src, 512, kb * 64, fb * 64, 512, W1, 2048, e * 1024 + (fb >> 1) * 256 + (fb & 1) * 64 + mat * 16, kb * 64, true, 1.f, scr, lane); continue; } r -= I_W1;
        { const int nb = r % 32; r /= 32; const int kb = r % 8, e = r / 8;
            const float* src = a.w_down + ((size_t)l * 16 + e) * 512 * 2048;
            cvt_item(src, 2048, kb * 64, nb * 64, 2048, W2, 512, e * 2048 + nb * 64, kb * 64, false, 1.f, scr, lane); }
    }
}

__constant__ float c_invfreq[16] = {1.0f, 0.5623413f, 0.31622776f, 0.17782794f, 0.1f, 0.056234132f, 0.031622775f, 0.017782794f, 0.01f, 0.0056234132f, 0.0031622776f, 0.0017782794f, 0.001f, 0.00056234133f, 0.00031622776f, 0.00017782794f};
DEV void phase_rope(const Args& a, int wv) {
    float* COS = WSP(float, WS_COS); float* SIN = WSP(float, WS_SIN);
    for (int i = blockIdx.x * 512 + otid(wv); i < S_ * 16; i += gridDim.x * 512) {
        const int t = i >> 4, f = i & 15;
        const float ang = (float)a.pos[t] * c_invfreq[f];
        const double rev = (double)ang * 0.15915494309189535;
        const float fr = (float)(rev - __builtin_rint(rev));
        COS[i] = __builtin_amdgcn_cosf(fr); SIN[i] = __builtin_amdgcn_sinf(fr);
    }
}

DEV void phase_norm1(const Args& a, int l, int mode, int wv) {
    const int wid = __builtin_amdgcn_readfirstlane(otid(wv) >> 6), lane = otid(wv) & 63;
    const float* src = mode == 2 ? (const float*)a.out : a.x; const bf16_t* DLT = WSP(bf16_t, WS_XB);
    const bf16_t* YS = WSP(bf16_t, B_YS); const int* SLOTOF = WSP(int, WS_SLOTOF); bf16_t* XN = WSP(bf16_t, WS_XN);
    const float* gain = a.norm_mix + (size_t)(mode == 2 ? 0 : l) * DM;
    const int nw = gridDim.x * 8;
    for (int row0 = blockIdx.x * 8 + wid; row0 < S_; row0 += 2 * nw) {
        f32x4 v[2][8]; int sl[2][2] = {{0, 0}, {0, 0}}; const int rws[2] = {row0, row0 + nw < S_ ? row0 + nw : row0};
        if (mode != 0) {
#pragma unroll
            for (int rr = 0; rr < 2; ++rr) { sl[rr][0] = SLOTOF[rws[rr] * 2]; sl[rr][1] = SLOTOF[rws[rr] * 2 + 1]; } }
#pragma unroll
        for (int rr = 0; rr < 2; ++rr)
#pragma unroll
            for (int i = 0; i < 8; ++i) v[rr][i] = (mode == 0) ? __builtin_nontemporal_load((const f32x4*)(src + (size_t)rws[rr] * DM + (i * 64 + lane) * 4)) : ld_h4nt(src, DLT, (size_t)rws[rr] * DM + (i * 64 + lane) * 4);
        if (mode != 0) {
#pragma unroll
            for (int rr = 0; rr < 2; ++rr) { const int row = rws[rr];
#pragma unroll
                for (int i = 0; i < 8; ++i) { const u32x2 y0 = __builtin_nontemporal_load((const u32x2*)(YS + (size_t)sl[rr][0] * DM + (i * 64 + lane) * 4)), y1 = __builtin_nontemporal_load((const u32x2*)(YS + (size_t)sl[rr][1] * DM + (i * 64 + lane) * 4));
                    v[rr][i][0] += __uint_as_float(y0.x << 16) + __uint_as_float(y1.x << 16); v[rr][i][1] += __uint_as_float(y0.x & 0xffff0000u) + __uint_as_float(y1.x & 0xffff0000u);
                    v[rr][i][2] += __uint_as_float(y0.y << 16) + __uint_as_float(y1.y << 16); v[rr][i][3] += __uint_as_float(y0.y & 0xffff0000u) + __uint_as_float(y1.y & 0xffff0000u);
                    if (mode == 2) __builtin_nontemporal_store(v[rr][i], (f32x4*)(a.out + (size_t)row * DM + (i * 64 + lane) * 4)); else *(f32x4*)(a.out + (size_t)row * DM + (i * 64 + lane) * 4) = v[rr][i]; } } }
        if (mode == 2) continue;
#pragma unroll
        for (int rr = 0; rr < 2; ++rr) { const int row = rws[rr]; float ss = 0.f;
#pragma unroll
            for (int i = 0; i < 8; ++i) ss += (v[rr][i][0] * v[rr][i][0] + v[rr][i][1] * v[rr][i][1]) + (v[rr][i][2] * v[rr][i][2] + v[rr][i][3] * v[rr][i][3]);
            const float rstd = rsqrtf(wave_sum(ss) * (1.f / DM) + EPS);
#pragma unroll
            for (int i = 0; i < 8; ++i) { const f32x4 g = *(const f32x4*)(gain + (i * 64 + lane) * 4); u32x2 o;
                o.x = cvtpk(v[rr][i][0] * rstd * g[0], v[rr][i][1] * rstd * g[1]); o.y = cvtpk(v[rr][i][2] * rstd * g[2], v[rr][i][3] * rstd * g[3]);
                *(u32x2*)(XN + (size_t)row * DM + (i * 64 + lane) * 4) = o; } }
    }
}

DEV float logsigmoidf(float x) { return fminf(x, 0.f) - __logf(1.f + __expf(-fabsf(x))); }

DEV void phase_p3a(const Args& a, int l, int wv) {
    const int wid = __builtin_amdgcn_readfirstlane(otid(wv) >> 6), lane = otid(wv) & 63, l16 = lane & 15;
    const bf16_t* PROJ = WSP(bf16_t, A_PROJ); bf16_t* CQKV = WSP(bf16_t, A_CQKV); bf16_t* UC = WSP(bf16_t, A_UC);
    float* KR = WSP(float, WS_KR); float* GLI = WSP(float, WS_GLI); float* GLF = WSP(float, WS_GLF);
    const float* COS = WSP(float, WS_COS); const float* SIN = WSP(float, WS_SIN);
    const float* gcq = a.g_cq + l * 384; const float* gckv = a.g_ckv + l * 128; const float* cw = a.conv_w + (size_t)l * 5 * 768; const float* cb = a.conv_b + l * 768; const float* gb = a.gate_bias + l * 16;
    float2 wcv[6][5], bv[6], gq2[3], gk2;
#pragma unroll
    for (int i = 0; i < 6; ++i) { const int ch = 2 * lane + 128 * i; bv[i] = *(const float2*)(cb + ch);
#pragma unroll
        for (int j = 0; j < 5; ++j) wcv[i][j] = *(const float2*)(cw + j * 768 + ch); }
#pragma unroll
    for (int i = 0; i < 3; ++i) gq2[i] = *(const float2*)(gcq + 2 * lane + 128 * i);
    gk2 = *(const float2*)(gckv + 2 * lane);
    const float gbias = gb[l16];
    for (int t = blockIdx.x * 8 + wid; t < S_; t += gridDim.x * 8) {
        const bf16_t* pr = PROJ + (size_t)t * CINP;
        float2 cq[3], u[6][5];
#pragma unroll
        for (int i = 0; i < 3; ++i) cq[i] = ld_bf2(pr + OFF_CQ + 2 * lane + 128 * i);
        const float2 ck = ld_bf2(pr + OFF_CKV + 2 * lane);
        const float x1 = bf2f(pr[OFF_KR + l16]), x2 = bf2f(pr[OFF_KR + 16 + l16]), cs = COS[t * 16 + l16], sn = SIN[t * 16 + l16];
        const float pre = bf2f(pr[OFF_MG + l16]) + gbias;
#pragma unroll
        for (int j = 0; j < 5; ++j) { const int tt = t + j - 2, tc = tt < 0 ? 0 : (tt >= S_ ? S_ - 1 : tt);
#pragma unroll
            for (int i = 0; i < 6; ++i) u[i][j] = ld_bf2(PROJ + (size_t)tc * CINP + OFF_MU + 2 * lane + 128 * i); }
        { float ss = 0.f;
#pragma unroll
          for (int i = 0; i < 3; ++i) ss += cq[i].x * cq[i].x + cq[i].y * cq[i].y;
          const float rq = rsqrtf(wave_sum(ss) * (1.f / 384.f) + EPS);
#pragma unroll
          for (int i = 0; i < 3; ++i) st_bf2(CQKV + (size_t)t * 512 + 2 * lane + 128 * i, cq[i].x * rq * gq2[i].x, cq[i].y * rq * gq2[i].y); }
        { const float rk = rsqrtf(wave_sum(ck.x * ck.x + ck.y * ck.y) * (1.f / 128.f) + EPS);
          st_bf2(CQKV + (size_t)t * 512 + 384 + 2 * lane, ck.x * rk * gk2.x, ck.y * rk * gk2.y); }
        if (lane < 16) { KR[t * 32 + lane] = x1 * cs - x2 * sn; KR[t * 32 + 16 + lane] = x1 * sn + x2 * cs; }
#pragma unroll
        for (int i = 0; i < 6; ++i) { float a0 = bv[i].x, a1 = bv[i].y;
#pragma unroll
            for (int j = 0; j < 5; ++j) { const int tt = t + j - 2; const float ok = (tt >= 0 && tt < S_) ? 1.f : 0.f; a0 += ok * u[i][j].x * wcv[i][j].x; a1 += ok * u[i][j].y * wcv[i][j].y; }
            a0 = a0 / (1.f + __expf(-a0)); a1 = a1 / (1.f + __expf(-a1));
            st_bf2(UC + (size_t)t * 768 + 2 * lane + 128 * i, a0, a1); }
        if (lane < 16) { const int dir = lane >> 3, isf = (lane >> 2) & 1, hd = lane & 3;
            if (!isf) GLI[(size_t)(dir * 4 + hd) * S_ + t] = pre; else GLF[(size_t)(dir * 4 + hd) * S_ + t] = logsigmoidf(pre); }
    }
}

constexpr float MLA_QSCALE = 0.10206207261596575f * 1.4426950408889634f;
DEV void phase_p3c(const Args& a, int l, bool do_dil, int wv) {
    const int wid = __builtin_amdgcn_readfirstlane(otid(wv) >> 6), lane = otid(wv) & 63, h8 = lane >> 3, l8 = lane & 7, hh = lane >> 4, l16 = lane & 15;
    bf16_t* PROJ = WSP(bf16_t, A_PROJ); const bf16_t* RAW = WSP(bf16_t, A_RAW); bf16_t* QM = WSP(bf16_t, A_QM); bf16_t* KM = WSP(bf16_t, A_KM);
    const float* KR = WSP(float, WS_KR); const float* COS = WSP(float, WS_COS); const float* SIN = WSP(float, WS_SIN);
    const float* gq = a.g_q + l * 96; const float* gk = a.g_k + l * 96; const float* dgq = a.dg_q + l * 64; const float* dgk = a.dg_k + l * 64;
    float gqn[8], gkn[8]; float2 gq1, gq2, gk1, gk2; f32x4 dq4, dk4;
#pragma unroll
    for (int j = 0; j < 8; ++j) { gqn[j] = gq[8 * l8 + j]; gkn[j] = gk[8 * l8 + j]; }
    gq1 = *(const float2*)(gq + 64 + 2 * l8); gq2 = *(const float2*)(gq + 80 + 2 * l8); gk1 = *(const float2*)(gk + 64 + 2 * l8); gk2 = *(const float2*)(gk + 80 + 2 * l8);
    dq4 = *(const f32x4*)(dgq + 4 * l16); dk4 = *(const f32x4*)(dgk + 4 * l16);
    for (int t = blockIdx.x * 8 + wid; t < S_; t += gridDim.x * 8) {
        const bf16_t* rq = RAW + (size_t)t * 1792; bf16_t* pr = PROJ + (size_t)t * CINP;
        const u32x4 qn = *(const u32x4*)(rq + h8 * 96 + 8 * l8); const float2 qx1 = ld_bf2(rq + h8 * 96 + 64 + 2 * l8), qx2 = ld_bf2(rq + h8 * 96 + 80 + 2 * l8);
        const u32x4 kn = *(const u32x4*)(rq + 768 + h8 * 128 + 8 * l8);
        const float2 cs = *(const float2*)(COS + t * 16 + 2 * l8), sn = *(const float2*)(SIN + t * 16 + 2 * l8);
        const float2 kr1 = *(const float2*)(KR + t * 32 + 2 * l8), kr2 = *(const float2*)(KR + t * 32 + 16 + 2 * l8);
        u32x2 dq[3], dk[3];
        if (do_dil) {
#pragma unroll
            for (int ps = 0; ps < 3; ++ps) { dq[ps] = *(const u32x2*)(pr + OFF_DQ + (ps * 4 + hh) * 64 + 4 * l16); dk[ps] = *(const u32x2*)(pr + OFF_DK + (ps * 4 + hh) * 64 + 4 * l16); } }
        { float v[8];
#pragma unroll
          for (int j = 0; j < 4; ++j) { v[2 * j] = __uint_as_float(qn[j] << 16); v[2 * j + 1] = __uint_as_float(qn[j] & 0xffff0000u); }
          const float o1x = qx1.x * cs.x - qx2.x * sn.x, o1y = qx1.y * cs.y - qx2.y * sn.y, o2x = qx1.x * sn.x + qx2.x * cs.x, o2y = qx1.y * sn.y + qx2.y * cs.y;
          float ss = o1x * o1x + o1y * o1y + o2x * o2x + o2y * o2y;
#pragma unroll
          for (int j = 0; j < 8; ++j) ss += v[j] * v[j];
          ss += __shfl_xor(ss, 1); ss += __shfl_xor(ss, 2); ss += __shfl_xor(ss, 4);
          const float r = rsqrtf(ss * (1.f / 96.f) + EPS) * MLA_QSCALE;
          bf16_t* qo = QM + (size_t)t * 768 + h8 * 96; u32x4 w;
          w.x = cvtpk(v[0] * r * gqn[0], v[1] * r * gqn[1]); w.y = cvtpk(v[2] * r * gqn[2], v[3] * r * gqn[3]); w.z = cvtpk(v[4] * r * gqn[4], v[5] * r * gqn[5]); w.w = cvtpk(v[6] * r * gqn[6], v[7] * r * gqn[7]);
          *(u32x4*)(qo + 8 * l8) = w; st_bf2(qo + 64 + 2 * l8, o1x * r * gq1.x, o1y * r * gq1.y); st_bf2(qo + 80 + 2 * l8, o2x * r * gq2.x, o2y * r * gq2.y); }
        { float v[8];
#pragma unroll
          for (int j = 0; j < 4; ++j) { v[2 * j] = __uint_as_float(kn[j] << 16); v[2 * j + 1] = __uint_as_float(kn[j] & 0xffff0000u); }
          float ss = kr1.x * kr1.x + kr1.y * kr1.y + kr2.x * kr2.x + kr2.y * kr2.y;
#pragma unroll
          for (int j = 0; j < 8; ++j) ss += v[j] * v[j];
          ss += __shfl_xor(ss, 1); ss += __shfl_xor(ss, 2); ss += __shfl_xor(ss, 4);
          const float r = rsqrtf(ss * (1.f / 96.f) + EPS);
          bf16_t* ko = KM + (size_t)t * 768 + h8 * 96; u32x4 w;
          w.x = cvtpk(v[0] * r * gkn[0], v[1] * r * gkn[1]); w.y = cvtpk(v[2] * r * gkn[2], v[3] * r * gkn[3]); w.z = cvtpk(v[4] * r * gkn[4], v[5] * r * gkn[5]); w.w = cvtpk(v[6] * r * gkn[6], v[7] * r * gkn[7]);
          *(u32x4*)(ko + 8 * l8) = w; st_bf2(ko + 64 + 2 * l8, kr1.x * r * gk1.x, kr1.y * r * gk1.y); st_bf2(ko + 80 + 2 * l8, kr2.x * r * gk2.x, kr2.y * r * gk2.y); }
        if (do_dil) {
#pragma unroll
            for (int ps = 0; ps < 3; ++ps) {
                { const float x0 = __uint_as_float(dq[ps].x << 16), x1 = __uint_as_float(dq[ps].x & 0xffff0000u), x2 = __uint_as_float(dq[ps].y << 16), x3 = __uint_as_float(dq[ps].y & 0xffff0000u);
                  float ss = x0 * x0 + x1 * x1 + x2 * x2 + x3 * x3; ss += __shfl_xor(ss, 1); ss += __shfl_xor(ss, 2); ss += __shfl_xor(ss, 4); ss += __shfl_xor(ss, 8);
                  const float r = rsqrtf(ss * (1.f / 64.f) + EPS); u32x2 w; w.x = cvtpk(x0 * r * dq4[0], x1 * r * dq4[1]); w.y = cvtpk(x2 * r * dq4[2], x3 * r * dq4[3]);
                  *(u32x2*)(pr + OFF_DQ + (ps * 4 + hh) * 64 + 4 * l16) = w; }
                { const float x0 = __uint_as_float(dk[ps].x << 16), x1 = __uint_as_float(dk[ps].x & 0xffff0000u), x2 = __uint_as_float(dk[ps].y << 16), x3 = __uint_as_float(dk[ps].y & 0xffff0000u);
                  float ss = x0 * x0 + x1 * x1 + x2 * x2 + x3 * x3; ss += __shfl_xor(ss, 1); ss += __shfl_xor(ss, 2); ss += __shfl_xor(ss, 4); ss += __shfl_xor(ss, 8);
                  const float r = rsqrtf(ss * (1.f / 64.f) + EPS); u32x2 w; w.x = cvtpk(x0 * r * dk4[0], x1 * r * dk4[1]); w.y = cvtpk(x2 * r * dk4[2], x3 * r * dk4[3]);
                  *(u32x2*)(pr + OFF_DK + (ps * 4 + hh) * 64 + 4 * l16) = w; } } }
    }
}

DEV void phase_router(const Args& a, int l, int wv) {
    const int wid = __builtin_amdgcn_readfirstlane(otid(wv) >> 6), lane = otid(wv) & 63;
    const float* RS = (l == 0) ? a.x : (const float*)a.out; const bf16_t* DLT = WSP(bf16_t, WS_XB); bf16_t* HN = WSP(bf16_t, WS_XN); int* EID = WSP(int, WS_EID); float* WGT = WSP(float, WS_WGT);
    const float* gain = a.norm_ffn + (size_t)l * DM; const f32x4* WR3 = WSP(f32x4, WS_WR3); const float* bg = a.bg + l * 4; const float* be = a.be + l * 16;
    for (int row0 = (blockIdx.x * 8 + wid) * 4; row0 < S_; row0 += gridDim.x * 32) {
        float ss[4] = {0.f, 0.f, 0.f, 0.f};
#pragma unroll
        for (int i = 0; i < 8; ++i)
#pragma unroll
            for (int rr = 0; rr < 4; ++rr) { const f32x4 v = ld_h4(RS, DLT, (size_t)(row0 + rr) * DM + (i * 64 + lane) * 4); ss[rr] += (v[0] * v[0] + v[1] * v[1]) + (v[2] * v[2] + v[3] * v[3]); }
        float rstd[4];
#pragma unroll
        for (int rr = 0; rr < 4; ++rr) rstd[rr] = rsqrtf(wave_sum(ss[rr]) * (1.f / DM) + EPS);
        float lg[4][20];
#pragma unroll
        for (int rr = 0; rr < 4; ++rr)
#pragma unroll
            for (int j = 0; j < 20; ++j) lg[rr][j] = 0.f;
#pragma unroll 1
        for (int i = 0; i < 8; ++i) { const int e0 = (i * 64 + lane) * 4; const f32x4 g = *(const f32x4*)(gain + e0);
            float hn[4][4];
#pragma unroll
            for (int rr = 0; rr < 4; ++rr) { const f32x4 v = ld_h4nt(RS, DLT, (size_t)(row0 + rr) * DM + e0);
#pragma unroll
                for (int c = 0; c < 4; ++c) hn[rr][c] = v[c] * rstd[rr] * g[c];
                u32x2 o; o.x = cvtpk(hn[rr][0], hn[rr][1]); o.y = cvtpk(hn[rr][2], hn[rr][3]); *(u32x2*)(HN + (size_t)(row0 + rr) * DM + e0) = o; }
#pragma unroll
            for (int c = 0; c < 4; ++c) { const f32x4 w4 = WR3[(i * 20 + c * 5) * 64 + lane];
#pragma unroll
                for (int rr = 0; rr < 4; ++rr)
#pragma unroll
                    for (int j = 0; j < 4; ++j) lg[rr][j] += hn[rr][c] * w4[j];
#pragma unroll
                for (int q = 0; q < 4; ++q) { const f32x4 w16 = WR3[(i * 20 + c * 5 + 1 + q) * 64 + lane];
#pragma unroll
                    for (int rr = 0; rr < 4; ++rr)
#pragma unroll
                        for (int j = 0; j < 4; ++j) lg[rr][4 + q * 4 + j] += hn[rr][c] * w16[j]; } } }
#pragma unroll
        for (int rr = 0; rr < 4; ++rr)
#pragma unroll
            for (int j = 0; j < 20; ++j) lg[rr][j] = wave_sum(lg[rr][j]);
        if (lane < 4) {
            float lgs[20];
#pragma unroll
            for (int j = 0; j < 20; ++j) lgs[j] = lane == 0 ? lg[0][j] : (lane == 1 ? lg[1][j] : (lane == 2 ? lg[2][j] : lg[3][j]));
            const int row = row0 + lane;
            float gl[4]; int grp = 0; float gmax;
#pragma unroll
            for (int j = 0; j < 4; ++j) gl[j] = lgs[j] + bg[j];
            gmax = gl[0];
#pragma unroll
            for (int j = 1; j < 4; ++j) if (gl[j] > gmax) { gmax = gl[j]; grp = j; }
            float den = 0.f;
#pragma unroll
            for (int j = 0; j < 4; ++j) den += expf(gl[j] - gmax);
            const float pgrp = 1.f / den;
            float el[4];
#pragma unroll
            for (int j = 0; j < 4; ++j) { float sv = 0.f;
#pragma unroll
                for (int q = 0; q < 4; ++q) sv = (grp == q) ? (lgs[4 + q * 4 + j] + be[q * 4 + j]) : sv;
                el[j] = sv; }
            int i0 = 0; float v0 = el[0];
#pragma unroll
            for (int j = 1; j < 4; ++j) if (el[j] > v0) { v0 = el[j]; i0 = j; }
            int i1 = -1; float v1 = 0.f;
#pragma unroll
            for (int j = 0; j < 4; ++j) if (j != i0 && (i1 < 0 || el[j] > v1)) { v1 = el[j]; i1 = j; }
            const float e1 = expf(v1 - v0), inv = 1.f / (1.f + e1);
            EID[row * 2] = grp * 4 + i0; EID[row * 2 + 1] = grp * 4 + i1; WGT[row * 2] = inv * pgrp; WGT[row * 2 + 1] = e1 * inv * pgrp;
        }
    }
}

DEV void phase_lists(const Args& a, LAS char* lds, int wv) {
    if (blockIdx.x >= 16) return;
    const int e = blockIdx.x, tid = otid(wv), lane = tid & 63, wid = tid >> 6;
    LAS int* cnt = (LAS int*)lds; LAS int* ts = cnt + 16; LAS int* wtot = ts + 32;
    const int* EID = WSP(int, WS_EID); const float* WGT = WSP(float, WS_WGT); int* SLOTOF = WSP(int, WS_SLOTOF); int* PERM = WSP(int, WS_PERM); float* SLOTW = WSP(float, WS_SLOTW); int* TST = WSP(int, WS_TSTART);
    if (tid < 16) cnt[tid] = 0;
    __syncthreads();
    int mine = 0;
    for (int i = 0; i < 16; ++i) { const int t = tid * 16 + i; const int e0 = EID[t * 2], e1 = EID[t * 2 + 1];
        __hip_atomic_fetch_add(&cnt[e0], 1, __ATOMIC_RELAXED, __HIP_MEMORY_SCOPE_WORKGROUP); __hip_atomic_fetch_add(&cnt[e1], 1, __ATOMIC_RELAXED, __HIP_MEMORY_SCOPE_WORKGROUP);
        mine += (e0 == e || e1 == e) ? 1 : 0; }
    int incl = mine;
#pragma unroll
    for (int o = 1; o < 64; o <<= 1) { const int y = __shfl_up(incl, o); if (lane >= o) incl += y; }
    if (lane == 63) wtot[wid] = incl;
    __syncthreads();
    if (tid == 0) { int acc = 0; for (int j = 0; j < 16; ++j) { ts[j] = acc; acc += (cnt[j] + 255) / 256; } ts[16] = acc;
        if (e == 0) { for (int j = 0; j <= 16; ++j) TST[j] = ts[j];
            int* TL = WSP(int, WS_TILES); int n = 0;
            for (int pass = 0; pass < 2; ++pass)
                for (int j = 0; j < 16; ++j) { const int nt = ts[j + 1] - ts[j];
                    for (int t = 0; t < nt; ++t) { const int p = ts[j] + t, rows = cnt[j] - 256 * t, hf = (rows <= 128) ? 1 : 0;
                        if (pass == 0) { TL[96 + p] = j; TL[192 + p] = hf; } if (hf == pass) TL[n++] = p; } } } }
    __syncthreads();
    int base = incl - mine; for (int w = 0; w < wid; ++w) base += wtot[w];
    const int start = ts[e] * 256, n_e = cnt[e], end = ts[e + 1] * 256;
    int slot = start + base;
    for (int i = 0; i < 16; ++i) { const int t = tid * 16 + i; const int e0 = EID[t * 2], e1 = EID[t * 2 + 1];
        if (e0 == e) { PERM[slot] = t; SLOTW[slot] = WGT[t * 2]; SLOTOF[t * 2] = slot; ++slot; }
        else if (e1 == e) { PERM[slot] = t; SLOTW[slot] = WGT[t * 2 + 1]; SLOTOF[t * 2 + 1] = slot; ++slot; } }
    for (int s = start + n_e + tid; s < end; s += 512) { PERM[s] = 0; SLOTW[s] = 0.f; }
}
DEV void phase_gather(const Args& a, int wv) {
    const int wid = __builtin_amdgcn_readfirstlane(otid(wv) >> 6), lane = otid(wv) & 63;
    const int* PERM = WSP(int, WS_PERM); const bf16_t* HN = WSP(bf16_t, WS_XN); bf16_t* AP = WSP(bf16_t, B_APERM);
    const int rows = ld_agent_i(WSP(int, WS_TSTART) + 16) * 256;
    for (int r = blockIdx.x * 8 + wid; r < rows; r += gridDim.x * 8) { const int t = PERM[r];
        const u32x4* s = (const u32x4*)(HN + (size_t)t * DM); u32x4* d = (u32x4*)(AP + (size_t)r * DM);
#pragma unroll
        for (int i = 0; i < 4; ++i) d[lane + 64 * i] = s[lane + 64 * i]; }
}

DEV int v_st2(int k, int c) { const int kk = (k & ~0xC) | ((k & 4) << 1) | ((k & 8) >> 1); return ((kk >> 3) * 2 + (c >> 5)) * 512 + ((kk & 7) * 32 + (c & 31)) * 2; }
DEV int v_rd_base(int lane) { return ((lane & 3) << 3) | (((lane >> 2) & 3) << 6) | (((lane >> 4) & 1) << 5) | (((lane >> 5) & 1) << 8); }
template <int OFF> DEV s16x4 tr_read(int vb) { s16x4 r; asm volatile("ds_read_b64_tr_b16 %0, %1 offset:%2" : "=&v"(r) : "v"(vb), "i"(OFF) : "memory"); return r; }
template <int OFF> DEV s16x4 tr_rd(const LAS char* b) { return __builtin_amdgcn_ds_read_tr16_b64_v4i16((LAS s16x4*)(b + OFF)); }
#define PKV(L, H) (bf16x8){L[0], L[1], L[2], L[3], H[0], H[1], H[2], H[3]}

namespace mla {
constexpr int LDQ = 768, LDK = 768, LDV = 1792, LDO = 2048, KVBLK = 64, QBLK = 32;
constexpr float SCALE = 0.10206207261596575f, THR = 8.f;
constexpr int SHM_V = 8192, SHM_K = 16384;
#define KSWZ(row, colB) ((row) * 256 + ((colB) ^ (((row) & 15) << 4)))
template <bool NOMAX, int PRB = 0, bool EXPDONE = false> DEV void partialSM(f32x16& p0, f32x16& p1, float& m_reg, float& mn, float& alpha) {
  if constexpr (NOMAX) {
    mn = 0.f; alpha = 1.f;
    if constexpr (PRB != 2 && !EXPDONE) {
#pragma unroll
    for (int r = 0; r < 16; ++r) p0[r] = __builtin_amdgcn_exp2f(p0[r]); }
    return;
  }
  float pmax = p0[0];
#pragma unroll
  for (int r = 1; r < 16; ++r) pmax = fmaxf(pmax, p0[r]);
#pragma unroll
  for (int r = 0; r < 16; ++r) pmax = fmaxf(pmax, p1[r]);
  { auto rr = __builtin_amdgcn_permlane32_swap(__float_as_uint(pmax), __float_as_uint(pmax), false, false);
    pmax = fmaxf(__uint_as_float(rr[0]), __uint_as_float(rr[1])); }
  if (__builtin_expect(__all(pmax - m_reg <= THR * LOG2E), 1)) { mn = m_reg; alpha = 1.f; }
  else { mn = fmaxf(m_reg, pmax); alpha = __builtin_amdgcn_exp2f(m_reg - mn); m_reg = mn; }
#pragma unroll
  for (int r = 0; r < 16; ++r) p0[r] = p0[r] - mn;
#pragma unroll
  for (int r = 0; r < 16; ++r) p1[r] = p1[r] - mn;
#pragma unroll
  for (int r = 0; r < 16; ++r) p0[r] = __builtin_amdgcn_exp2f(p0[r]);
}
DEV void finishSM(f32x16& p0, f32x16& p1, float alpha, float& l_reg, bf16x8& pa0, bf16x8& pa1, bf16x8& pa2, bf16x8& pa3) {
#pragma unroll
  for (int r = 0; r < 16; ++r) p1[r] = __builtin_amdgcn_exp2f(p1[r]);
  f32x2 ps2 = {0.f, 0.f};
#pragma unroll
  for (int r = 0; r < 16; r += 2) ps2 += mk2(p0[r], p0[r + 1]);
#pragma unroll
  for (int r = 0; r < 16; r += 2) ps2 += mk2(p1[r], p1[r + 1]);
  float ps = ps2[0] + ps2[1];
  { auto rr = __builtin_amdgcn_permlane32_swap(__float_as_uint(ps), __float_as_uint(ps), false, false);
    ps = __uint_as_float(rr[0]) + __uint_as_float(rr[1]); }
  l_reg = l_reg * alpha + ps;
  PK4(p0, 0, pa0); PK4(p0, 8, pa1); PK4(p1, 0, pa2); PK4(p1, 8, pa3);
}
DEV void qkt(f32x16& p0, f32x16& p1, const LAS char* Ks, const bf16x8* qr, int r32, int hi) {
  p0 = f32x16{}; p1 = f32x16{};
  bf16x8 b0 = *(const LAS bf16x8*)(Ks + KSWZ(r32, hi * 16)), b1 = *(const LAS bf16x8*)(Ks + KSWZ(32 + r32, hi * 16));
#pragma unroll
  for (int d0 = 0; d0 < 6; ++d0) {
    bf16x8 n0 = b0, n1 = b1;
    if (d0 + 1 < 6) { const int cb = ((d0 + 1) * 16 + hi * 8) * 2; n0 = *(const LAS bf16x8*)(Ks + KSWZ(r32, cb)); n1 = *(const LAS bf16x8*)(Ks + KSWZ(32 + r32, cb)); }
    SBAR();
    p0 = MFMA32(b0, qr[d0], p0); p1 = MFMA32(b1, qr[d0], p1);
    SBAR();
    b0 = n0; b1 = n1; }
}
template <int PRB = 0> DEV void qkt_fin(f32x16& n0, f32x16& n1, const LAS char* Ks, const bf16x8* qr, int r32, int hi, bf16x8 b0, bf16x8 b1,
                 f32x16& p0, f32x16& p1, float alpha, float& l_reg, bf16x8& pa0, bf16x8& pa1, bf16x8& pa2, bf16x8& pa3) {
  n0 = f32x16{}; n1 = f32x16{};
  bf16x8 c0, c1;
  f32x2 ps2; float ps;
#define QF_STEP(D0, CUR0, CUR1, NXT0, NXT1, WORK) do { \
    if ((D0) + 1 < 6) { const int cb_ = (((D0) + 1) * 16 + hi * 8) * 2; NXT0 = *(const LAS bf16x8*)(Ks + KSWZ(r32, cb_)); NXT1 = *(const LAS bf16x8*)(Ks + KSWZ(32 + r32, cb_)); } \
    SBAR(); if constexpr (PRB != 5) { n0 = MFMA32(CUR0, qr[D0], n0); n1 = MFMA32(CUR1, qr[D0], n1); } else { asm volatile("" :: "v"(CUR0), "v"(CUR1)); } WORK; SBAR(); } while (0)
  QF_STEP(0, b0, b1, c0, c1, { _Pragma("unroll") for (int r = 0; r < 6; ++r) p1[r] = (PRB == 2) ? p1[r] : __builtin_amdgcn_exp2f(p1[r]); });
  QF_STEP(1, c0, c1, b0, b1, { _Pragma("unroll") for (int r = 6; r < 12; ++r) p1[r] = (PRB == 2) ? p1[r] : __builtin_amdgcn_exp2f(p1[r]); });
  QF_STEP(2, b0, b1, c0, c1, { _Pragma("unroll") for (int r = 12; r < 16; ++r) p1[r] = (PRB == 2) ? p1[r] : __builtin_amdgcn_exp2f(p1[r]); ps2 = mk2(p0[0], p0[1]); _Pragma("unroll") for (int r = 2; r < 8; r += 2) ps2 += mk2(p0[r], p0[r + 1]); });
  QF_STEP(3, c0, c1, b0, b1, { _Pragma("unroll") for (int r = 8; r < 16; r += 2) ps2 += mk2(p0[r], p0[r + 1]); _Pragma("unroll") for (int r = 0; r < 8; r += 2) ps2 += mk2(p1[r], p1[r + 1]); });
  QF_STEP(4, b0, b1, c0, c1, { _Pragma("unroll") for (int r = 8; r < 16; r += 2) ps2 += mk2(p1[r], p1[r + 1]); ps = ps2[0] + ps2[1];
      { auto rr = __builtin_amdgcn_permlane32_swap(__float_as_uint(ps), __float_as_uint(ps), false, false); ps = __uint_as_float(rr[0]) + __uint_as_float(rr[1]); }
      l_reg = l_reg * alpha + ps; PK4(p0, 0, pa0); PK4(p0, 8, pa1); });
  QF_STEP(5, c0, c1, b0, b1, { PK4(p1, 0, pa2); PK4(p1, 8, pa3); });
#undef QF_STEP
}
constexpr int v_rd_off(int d0, int ks, int half) { return d0 * 512 + ks * 2048 + half * 1024; }
template <int D0, int BO = 0, int PRB = 0> DEV void pv_one(f32x16& od, int vb, bf16x8 pa0, bf16x8 pa1, bf16x8 pa2, bf16x8 pa3) {
  const s16x4 l0 = tr_read<BO + v_rd_off(D0, 0, 0)>(vb), h0 = tr_read<BO + v_rd_off(D0, 0, 1)>(vb), l1 = tr_read<BO + v_rd_off(D0, 1, 0)>(vb), h1 = tr_read<BO + v_rd_off(D0, 1, 1)>(vb);
  const s16x4 l2 = tr_read<BO + v_rd_off(D0, 2, 0)>(vb), h2 = tr_read<BO + v_rd_off(D0, 2, 1)>(vb), l3 = tr_read<BO + v_rd_off(D0, 3, 0)>(vb), h3 = tr_read<BO + v_rd_off(D0, 3, 1)>(vb);
  asm volatile("s_waitcnt lgkmcnt(0)" ::: "memory"); SBAR();
  if constexpr (PRB != 5) { od = MFMA32(pa0, PKV(l0, h0), od); od = MFMA32(pa1, PKV(l1, h1), od); od = MFMA32(pa2, PKV(l2, h2), od); od = MFMA32(pa3, PKV(l3, h3), od); }
  else asm volatile("" :: "v"(l0), "v"(h0), "v"(l1), "v"(h1), "v"(l2), "v"(h2), "v"(l3), "v"(h3), "v"(pa0), "v"(pa1), "v"(pa2), "v"(pa3));
}
#define KFR(Ks_, D_, A_, B_) do { const int cb_ = ((D_) * 16 + hi * 8) * 2; A_ = *(const LAS bf16x8*)((Ks_) + KSWZ(r32, cb_)); B_ = *(const LAS bf16x8*)((Ks_) + KSWZ(32 + r32, cb_)); } while (0)
#define VRD8(VF, D0, BO) do { VF[0] = tr_rd<(BO) + v_rd_off(D0, 0, 0)>(vbp); VF[1] = tr_rd<(BO) + v_rd_off(D0, 0, 1)>(vbp); VF[2] = tr_rd<(BO) + v_rd_off(D0, 1, 0)>(vbp); VF[3] = tr_rd<(BO) + v_rd_off(D0, 1, 1)>(vbp); \
    VF[4] = tr_rd<(BO) + v_rd_off(D0, 2, 0)>(vbp); VF[5] = tr_rd<(BO) + v_rd_off(D0, 2, 1)>(vbp); VF[6] = tr_rd<(BO) + v_rd_off(D0, 3, 0)>(vbp); VF[7] = tr_rd<(BO) + v_rd_off(D0, 3, 1)>(vbp); } while (0)
template <int PRB, int VBO> DEV void qkt_fin2(f32x16& n0, f32x16& n1, const LAS char* Ks, const bf16x8* qr, int r32, int hi, bf16x8 f0a, bf16x8 f0b, bf16x8 f1a, bf16x8 f1b, const LAS char* vbp, s16x4* vf0,
                 f32x16& p0, f32x16& p1, float alpha, float& l_reg, bf16x8& pa0, bf16x8& pa1, bf16x8& pa2, bf16x8& pa3) {
  n0 = f32x16{}; n1 = f32x16{};
  bf16x8 ga = f0a, gb = f0b; f32x2 ps2; float ps;
#define QF2(D0, CA, CB, NA, NB, PRE, WA, WB) do { if constexpr (PRB < 7) { if ((D0) + 2 < 6) KFR(Ks, (D0) + 2, NA, NB); PRE; } else { asm volatile("" : "+v"(NA), "+v"(NB)); } \
    SBAR(); if constexpr (PRB != 5) n0 = MFMA32(CA, qr[D0], n0); else asm volatile("" :: "v"(CA)); WA; SBAR(); \
    if constexpr (PRB != 5) n1 = MFMA32(CB, qr[D0], n1); else asm volatile("" :: "v"(CB)); WB; SBAR(); } while (0)
#define EX_(r) p1[r] = (PRB == 2 || PRB == 8) ? p1[r] : __builtin_amdgcn_exp2f(p1[r])
  QF2(0, f0a, f0b, ga, gb, {}, { EX_(0); EX_(1); EX_(2); }, { EX_(3); EX_(4); EX_(5); });
  QF2(1, f1a, f1b, f0a, f0b, { VRD8(vf0, 0, VBO); }, { EX_(6); EX_(7); EX_(8); }, { EX_(9); EX_(10); EX_(11); });
  QF2(2, ga, gb, f1a, f1b, {}, { EX_(12); EX_(13); EX_(14); EX_(15); }, { ps2 = mk2(p0[0], p0[1]); _Pragma("unroll") for (int r = 2; r < 8; r += 2) ps2 += mk2(p0[r], p0[r + 1]); });
  QF2(3, f0a, f0b, ga, gb, {}, { _Pragma("unroll") for (int r = 8; r < 16; r += 2) ps2 += mk2(p0[r], p0[r + 1]); }, { _Pragma("unroll") for (int r = 0; r < 8; r += 2) ps2 += mk2(p1[r], p1[r + 1]); });
  QF2(4, f1a, f1b, f0a, f0b, {}, { _Pragma("unroll") for (int r = 8; r < 16; r += 2) ps2 += mk2(p1[r], p1[r + 1]); ps = ps2[0] + ps2[1];
      { auto rr = __builtin_amdgcn_permlane32_swap(__float_as_uint(ps), __float_as_uint(ps), false, false); ps = __uint_as_float(rr[0]) + __uint_as_float(rr[1]); }
      l_reg = l_reg * alpha + ps; }, { PK4(p0, 0, pa0); PK4(p0, 8, pa1); });
  QF2(5, ga, gb, f0a, f0b, {}, { PK4(p1, 0, pa2); }, { PK4(p1, 8, pa3); });
#undef QF2
#undef EX_
}
template <bool NOMAX, int PRB, int VBO> DEV void pv2(f32x16& o0, f32x16& o1, const LAS char* vbp, const s16x4* vf0, bf16x8 pa0, bf16x8 pa1, bf16x8 pa2, bf16x8 pa3, f32x16& pn0) {
  s16x4 vf1[8]; if constexpr (PRB < 7) { VRD8(vf1, 1, VBO); } else { _Pragma("unroll") for (int i = 0; i < 8; ++i) { vf1[i] = vf0[i]; asm volatile("" : "+v"(vf1[i])); } }
#define EX2(r) do { if constexpr (NOMAX && PRB != 2 && PRB != 8) { pn0[r] = __builtin_amdgcn_exp2f(pn0[r]); pn0[(r) + 1] = __builtin_amdgcn_exp2f(pn0[(r) + 1]); } } while (0)
#define PVM(OD, PA, L, H, R) do { SBAR(); if constexpr (PRB != 5) OD = MFMA32(PA, PKV(L, H), OD); else asm volatile("" :: "v"(L), "v"(H), "v"(PA)); EX2(R); SBAR(); } while (0)
  PVM(o0, pa0, vf0[0], vf0[1], 0); PVM(o0, pa1, vf0[2], vf0[3], 2); PVM(o0, pa2, vf0[4], vf0[5], 4); PVM(o0, pa3, vf0[6], vf0[7], 6);
  PVM(o1, pa0, vf1[0], vf1[1], 8); PVM(o1, pa1, vf1[2], vf1[3], 10); PVM(o1, pa2, vf1[4], vf1[5], 12); PVM(o1, pa3, vf1[6], vf1[7], 14);
#undef PVM
#undef EX2
}
template <bool NOMAX, int PRB = 0> DEV void attn_unit(const bf16_t* __restrict__ Qb, const bf16_t* __restrict__ Kh, const bf16_t* __restrict__ Vh, bf16_t* __restrict__ Ob, int seq, LAS char* lds, int wv) {
  const int tid = otid(wv), wid = tid >> 6, lane = tid & 63, r32 = lane & 31, hi = lane >> 5;
  LAS char* K_lds = lds; LAS char* V_lds = lds + 4 * SHM_K;
  LAS float* ws = (LAS float*)(lds + 4 * SHM_V + 4 * SHM_K) + wid * 64; LAS float* li_l = ws; LAS float* al_l = ws + 32;
  float m_reg = -1e30f, l_reg = 0; f32x16 o[2] = {}; bf16x8 qr[6];
  const bf16_t* Qw = Qb + (long)(wid * QBLK + r32) * LDQ + hi * 8;
#pragma unroll
  for (int d0 = 0; d0 < 6; ++d0) qr[d0] = *reinterpret_cast<const bf16x8*>(Qw + d0 * 16);
  const int vrow = tid >> 3, vc8 = (tid & 7) * 8, kc1 = tid, kc2 = 512 + (tid & 255);
  const int kr1 = kc1 / 12, kch1 = kc1 % 12, kr2 = kc2 / 12, kch2 = kc2 % 12;
  const int vst = v_st2(vrow, vc8), kst1 = KSWZ(kr1, kch1 * 16), kst2 = KSWZ(kr2, kch2 * 16);
  const bf16_t* vsrc = Vh + (long)vrow * LDV + vc8; const bf16_t* ksrc1 = Kh + (long)kr1 * LDK + kch1 * 8; const bf16_t* ksrc2 = Kh + (long)kr2 * LDK + kch2 * 8;
  const int vb0 = (int)(unsigned)(uintptr_t)V_lds + v_rd_base(lane);
  struct { bf16x8 vs, k1, k2; } sr_[2];
  const __amdgpu_buffer_rsrc_t rsK = __builtin_amdgcn_make_buffer_rsrc((void*)Kh, (short)0, 0x40000000, 0x00020000), rsV = __builtin_amdgcn_make_buffer_rsrc((void*)Vh, (short)0, 0x40000000, 0x00020000);
  const int vgo = (vrow * LDV + vc8) * 2, kgo1 = (kr1 * LDK + kch1 * 8) * 2, kgo2 = (kr2 * LDK + kch2 * 8) * 2;
#define SLOAD(i, t_) do { sr_[i].vs = __builtin_bit_cast(bf16x8, __builtin_amdgcn_raw_buffer_load_b128(rsV, vgo, (t_) * (KVBLK * LDV * 2), 0)); \
    sr_[i].k1 = __builtin_bit_cast(bf16x8, __builtin_amdgcn_raw_buffer_load_b128(rsK, kgo1, (t_) * (KVBLK * LDK * 2), 0)); sr_[i].k2 = __builtin_bit_cast(bf16x8, __builtin_amdgcn_raw_buffer_load_b128(rsK, kgo2, (t_) * (KVBLK * LDK * 2), 0)); } while (0)
#define SWRITE(b, i) do { *(LAS bf16x8*)(V_lds + (b) * SHM_V + vst) = sr_[i].vs; *(LAS bf16x8*)(K_lds + (b) * SHM_K + kst1) = sr_[i].k1; *(LAS bf16x8*)(K_lds + (b) * SHM_K + kst2) = sr_[i].k2; } while (0)
#define SWAIT() asm volatile("s_waitcnt vmcnt(3)" ::: "memory")
#define RESC(a_) do { if (!NOMAX && __any((a_) < 1.f)) { if (hi == 0) al_l[r32] = (a_); asm volatile("s_waitcnt lgkmcnt(0)" ::: "memory"); \
    _Pragma("unroll") for (int d = 0; d < 2; ++d) _Pragma("unroll") for (int r = 0; r < 16; ++r) o[d][r] *= al_l[crow(r, hi)]; } } while (0)
#define PVD(B_) do { pv_one<0, (B_) * SHM_V, PRB>(o[0], vb0, pa0, pa1, pa2, pa3); pv_one<1, (B_) * SHM_V, PRB>(o[1], vb0, pa0, pa1, pa2, pa3); } while (0)
  f32x16 pA0, pA1, pB0, pB1; float mnA, mnB, alA, alB; bf16x8 pa0, pa1, pa2, pa3; constexpr int NT = S_ / KVBLK;
  constexpr int SE = 0, SO = 1;
  SLOAD(SE, 0); asm volatile("s_waitcnt vmcnt(0)" ::: "memory"); SWRITE(0, SE); __syncthreads();
  qkt(pA0, pA1, K_lds, qr, r32, hi); partialSM<NOMAX>(pA0, pA1, m_reg, mnA, alA);
  SLOAD(SO, 1); SLOAD(SE, 2);
  asm volatile("s_waitcnt vmcnt(0)" ::: "memory"); SWRITE(1, SO); SWRITE(2, SE);
  SLOAD(SO, 3);
  __syncthreads();
  const LAS char* vbp = V_lds + v_rd_base(lane);
#define KPRE(buf) do { KFR(K_lds + (buf) * SHM_K, 0, pre0, pre1); KFR(K_lds + (buf) * SHM_K, 1, pre2, pre3); } while (0)
  bf16x8 pre0, pre1, pre2, pre3; KPRE(1);
  s16x4 vf0[8];
#define HALF(T, BP, BC, B1, BW, PN0, PN1, PO0, PO1, MNN, ALN, ALO, SL, SW, DOLOAD, DOWRITE) do { \
    SBAR(); qkt_fin2<PRB, (BP) * SHM_V>(PN0, PN1, K_lds + (BC) * SHM_K, qr, r32, hi, pre0, pre1, pre2, pre3, vbp, vf0, PO0, PO1, ALO, l_reg, pa0, pa1, pa2, pa3); SBAR(); \
    if (DOLOAD && PRB != 4 && PRB < 7) SLOAD(SL, (T) + 3); SBAR(); \
    pv2<NOMAX, PRB, (BP) * SHM_V>(o[0], o[1], vbp, vf0, pa0, pa1, pa2, pa3, PN0); partialSM<NOMAX, PRB, true>(PN0, PN1, m_reg, MNN, ALN); \
    if constexpr (PRB < 7) { SWAIT(); if (DOWRITE && PRB != 4) SWRITE(BW, SW); KPRE(B1); } \
    RESC(ALN); if constexpr (PRB != 3 && PRB < 7) __syncthreads(); } while (0)
  static_assert(NT % 4 == 0 && NT >= 8, "tile loop is unrolled by four");
  for (int j = 1; j + 6 < NT; j += 4) {
    HALF(j,     0, 1, 2, 3, pB0, pB1, pA0, pA1, mnB, alB, alA, SE, SO, true, true);
    HALF(j + 1, 1, 2, 3, 0, pA0, pA1, pB0, pB1, mnA, alA, alB, SO, SE, true, true);
    HALF(j + 2, 2, 3, 0, 1, pB0, pB1, pA0, pA1, mnB, alB, alA, SE, SO, true, true);
    HALF(j + 3, 3, 0, 1, 2, pA0, pA1, pB0, pB1, mnA, alA, alB, SO, SE, true, true);
  }
  HALF(NT - 3, 0, 1, 2, 3, pB0, pB1, pA0, pA1, mnB, alB, alA, SE, SO, false, true);
  HALF(NT - 2, 1, 2, 3, 0, pA0, pA1, pB0, pB1, mnA, alA, alB, SO, SE, false, false);
  SBAR(); qkt(pB0, pB1, K_lds + 3 * SHM_K, qr, r32, hi);
  finishSM(pA0, pA1, alA, l_reg, pa0, pa1, pa2, pa3); SBAR();
  PVD(2); partialSM<NOMAX>(pB0, pB1, m_reg, mnB, alB);
  RESC(alB);
  finishSM(pB0, pB1, alB, l_reg, pa0, pa1, pa2, pa3); SBAR();
  PVD(3);
#undef HALF
#undef KPRE
  if constexpr (PRB != 0) { asm volatile("" :: "v"(o[0]), "v"(o[1]), "v"(l_reg)); __syncthreads(); return; }
  if (hi == 0) li_l[r32] = l_reg; asm volatile("s_waitcnt lgkmcnt(0)" ::: "memory");
  float rli[16];
#pragma unroll
  for (int r = 0; r < 16; ++r) rli[r] = __builtin_amdgcn_rcpf(li_l[crow(r, hi)]);
  bf16_t* Ow = Ob + (long)(wid * QBLK) * LDO;
#pragma unroll
  for (int r = 0; r < 16; ++r) { const int orow = crow(r, hi);
#pragma unroll
    for (int d0 = 0; d0 < 2; ++d0) Ow[(long)orow * LDO + d0 * 32 + r32] = f2bf(o[d0][r] * rli[r]); }
  __syncthreads();
#undef SLOAD
#undef SWRITE
#undef SWAIT
#undef RESC
#undef PVD
}
DEV bool bound_ok(const float* gq, const float* gk, int lane) {
  float bq = fmaxf(fabsf(gq[lane]), lane < 32 ? fabsf(gq[64 + lane]) : 0.f), bk = fmaxf(fabsf(gk[lane]), lane < 32 ? fabsf(gk[64 + lane]) : 0.f);
#pragma unroll
  for (int o = 1; o < 64; o <<= 1) { bq = fmaxf(bq, __shfl_xor(bq, o)); bk = fmaxf(bk, __shfl_xor(bk, o)); }
  return 9.797958971f * bq * bk * 1.01f * LOG2E <= 64.f;
}
}

DEV int kswz128(int row, int cb) { return row * 128 + (cb ^ (((row >> 1) & 7) << 4)); }
struct DilU { int p, hd, res, B, d, nsub; };
DEV DilU dil_decode(int u) { DilU x; x.p = u / 384; const int v = u % 384, w = v % 32; x.hd = v / 32; const int nb = (x.p == 0) ? 32 : (x.p == 1 ? 8 : 2);
  x.res = w / nb; x.B = w % nb; x.d = (x.p == 0) ? 1 : (x.p == 1 ? 4 : 16); x.nsub = S_ / x.d; return x; }
DEV void dil_load(const bf16_t* PROJ, const DilU& x, int tid, u32x4 (&st)[12]) {
  const int r0 = tid >> 4, ch = tid & 15, j0 = 256 * x.B - 64 + r0;
  const int col = (ch < 8) ? (OFF_DK + x.hd * 64 + ch * 8) : (OFF_DV + x.hd * 64 + (ch - 8) * 8);
  const bf16_t* gp = PROJ + ((long)x.res + (long)x.d * j0) * CINP + col; const long gs = (long)32 * x.d * CINP;
#pragma unroll
  for (int i = 0; i < 12; ++i) { const int jj = j0 + 32 * i; u32x4 v = zero4(); if (jj >= 0 && jj < x.nsub) v = *(const u32x4*)(gp + i * gs); st[i] = v; }
}
DEV void dil_loadq(const bf16_t* PROJ, const DilU& x, int wid, int r32, int hi, bf16x8 (&qr)[4]) {
  const long tokq = (long)x.res + (long)x.d * (256 * x.B + 32 * wid + r32);
#pragma unroll
  for (int d0 = 0; d0 < 4; ++d0) qr[d0] = *reinterpret_cast<const bf16x8*>(PROJ + tokq * CINP + OFF_DQ + x.hd * 64 + d0 * 16 + hi * 8);
}
DEV void phase_dilated(const Args& a, LAS char* lds, int wv) {
  const int tid = otid(wv), wid = tid >> 6, lane = tid & 63, r32 = lane & 31, hi = lane >> 5; const int G = gridDim.x;
  const bf16_t* PROJ = WSP(bf16_t, A_PROJ);
  LAS char* KI = lds; LAS char* VI = lds + 49152; LAS float* wsf = (LAS float*)(lds + 98304) + wid * 64; LAS float* biasall = (LAS float*)(lds + 98304 + 2048); LAS float* bshift = (LAS float*)(lds + 98304 + 2048 + 19008);
  for (int i = tid; i < 36 * 129; i += 512) { const int ph = i / 129, k = i % 129; biasall[ph * 132 + k] = a.rel_bias[(int)c_bucket[ph / 12][k] * 12 + (ph % 12)] * LOG2E; }
  int u = blockIdx.x; if (u >= 1152) return;
  u32x4 st[12];
  { const DilU x0 = dil_decode(u); dil_load(PROJ, x0, tid, st); }
  for (; u < 1152; u += G) {
    const DilU x = dil_decode(u); const int p = x.p, hd = x.hd, res = x.res, B = x.B, d = x.d, nsub = x.nsub;
    bf16_t* DPART = WSP(bf16_t, A_DPART) + (size_t)p * S_ * 768; float* DLSE = WSP(float, A_DLSE) + (size_t)p * S_ * 12;
    bf16x8 qr[4]; dil_loadq(PROJ, x, wid, r32, hi, qr);
    { const LAS float* bsrc = biasall + (p * 12 + hd) * 132;
      for (int i = tid; i < 800; i += 512) { const int sh = i / 200, j = i % 200, k = j + sh - 32; bshift[i] = ((unsigned)k <= 128u) ? bsrc[k] : 0.f; } }
    { const int r0 = tid >> 4, ch = tid & 15;
      LAS char* lb = (ch < 8) ? (KI + kswz128(r0, ch * 16)) : (VI + v_st2(r0, (ch - 8) * 8));
#pragma unroll
      for (int i = 0; i < 12; ++i) *(LAS u32x4*)(lb + i * 4096) = st[i]; }
    asm volatile("s_waitcnt lgkmcnt(0)\n\ts_barrier" ::: "memory");
    asm volatile("" : "+v"(qr[0]), "+v"(qr[1]), "+v"(qr[2]), "+v"(qr[3]));
    if (u + G < 1152) { const DilU xn = dil_decode(u + G); dil_load(PROJ, xn, tid, st); }
    const int j0 = 256 * B - 64;
    constexpr float C = 0.125f * LOG2E;
    float m, l; f32x16 o[2];
    const int vbase = (int)(unsigned)(uintptr_t)VI + v_rd_base(lane) + 2 * wid * 2048;
    for (int rp_ = 0; rp_ < ((DUP_K == 30) ? 2 : 1); ++rp_) {
    f32x16 sc[5]; bf16x8 kfa[4], kfb[4]; float mx = -INFINITY;
#define DIL_KRD(dst, kb_) do { _Pragma("unroll") for (int d0 = 0; d0 < 4; ++d0) dst[d0] = *(const LAS bf16x8*)(KI + kswz128(32 * wid + 32 * (kb_) + r32, (d0 * 16 + hi * 8) * 2)); } while (0)
#define DIL_QK(src, kb_) do { sc[kb_] = f32x16{}; _Pragma("unroll") for (int d0 = 0; d0 < 4; ++d0) sc[kb_] = MFMA32(src[d0], qr[d0], sc[kb_]); } while (0)
#define DIL_TR(kb_) do { _Pragma("unroll") for (int g = 0; g < 4; ++g) { const f32x4 bq_ = *(const LAS f32x4*)(bbase_ + (32 * (kb_) + 8 * g) * 4); \
      _Pragma("unroll") for (int e = 0; e < 4; ++e) { const int i = 4 * g + e, bi = 32 * (kb_) + 8 * g + e - rq_, jj = jq_ + 32 * (kb_) + 8 * g + e; \
        const bool valid = ((unsigned)bi <= 128u) && ((unsigned)jj < (unsigned)nsub); \
        sc[kb_][i] = fmaf(sc[kb_][i], C, bq_[e]) + (valid ? 0.f : -INFINITY); mx = fmaxf(mx, sc[kb_][i]); } } } while (0)
    int rq_ = r32 - 4 * hi, jq_ = j0 + 32 * wid + 4 * hi; asm volatile("" : "+v"(rq_), "+v"(jq_));
    const int sh_ = (32 - rq_) & 3; const LAS char* bbase_ = (const LAS char*)bshift + sh_ * 800 + (32 - rq_ - sh_) * 4;
    DIL_KRD(kfa, 0); SBAR();
    DIL_KRD(kfb, 1); DIL_QK(kfa, 0); SBAR();
    DIL_KRD(kfa, 2); DIL_QK(kfb, 1); DIL_TR(0); SBAR();
    DIL_KRD(kfb, 3); DIL_QK(kfa, 2); DIL_TR(1); SBAR();
    DIL_KRD(kfa, 4); DIL_QK(kfb, 3); DIL_TR(2); SBAR();
    DIL_QK(kfa, 4); DIL_TR(3); SBAR();
    DIL_TR(4); SBAR();
#undef DIL_KRD
#undef DIL_QK
#undef DIL_TR
    mx = fmaxf(mx, __shfl_xor(mx, 32));
    float ps = 0.f;
#pragma unroll
    for (int kb = 0; kb < 5; ++kb)
#pragma unroll
      for (int i = 0; i < 16; ++i) { sc[kb][i] = __builtin_amdgcn_exp2f(sc[kb][i] - mx); ps += sc[kb][i]; }
    ps += __shfl_xor(ps, 32);
    m = mx; l = ps; o[0] = f32x16{}; o[1] = f32x16{};
    s16x4 va[8], vb8[8];
#define DIL_VRD(dst, kb_) do { const int vb_ = vbase + (kb_) * 4096; dst[0] = tr_read<0>(vb_); dst[1] = tr_read<1024>(vb_); dst[2] = tr_read<2048>(vb_); dst[3] = tr_read<3072>(vb_); \
      dst[4] = tr_read<512>(vb_); dst[5] = tr_read<1536>(vb_); dst[6] = tr_read<2560>(vb_); dst[7] = tr_read<3584>(vb_); } while (0)
#define DIL_PV(src, kb_) do { bf16x8 pa0_, pa1_; PK4(sc[kb_], 0, pa0_); PK4(sc[kb_], 8, pa1_); \
      o[0] = MFMA32(pa0_, PKV(src[0], src[1]), o[0]); o[0] = MFMA32(pa1_, PKV(src[2], src[3]), o[0]); o[1] = MFMA32(pa0_, PKV(src[4], src[5]), o[1]); o[1] = MFMA32(pa1_, PKV(src[6], src[7]), o[1]); } while (0)
#define DIL_WAIT() do { asm volatile("s_waitcnt lgkmcnt(0)" ::: "memory"); SBAR(); } while (0)
    DIL_VRD(va, 0); DIL_WAIT(); DIL_VRD(vb8, 1); DIL_PV(va, 0); DIL_WAIT(); DIL_VRD(va, 2); DIL_PV(vb8, 1); DIL_WAIT(); DIL_VRD(vb8, 3); DIL_PV(va, 2); DIL_WAIT(); DIL_VRD(va, 4); DIL_PV(vb8, 3); DIL_WAIT(); DIL_PV(va, 4);
#undef DIL_VRD
#undef DIL_PV
#undef DIL_WAIT
    }
    if (hi == 0) wsf[32 + r32] = l; asm volatile("s_waitcnt lgkmcnt(0)" ::: "memory");
    { const long tokq = (long)res + (long)d * (256 * B + 32 * wid + r32);
      DLSE[tokq * 12 + hd] = (m + __log2f(l)) * LN2; }
#pragma unroll
    for (int r = 0; r < 16; ++r) { const int cr = crow(r, hi); const float rl = __builtin_amdgcn_rcpf(wsf[32 + cr]);
      const long tok = (long)res + (long)d * (256 * B + 32 * wid + cr);
#pragma unroll
      for (int d0 = 0; d0 < 2; ++d0) DPART[tok * 768 + hd * 64 + d0 * 32 + r32] = f2bf(o[d0][r] * rl); }
    asm volatile("s_waitcnt lgkmcnt(0)\n\ts_barrier" ::: "memory");
  }
}
DEV void phase_dilcomb(const Args& a, int wv) {
  const int wid = __builtin_amdgcn_readfirstlane(otid(wv) >> 6), lane = otid(wv) & 63;
  const bf16_t* DPART = WSP(bf16_t, A_DPART); const float* DLSE = WSP(float, A_DLSE); bf16_t* YMIX = WSP(bf16_t, A_YMIX);
  for (int t = blockIdx.x * 8 + wid; t < S_; t += gridDim.x * 8) {
#pragma unroll
    for (int i = 0; i < 6; ++i) { const int c = 2 * lane + 128 * i, hd = c >> 6;
      const float l0 = DLSE[(size_t)t * 12 + hd], l1 = DLSE[((size_t)S_ + t) * 12 + hd], l2 = DLSE[((size_t)2 * S_ + t) * 12 + hd];
      const float mx = fmaxf(l0, fmaxf(l1, l2)), e0 = __expf(l0 - mx), e1 = __expf(l1 - mx), e2 = __expf(l2 - mx), inv = 1.f / (e0 + e1 + e2);
      const float2 o0 = ld_bf2(DPART + (size_t)t * 768 + c), o1 = ld_bf2(DPART + ((size_t)S_ + t) * 768 + c), o2 = ld_bf2(DPART + ((size_t)2 * S_ + t) * 768 + c);
      st_bf2(YMIX + (size_t)t * DM + 512 + c, (e0 * o0.x + e1 * o1.x + e2 * o2.x) * inv, (e0 * o0.y + e1 * o1.y + e2 * o2.y) * inv); }
  }
}

constexpr int ML_ROWB = 272;
DEV float ml_tables(const float* GLI, const float* GLF, int dir, int hd, int T0, int lane, LAS float* Bt, LAS float* Et, LAS float* gt) {
  const size_t base = (size_t)(dir * 4 + hd) * S_ + T0 + 2 * lane;
  const float lf0 = GLF[base], lf1 = GLF[base + 1], li0 = GLI[base], li1 = GLI[base + 1];
  const float ps = lf0 + lf1; float incl = ps;
#pragma unroll
  for (int o = 1; o < 64; o <<= 1) { const float y = __shfl_up(incl, o); if (lane >= o) incl += y; }
  const float excl = incl - ps, total = __shfl(incl, 63);
  float b0, b1;
  if (dir == 0) { b0 = excl + lf0; b1 = incl; }
  else { b0 = total - excl; b1 = total - (excl + lf0); }
  if (Bt) { Bt[2 * lane] = b0; Bt[2 * lane + 1] = b1; Et[2 * lane] = li0 - b0; Et[2 * lane + 1] = li1 - b1; }
  if (gt) { gt[2 * lane] = __expf(total - b0 + li0); gt[2 * lane + 1] = __expf(total - b1 + li1); }
  return total;
}
DEV void ml_stage_vt(const bf16_t* PROJ, int hd, int T0, LAS char* VT, int tid) {
#pragma unroll
  for (int i = 0; i < 6; ++i) { const int idx = tid + 512 * i, s = idx & 127, ch = idx >> 7;
    const bf16x8 v = *reinterpret_cast<const bf16x8*>(PROJ + (size_t)(T0 + s) * CINP + off_mv(hd) + ch * 8);
#pragma unroll
    for (int j = 0; j < 8; ++j) *(LAS short*)(VT + (ch * 8 + j) * ML_ROWB + s * 2) = v[j]; }
}
DEV void ml_m1_unit(const Args& a, int hd, int c, LAS char* lds, int wv) {
  const int tid = otid(wv), wid = tid >> 6, lane = tid & 63, r = lane & 31, h = lane >> 5, T0 = c * 128;
  const bf16_t* PROJ = WSP(bf16_t, A_PROJ); const bf16_t* MLQK = WSP(bf16_t, A_MLQK); const float* GLI = WSP(float, WS_GLI); const float* GLF = WSP(float, WS_GLF);
  bf16_t* DS = WSP(bf16_t, A_DS); float* DN = WSP(float, A_DN); float* CD = WSP(float, WS_CD);
  LAS char* VT = lds; LAS char* GKT = lds + 192 * ML_ROWB; LAS float* gt = (LAS float*)(lds + 2 * 192 * ML_ROWB);
  if (wid < 2) { const float total = ml_tables(GLI, GLF, wid, hd, T0, lane, nullptr, nullptr, gt + wid * 128); if (lane == 0) CD[(wid * 4 + hd) * 64 + c] = __expf(total); }
  ml_stage_vt(PROJ, hd, T0, VT, tid);
  __syncthreads();
  for (int dir = 0; dir < 2; ++dir) {
#pragma unroll
    for (int i = 0; i < 6; ++i) { const int idx = tid + 512 * i, s = idx & 127, ch = idx >> 7; const float g = gt[dir * 128 + s];
      const bf16x8 v = *reinterpret_cast<const bf16x8*>(MLQK + (size_t)(T0 + s) * 1536 + 768 + hd * 192 + ch * 8);
#pragma unroll
      for (int j = 0; j < 8; ++j) *(LAS bf16_t*)(GKT + (ch * 8 + j) * ML_ROWB + s * 2) = f2bf(bf2f((bf16_t)v[j]) * g); }
    __syncthreads();
    const size_t ub = (size_t)((dir * 4 + hd) * 64 + c);
    if (tid < 192) { float sum = 0.f; const LAS char* rowp = GKT + tid * ML_ROWB;
      for (int s = 0; s < 128; s += 2) { const unsigned u = *(const LAS unsigned*)(rowp + s * 2); sum += __uint_as_float(u << 16) + __uint_as_float(u & 0xffff0000u); }
      DN[ub * 192 + tid] = sum; }
    for (int tile = wid; tile < 36; tile += 8) { const int dvb = tile / 6, dkb = tile % 6; f32x16 acc = {};
#pragma unroll
      for (int ks = 0; ks < 8; ++ks) { const bf16x8 av = *(const LAS bf16x8*)(VT + (32 * dvb + r) * ML_ROWB + (16 * ks + 8 * h) * 2);
        const bf16x8 bk = *(const LAS bf16x8*)(GKT + (32 * dkb + r) * ML_ROWB + (16 * ks + 8 * h) * 2); acc = MFMA32(av, bk, acc); }
#pragma unroll
      for (int i = 0; i < 16; ++i) DS[(ub * 192 + 32 * dvb + crow(i, h)) * 192 + 32 * dkb + r] = f2bf(acc[i]); }
    __syncthreads();
  }
}
DEV void phase_ml_scan(const Args& a, int wv) {
  const bf16_t* DS = WSP(bf16_t, A_DS); const float* DN = WSP(float, A_DN); const float* CD = WSP(float, WS_CD); bf16_t* ST = WSP(bf16_t, A_ST); float* SN = WSP(float, A_SN);
  constexpr int NE4 = 8 * 36864 / 4, NN = 8 * 192;
  const int nb_ = (int)gridDim.x, per_ = (((NE4 + NN + nb_ - 1) / nb_) + 63) & ~63, e0_ = (int)blockIdx.x * per_;
  for (int e = e0_ + otid(wv); e < e0_ + per_ && e < NE4 + NN; e += 512) {
    if (e < NE4) { const int dh = e / 9216, idx = (e % 9216) * 4, dir = dh >> 2; const size_t base = (size_t)dh * 64 * 36864 + idx; float S0 = 0.f, S1 = 0.f, S2 = 0.f, S3 = 0.f;
#pragma unroll
      for (int hf = 0; hf < 2; ++hf) {
        u32x2 d[32]; float cd[32];
#pragma unroll
        for (int st = 0; st < 32; ++st) { const int s2 = hf * 32 + st, c = dir ? 63 - s2 : s2; d[st] = __builtin_nontemporal_load((const u32x2*)(DS + base + (size_t)c * 36864)); cd[st] = __uint_as_float(__builtin_amdgcn_readfirstlane(__float_as_uint(CD[dh * 64 + c]))); }
#pragma unroll
        for (int st = 0; st < 32; ++st) { const int s2 = hf * 32 + st, c = dir ? 63 - s2 : s2;
          u32x2 w; w.x = cvtpk(S0, S1); w.y = cvtpk(S2, S3); *(u32x2*)(ST + base + (size_t)c * 36864) = w;
          S0 = cd[st] * S0 + __uint_as_float(d[st].x << 16); S1 = cd[st] * S1 + __uint_as_float(d[st].x & 0xffff0000u); S2 = cd[st] * S2 + __uint_as_float(d[st].y << 16); S3 = cd[st] * S3 + __uint_as_float(d[st].y & 0xffff0000u); } } }
    else { const int e2 = e - NE4, dh = e2 / 192, idx = e2 % 192, dir = dh >> 2; const size_t base = (size_t)dh * 64 * 192 + idx; float Sv = 0.f;
#pragma unroll 8
      for (int st = 0; st < 64; ++st) { const int c = dir ? 63 - st : st; SN[base + (size_t)c * 192] = Sv; Sv = CD[dh * 64 + c] * Sv + DN[base + (size_t)c * 192]; } }
  }
}
DEV void ml_m3_unit(const Args& a, int l, int hd, int c, LAS char* lds, int wv) {
  const int tid = otid(wv), wid = tid >> 6, lane = tid & 63, r = lane & 31, h = lane >> 5, T0 = c * 128;
  const int dir = wid >> 2, rb = wid & 3;
  const bf16_t* PROJ = WSP(bf16_t, A_PROJ); const bf16_t* MLQK = WSP(bf16_t, A_MLQK); const float* GLI = WSP(float, WS_GLI); const float* GLF = WSP(float, WS_GLF);
  const bf16_t* ST = WSP(bf16_t, A_ST); const float* SN = WSP(float, A_SN); bf16_t* YMIX = WSP(bf16_t, A_YMIX);
  constexpr int KROWB = 400;
  LAS char* KL = lds; LAS char* VT = lds + 128 * KROWB; LAS float* tab = (LAS float*)(lds + 128 * KROWB + 192 * ML_ROWB);
  LAS float* Btab = tab; LAS float* Etab = tab + 256; LAS float* nv = tab + 512; LAS float* denx = tab + 512 + 384;
  LAS float* HB = (LAS float*)lds;
  if (wid < 2) (void)ml_tables(GLI, GLF, wid, hd, T0, lane, Btab + wid * 128, Etab + wid * 128, nullptr);
  else if (tid - 128 < 384) { const int i = tid - 128, d2 = i / 192, dk = i % 192; nv[i] = SN[(size_t)((d2 * 4 + hd) * 64 + c) * 192 + dk]; }
#pragma unroll
  for (int i = 0; i < 6; ++i) { const int idx = tid + 512 * i, s = idx / 24, ch = idx % 24;
    *(LAS bf16x8*)(KL + s * KROWB + ch * 16) = *reinterpret_cast<const bf16x8*>(MLQK + (size_t)(T0 + s) * 1536 + 768 + hd * 192 + ch * 8); }
  ml_stage_vt(PROJ, hd, T0, VT, tid);
  bf16x8 qf[12];
#pragma unroll
  for (int k = 0; k < 12; ++k) qf[k] = *reinterpret_cast<const bf16x8*>(MLQK + (size_t)(T0 + 32 * rb + r) * 1536 + hd * 192 + 16 * k + 8 * h);
  __syncthreads();
  const float Bt = Btab[dir * 128 + 32 * rb + r];
  f32x16 o[6] = {}; float den = 0.f;
  const bf16_t* STu = ST + (size_t)((dir * 4 + hd) * 64 + c) * 36864;
  bf16x8 sfp[2][6];
#pragma unroll
  for (int kk = 0; kk < 2; ++kk)
#pragma unroll
    for (int dvb = 0; dvb < 6; ++dvb) sfp[kk][dvb] = *reinterpret_cast<const bf16x8*>(STu + (size_t)(32 * dvb + r) * 192 + 16 * kk + 8 * h);
  const int sb_lo = dir ? rb : 0, sb_hi = dir ? 3 : rb;
  for (int sb = sb_lo; sb <= sb_hi; ++sb) {
    f32x16 p = {};
#pragma unroll
    for (int k = 0; k < 12; ++k) { const bf16x8 kf = *(const LAS bf16x8*)(KL + (32 * sb + r) * KROWB + (16 * k + 8 * h) * 2); p = MFMA32(kf, qf[k], p); }
#pragma unroll
    for (int i = 0; i < 16; ++i) { const int sl = crow(i, h); const float w = __builtin_amdgcn_exp2f((Bt + Etab[dir * 128 + 32 * sb + sl]) * LOG2E);
      const bool keep = (sb != rb) || (dir ? (sl >= r) : (sl <= r));
      p[i] = keep ? p[i] * w : 0.f; den += p[i]; }
    bf16x8 pa0, pa1; PK4(p, 0, pa0); PK4(p, 8, pa1);
#pragma unroll
    for (int dvb = 0; dvb < 6; ++dvb) { const LAS char* vrow = VT + (32 * dvb + r) * ML_ROWB + (32 * sb + 8 * h) * 2;
      const bf16x8 b0 = *(const LAS bf16x8*)(vrow), b1 = *(const LAS bf16x8*)(vrow + 32);
      o[dvb] = MFMA32(pa0, b0, o[dvb]); o[dvb] = MFMA32(pa1, b1, o[dvb]); }
  }
  {
    const float ef = __builtin_amdgcn_exp2f(Bt * LOG2E); float deni = 0.f;
#pragma unroll
    for (int k = 0; k < 12; ++k) { u32x4 w4 = __builtin_bit_cast(u32x4, qf[k]); float f[8];
#pragma unroll
      for (int j = 0; j < 4; ++j) { f[2 * j] = __uint_as_float(w4[j] << 16) * ef; f[2 * j + 1] = __uint_as_float(w4[j] & 0xffff0000u) * ef; }
#pragma unroll
      for (int j = 0; j < 8; ++j) deni += f[j] * nv[dir * 192 + 16 * k + 8 * h + j];
      u32x4 q4; q4.x = cvtpk(f[0], f[1]); q4.y = cvtpk(f[2], f[3]); q4.z = cvtpk(f[4], f[5]); q4.w = cvtpk(f[6], f[7]);
      const bf16x8 qs = __builtin_bit_cast(bf16x8, q4);
#pragma unroll
      for (int dvb = 0; dvb < 6; ++dvb) o[dvb] = MFMA32(qs, sfp[k & 1][dvb], o[dvb]);
      if (k + 2 < 12) {
#pragma unroll
        for (int dvb = 0; dvb < 6; ++dvb) sfp[k & 1][dvb] = *reinterpret_cast<const bf16x8*>(STu + (size_t)(32 * dvb + r) * 192 + 16 * (k + 2) + 8 * h); } }
    den += deni;
  }
  den += __shfl_xor(den, 32);
  if (h == 0) denx[wid * 32 + r] = den;
  asm volatile("s_waitcnt lgkmcnt(0)" ::: "memory");
  float rden[16];
#pragma unroll
  for (int i = 0; i < 16; ++i) rden[i] = 1.f / fmaxf(fabsf(denx[wid * 32 + crow(i, h)]), 1.f);
  __syncthreads();
  if (dir == 1) {
#pragma unroll
    for (int dvb = 0; dvb < 6; ++dvb)
#pragma unroll
      for (int i = 0; i < 16; ++i) HB[(32 * rb + crow(i, h)) * 193 + 32 * dvb + r] = o[dvb][i] * rden[i];
  }
  __syncthreads();
  if (dir == 0) {
#pragma unroll
    for (int dvb = 0; dvb < 6; ++dvb)
#pragma unroll
      for (int i = 0; i < 16; ++i) { LAS float* hp = HB + (32 * rb + crow(i, h)) * 193 + 32 * dvb + r; *hp = o[dvb][i] * rden[i] + *hp; }
  }
  __syncthreads();
  {
    const float* gout = a.g_out + (size_t)l * 768 + hd * 192; const float g0 = gout[lane], g1 = gout[lane + 64], g2 = gout[lane + 128];
    bf16_t opv[16][3];
#pragma unroll
    for (int rr = 0; rr < 16; ++rr) { const size_t t = (size_t)T0 + 16 * wid + rr;
#pragma unroll
      for (int cc = 0; cc < 3; ++cc) opv[rr][cc] = PROJ[t * CINP + OFF_MO + hd * 192 + lane + 64 * cc]; }
#pragma unroll
    for (int rr = 0; rr < 16; ++rr) { const int row = 16 * wid + rr; const size_t t = (size_t)T0 + row;
      const float v0 = HB[row * 193 + lane], v1 = HB[row * 193 + lane + 64], v2 = HB[row * 193 + lane + 128];
      const float rs = rsqrtf(wave_sum(v0 * v0 + v1 * v1 + v2 * v2) * (1.f / 192.f) + EPS);
      bf16_t* yo = YMIX + t * DM + 1280 + hd * 192 + lane;
      yo[0] = f2bf(v0 * rs * g0 / (1.f + __expf(-bf2f(opv[rr][0])))); yo[64] = f2bf(v1 * rs * g1 / (1.f + __expf(-bf2f(opv[rr][1])))); yo[128] = f2bf(v2 * rs * g2 / (1.f + __expf(-bf2f(opv[rr][2])))); }
  }
  __syncthreads();
}

constexpr int NPH_L = 13, NPH = NL * NPH_L + 1;
__global__ void __launch_bounds__(512, 2) fwd_kernel(Args a) {
    extern __shared__ __attribute__((aligned(16))) unsigned char lds_raw[];
    LAS unsigned char* lds = (LAS unsigned char*)lds_raw; LAS char* ldsg = (LAS char*)lds_raw;
    const int wv = 0; const int tid = threadIdx.x;
#define G obid_((int)gridDim.x)
#define bid obid_((int)blockIdx.x)
    const bool use_bar = (a.ph_hi - a.ph_lo) > 1;
    XcdBarrier bar; bar.bar = WSP(unsigned, WS_CTL); bar.x = 0; bar.st = (volatile LAS unsigned*)(lds + LDS_BARW); bar.wv = wv;
    if (use_bar) {
        if (tid == 0) { *(LAS u32x4*)(lds + LDS_BARW) = (u32x4){0u, 0u, 0u, 0u}; }
        __syncthreads();
        bar = xcd_barrier_post(WSP(unsigned, WS_CTL), (volatile LAS unsigned*)(lds + LDS_BARW), wv);
    }
#ifndef ONLY_K
#define ONLY_K -1
#endif
#define IN(k) ((ONLY_K < 0 || ((k) % NPH_L) == ONLY_K) && a.ph_lo <= (k) && (k) < a.ph_hi)
#define SEAM(k) do { if (IN(k) && IN((k) + 1)) xcd_barrier(bar); } while (0)
#define REPS(k) ((DUP_K == (k)) ? 2 : 1)
#define SUBREP(id) for (int sr_ = 0; sr_ < ((DUP_K == (id)) ? 2 : 1); ++sr_)
#define DUPLOOP(k) for (int rep_ = 0; rep_ < REPS(k); ++rep_, (rep_ < REPS(k) ? xcd_barrier(bar) : (void)0))
    for (int l = 0; l < NL; ++l) {
        const int pb = l * NPH_L;
        if (IN(pb + 0)) DUPLOOP(0) { SUBREP(27) { phase_cvt_a(a, l, lds, wv); phase_cvt_router(a, l, wv); } SUBREP(28) phase_norm1(a, l, l == 0 ? 0 : 1, wv); if (l == 0) phase_rope(a, wv); }
        SEAM(pb + 0);
        if (IN(pb + 1)) DUPLOOP(1) { pg8::Gemm g{WSP(bf16_t, WS_XN), WSP(bf16_t, A_WIN), DM, DM, DM, 1, 0}; pg8::StaticOrder S; S.init(S_, N_EARLY, G, bid);
            pg8::EpiBf16 E{WSP(bf16_t, A_PROJ), CINP, 0x7fffffff}; pg8::gemm_phase<false>(lds, g, S, E, wv); }
        SEAM(pb + 1);
        if (IN(pb + 2)) DUPLOOP(2) phase_p3a(a, l, wv);
        SEAM(pb + 2);
        if (IN(pb + 3)) DUPLOOP(3) {
            const int g_ = G, b_ = bid; const bool bal = (g_ == 256);
            { pg8::Gemm g{WSP(bf16_t, WS_XN), WSP(bf16_t, A_WIN) + (size_t)N_EARLY * DM, DM, DM, DM, 1, 0}; pg8::StaticOrder S; S.init(S_, N_LATE, bal ? 160 : g_, bal ? (b_ < 160 ? b_ : -1) : b_);
              pg8::EpiBf16 E{WSP(bf16_t, A_PROJ) + N_EARLY, CINP, 0x7fffffff}; pg8::gemm_phase<false>(lds, g, S, E, wv); }
            { pg8::Gemm g{WSP(bf16_t, A_CQKV), WSP(bf16_t, A_BD1), 512, 512, 512, 1, 0}; pg8::StaticOrder S;
              if (!bal) S.init(S_, 1792, g_, b_); else if (b_ >= 160) S.init(S_, 1792, 96, b_ - 160, 0, 2); else S.init(S_, 1792, 256, b_ < 32 ? b_ : -1, 192, 1);
              pg8::EpiBf16 E{WSP(bf16_t, A_RAW), 1792, 0x7fffffff}; pg8::gemm_phase<false>(lds, g, S, E, wv); }
            { pg8::Gemm g{WSP(bf16_t, A_UC), WSP(bf16_t, A_BD2), 768, 768, 384, 3, 192};   pg8::StaticOrder S;
              if (!bal) S.init(S_, 1536, g_, g_ - 1 - b_); else S.init(S_, 1536, 96, b_ >= 160 ? b_ - 160 : -1, 0, 2);
              pg8::EpiBf16 E{WSP(bf16_t, A_MLQK), 1536, 0x7fffffff}; pg8::gemm_phase<false>(lds, g, S, E, wv); }
        }
        SEAM(pb + 3);
        if (IN(pb + 4)) DUPLOOP(4) { phase_p3c(a, l, rep_ == 0, wv); SUBREP(25) for (int u = bid; u < 256; u += G) ml_m1_unit(a, u >> 6, u & 63, ldsg, wv); }
        SEAM(pb + 4);
        if (IN(pb + 5)) DUPLOOP(5) {
            SUBREP(22) phase_ml_scan(a, wv);
            const bool nomax = mla::bound_ok(a.g_q + l * 96, a.g_k + l * 96, lane_id());
            SUBREP(20) for (int u = bid; u < 256; u += G) { const int hq = u & 7, qb = u >> 3;
                const bf16_t* Qp = WSP(bf16_t, A_QM) + (size_t)qb * 256 * 768 + hq * 96; const bf16_t* Kp = WSP(bf16_t, A_KM) + hq * 96; const bf16_t* Vp = WSP(bf16_t, A_RAW) + 768 + hq * 128 + 64;
                bf16_t* Op = WSP(bf16_t, A_YMIX) + (size_t)qb * 256 * DM + hq * 64;
                if (nomax) mla::attn_unit<true>(Qp, Kp, Vp, Op, S_, ldsg, wv); else mla::attn_unit<false>(Qp, Kp, Vp, Op, S_, ldsg, wv); }
            if constexpr (DUP_K >= 41 && DUP_K <= 49) for (int u = bid; u < 256; u += G) { const int hq = u & 7, qb = u >> 3;
                mla::attn_unit<true, (DUP_K >= 41 && DUP_K <= 49) ? DUP_K - 40 : 0>(WSP(bf16_t, A_QM) + (size_t)qb * 256 * 768 + hq * 96, WSP(bf16_t, A_KM) + hq * 96, WSP(bf16_t, A_RAW) + 768 + hq * 128 + 64, nullptr, S_, ldsg, wv); }
            SUBREP(21) phase_dilated(a, ldsg, wv);
        }
        SEAM(pb + 5);
        if (IN(pb + 6)) DUPLOOP(6) { SUBREP(26) for (int u = bid; u < 256; u += G) ml_m3_unit(a, l, u >> 6, u & 63, ldsg, wv); SUBREP(29) phase_dilcomb(a, wv); }
        SEAM(pb + 6);
        if (IN(pb + 7)) DUPLOOP(7) { pg8::Gemm g{WSP(bf16_t, A_YMIX), WSP(bf16_t, A_WOUT), DM, DM, DM, 1, 0}; pg8::StaticOrder S; S.init(S_, DM, G, bid);
            pg8::EpiBf16 E{WSP(bf16_t, WS_XB), DM, 0x7fffffff}; pg8::gemm_phase<false>(lds, g, S, E, wv); }
        SEAM(pb + 7);
        if (IN(pb + 8)) DUPLOOP(8) { SUBREP(23) phase_router(a, l, wv); }
        SEAM(pb + 8);
        if (IN(pb + 9)) DUPLOOP(9) { phase_lists(a, ldsg, wv); SUBREP(24) phase_cvt_b(a, l, lds, (int)gridDim.x > 32 ? 16 : 0, wv); }
        SEAM(pb + 9);
        if (IN(pb + 11)) DUPLOOP(11) {
            unsigned* pcnt = WSP(unsigned, WS_CTL) + 4096 + l * (80 * 64);
            { pg8::Gemm g{WSP(bf16_t, WS_XN), WSP(bf16_t, B_W1), DM, DM, DM, 1, 0}; pg8::MoeOrder S{WSP(int, WS_TSTART), WSP(int, WS_TILES), 4, G, bid};
              pg8::EpiMoe1 E{WSP(bf16_t, B_H), WSP(float, WS_SLOTW), pcnt}; pg8::gemm_phase<true, true>(lds, g, S, E, wv, WSP(int, WS_PERM)); }
            { pg8::Gemm g{WSP(bf16_t, B_H), WSP(bf16_t, B_W2), 512, 512, 512, 1, 0}; pg8::MoeOrder2 S{WSP(int, WS_TSTART), WSP(int, WS_TILES), pcnt, WSP(unsigned, WS_CTL) + XB_TMO, G, bid};
              pg8::EpiBf16 E{WSP(bf16_t, B_YS), DM, 7}; pg8::gemm_phase<false, true>(lds, g, S, E, wv); }
        }
        SEAM(pb + 12);
    }
    if (IN(NPH - 1)) phase_norm1(a, 0, 2, wv);
#undef IN
#undef SEAM
#undef G
#undef bid
}

extern "C" void kernel_launch(void* const* d_in, const int* in_sizes, int n_in, void* d_out, int out_size, void* d_ws, size_t ws_size, hipStream_t stream) {
    static int grid = 0;
    if (grid == 0) {
        if (n_in != 28 || out_size != S_ * DM || ws_size < WS_END) { fprintf(stderr, "kernel_launch: shape/workspace mismatch: n_in %d out %d ws %zu (need %zu)\n", n_in, out_size, ws_size, (size_t)WS_END); grid = -1; return; }
        int dev = 0, cus = 0;
        if (hipGetDevice(&dev) != hipSuccess || hipDeviceGetAttribute(&cus, hipDeviceAttributeMultiprocessorCount, dev) != hipSuccess) { grid = -1; return; }
        if (hipFuncSetAttribute((const void*)fwd_kernel, hipFuncAttributeMaxDynamicSharedMemorySize, LDS_BYTES) != hipSuccess) { fprintf(stderr, "kernel_launch: hipFuncSetAttribute failed\n"); grid = -1; return; }
        int per_cu = 0;
        if (hipOccupancyMaxActiveBlocksPerMultiprocessor(&per_cu, (const void*)fwd_kernel, 512, LDS_BYTES) != hipSuccess || per_cu < 1) fprintf(stderr, "kernel_launch: occupancy query reports %d\n", per_cu);
        (void)hipGetLastError();
        grid = cus;
    }
    if (grid < 0) return;
    (void)hipMemsetAsync((char*)d_ws + WS_CTL, 0, CTL_BYTES, stream);
    Args a{};
    a.x = (const float*)d_in[0]; a.pos = (const int*)d_in[1]; a.rel_bias = (const float*)d_in[2]; a.norm_mix = (const float*)d_in[3]; a.w_in = (const float*)d_in[4];
    a.g_cq = (const float*)d_in[5]; a.w_uq = (const float*)d_in[6]; a.g_ckv = (const float*)d_in[7]; a.w_ukv = (const float*)d_in[8]; a.g_q = (const float*)d_in[9]; a.g_k = (const float*)d_in[10];
    a.dg_q = (const float*)d_in[11]; a.dg_k = (const float*)d_in[12]; a.conv_w = (const float*)d_in[13]; a.conv_b = (const float*)d_in[14]; a.ml_wq = (const float*)d_in[15]; a.ml_wk = (const float*)d_in[16];
    a.gate_bias = (const float*)d_in[17]; a.g_out = (const float*)d_in[18]; a.w_out = (const float*)d_in[19]; a.norm_ffn = (const float*)d_in[20]; a.wg = (const float*)d_in[21]; a.bg = (const float*)d_in[22];
    a.we = (const float*)d_in[23]; a.be = (const float*)d_in[24]; a.w_gate = (const float*)d_in[25]; a.w_up = (const float*)d_in[26]; a.w_down = (const float*)d_in[27];
    a.out = (float*)d_out; a.ws = (unsigned char*)d_ws;
#if MK_MULTI
    for (int ph = 0; ph < NPH; ++ph) { a.ph_lo = ph; a.ph_hi = ph + 1; hipLaunchKernelGGL(fwd_kernel, dim3(grid), dim3(512), LDS_BYTES, stream, a); }
#else
    a.ph_lo = 0; a.ph_hi = NPH; hipLaunchKernelGGL(fwd_kernel, dim3(grid), dim3(512), LDS_BYTES, stream, a);
#endif
    const hipError_t le = hipPeekAtLastError();
    if (le != hipSuccess) fprintf(stderr, "kernel_launch: launch failed: %s\n", hipGetErrorName(le));
}
```

```cpp
#include <hip/hip_runtime.h>
#include <cstdio>
#include <cstdint>

#ifndef MK_MULTI
#define MK_MULTI 0
#endif

#ifndef DUP_K
#define DUP_K -1
#endif
#define DEV __device__ __forceinline__
#define LAS __attribute__((address_space(3)))
typedef unsigned short bf16_t;
typedef short bf16x8 __attribute__((ext_vector_type(8)));
typedef short s16x4 __attribute__((ext_vector_type(4)));
typedef float f32x4 __attribute__((ext_vector_type(4)));
typedef float f32x2 __attribute__((ext_vector_type(2)));
__device__ __forceinline__ f32x2 mk2(float a, float b) { f32x2 r; r[0] = a; r[1] = b; return r; }
typedef float f32x16 __attribute__((ext_vector_type(16)));
typedef unsigned u32x4 __attribute__((ext_vector_type(4)));
typedef unsigned u32x2 __attribute__((ext_vector_type(2)));

constexpr int S_ = 8192, DM = 2048, CIN = 5168, CINP = 5376, NL = 2;
constexpr int OFF_CQ = 0, OFF_CKV = 384, OFF_KR = 512, OFF_DQ = 544, OFF_DK = 1312, OFF_DV = 2080, OFF_MU = 2848, OFF_MG = 4000, OFF_MO = 4480, N_EARLY = 4096, N_LATE = 1280;
__host__ __device__ constexpr int off_mv(int hd) { return hd < 2 ? 3616 + hd * 192 : 4096 + (hd - 2) * 192; }
__host__ __device__ constexpr int win_src_col(int n) { return n < 4000 ? n : (n < 4016 ? n + 1152 : (n < 4096 ? -1 : (n < 5248 ? n - 96 : -1))); }
constexpr float EPS = 1e-6f;
constexpr float LOG2E = 1.4426950408889634f, LN2 = 0.6931471805599453f;
constexpr int MAXSLOT = 20480;

constexpr size_t al256(size_t x) { return (x + 255) / 256 * 256; }
constexpr size_t WS_CTL = 0, CTL_BYTES = 65536;
constexpr size_t WS_XB = WS_CTL + CTL_BYTES;
constexpr size_t WS_XN = WS_XB + (size_t)S_ * DM * 4;
constexpr size_t WS_COS = WS_XN + (size_t)S_ * DM * 2;
constexpr size_t WS_SIN = WS_COS + (size_t)S_ * 16 * 4;
constexpr size_t WS_KR = WS_SIN + (size_t)S_ * 16 * 4;
constexpr size_t WS_GLI = WS_KR + (size_t)S_ * 32 * 4;
constexpr size_t WS_GLF = WS_GLI + (size_t)8 * S_ * 4;
constexpr size_t WS_EID = WS_GLF + (size_t)8 * S_ * 4;
constexpr size_t WS_WGT = WS_EID + (size_t)S_ * 8;
constexpr size_t WS_SLOTOF = WS_WGT + (size_t)S_ * 8;
constexpr size_t WS_PERM = WS_SLOTOF + (size_t)S_ * 8;
constexpr size_t WS_SLOTW = WS_PERM + (size_t)MAXSLOT * 4;
constexpr size_t WS_SLOTR = WS_SLOTW + (size_t)MAXSLOT * 4;
constexpr size_t WS_RSTD = WS_SLOTR + (size_t)MAXSLOT * 4;
constexpr size_t WS_TSTART = WS_RSTD + (size_t)S_ * 4;
constexpr size_t WS_TILES = WS_TSTART + 256;
constexpr size_t WS_CD = WS_TILES + 3 * 96 * 4;
constexpr size_t WS_WR3 = al256(WS_CD + 2 * 4 * 64 * 4);
constexpr size_t WS_ARENA = al256(WS_WR3 + (size_t)8 * 20 * 64 * 16);
constexpr size_t A_WIN = WS_ARENA;
constexpr size_t A_WOUT = A_WIN + (size_t)CINP * DM * 2;
constexpr size_t A_BD1 = A_WOUT + (size_t)DM * DM * 2;
constexpr size_t A_BD2 = A_BD1 + (size_t)1792 * 512 * 2;
constexpr size_t A_PROJ = A_BD2 + (size_t)1536 * 768 * 2;
constexpr size_t A_CQKV = A_PROJ + (size_t)S_ * CINP * 2;
constexpr size_t A_UC = A_CQKV + (size_t)S_ * 512 * 2;
constexpr size_t A_RAW = A_UC + (size_t)S_ * 768 * 2;
constexpr size_t A_MLQK = A_RAW + (size_t)S_ * 1792 * 2;
constexpr size_t A_QM = A_MLQK + (size_t)S_ * 1536 * 2;
constexpr size_t A_KM = A_QM + (size_t)S_ * 768 * 2;
constexpr size_t A_DPART = A_KM + (size_t)S_ * 768 * 2;
constexpr size_t A_DLSE = A_DPART + (size_t)3 * S_ * 768 * 2;
constexpr size_t A_DS = A_DLSE + (size_t)3 * S_ * 12 * 4;
constexpr size_t A_DN = A_DS + (size_t)512 * 36864 * 4;
constexpr size_t A_ST = A_DN + (size_t)512 * 192 * 4;
constexpr size_t A_SN = A_ST + (size_t)512 * 36864 * 2;
constexpr size_t A_YMIX = A_SN + (size_t)512 * 192 * 4;
constexpr size_t A_END = A_YMIX + (size_t)S_ * DM * 2;
constexpr size_t B_W1 = WS_ARENA;
constexpr size_t B_W2 = B_W1 + (size_t)16384 * 2048 * 2;
constexpr size_t B_APERM = B_W2 + (size_t)32768 * 512 * 2;
constexpr size_t B_H = B_APERM + (size_t)MAXSLOT * 2048 * 2;
constexpr size_t B_YS = B_H + (size_t)MAXSLOT * 512 * 2;
constexpr size_t B_END = B_YS + (size_t)MAXSLOT * 2048 * 2;
static_assert(B_YS >= A_PROJ, "YS must not overlap the next layer's converted weights (written while YS is still read)");
constexpr size_t WS_END = (A_END > B_END ? A_END : B_END);

constexpr int LDS_BYTES = 147456;
constexpr int LDS_BARW = LDS_BYTES - 64;

DEV int lane_id() { return (int)__builtin_amdgcn_mbcnt_hi(~0u, __builtin_amdgcn_mbcnt_lo(~0u, 0u)); }
DEV float bf2f(bf16_t b) { return __uint_as_float(((unsigned)b) << 16); }
DEV bf16_t f2bf(float f) { unsigned u = __float_as_uint(f); u += 0x7FFFu + ((u >> 16) & 1u); return (bf16_t)(u >> 16); }
DEV unsigned cvtpk(float lo, float hi) { unsigned r; asm volatile("v_cvt_pk_bf16_f32 %0, %1, %2" : "=v"(r) : "v"(lo), "v"(hi)); return r; }
DEV f32x4 ld_h4(const float* resid, const bf16_t* delta, size_t off) { f32x4 v = *(const f32x4*)(resid + off); const u32x2 d = *(const u32x2*)(delta + off);
    v[0] += __uint_as_float(d.x << 16); v[1] += __uint_as_float(d.x & 0xffff0000u); v[2] += __uint_as_float(d.y << 16); v[3] += __uint_as_float(d.y & 0xffff0000u); return v; }
DEV f32x4 ld_h4nt(const float* resid, const bf16_t* delta, size_t off) { f32x4 v = __builtin_nontemporal_load((const f32x4*)(resid + off)); const u32x2 d = __builtin_nontemporal_load((const u32x2*)(delta + off));
    v[0] += __uint_as_float(d.x << 16); v[1] += __uint_as_float(d.x & 0xffff0000u); v[2] += __uint_as_float(d.y << 16); v[3] += __uint_as_float(d.y & 0xffff0000u); return v; }
DEV float2 ld_bf2(const bf16_t* p) { const unsigned u = *(const unsigned*)p; return make_float2(__uint_as_float(u << 16), __uint_as_float(u & 0xffff0000u)); }
DEV void st_bf2(bf16_t* p, float a, float b) { *(unsigned*)p = cvtpk(a, b); }
DEV float wave_sum(float v) {
#pragma unroll
    for (int o = 1; o < 64; o <<= 1) v += __shfl_xor(v, o);
    return v;
}
DEV int otid(int wv) { (void)wv; int t = threadIdx.x; asm volatile("" : "+v"(t)); return t; }
DEV u32x4 zero4() { unsigned z = 0u; asm volatile("" : "+v"(z)); return (u32x4){z, z, z, z}; }
DEV int obid_(int v) { asm volatile("" : "+s"(v)); return v; }
DEV int crow(int r, int hi) { return (r & 3) + 8 * (r >> 2) + 4 * hi; }
DEV int ld_agent_i(const int* p) { return __hip_atomic_load(p, __ATOMIC_RELAXED, __HIP_MEMORY_SCOPE_AGENT); }
#define MFMA32(a, b, c) __builtin_amdgcn_mfma_f32_32x32x16_bf16((a), (b), (c), 0, 0, 0)
#define SBAR() __builtin_amdgcn_sched_barrier(0)
#define PK4(P, BASE, OUT) do { unsigned a0_ = cvtpk(P[BASE + 0], P[BASE + 1]), a1_ = cvtpk(P[BASE + 2], P[BASE + 3]);   \
    unsigned b0_ = cvtpk(P[BASE + 4], P[BASE + 5]), b1_ = cvtpk(P[BASE + 6], P[BASE + 7]);                              \
    auto r0_ = __builtin_amdgcn_permlane32_swap(a0_, b0_, false, false); auto r1_ = __builtin_amdgcn_permlane32_swap(a1_, b1_, false, false); \
    u32x4 w_ = {r0_[0], r1_[0], r0_[1], r1_[1]}; OUT = __builtin_bit_cast(bf16x8, w_); } while (0)

#define XB_TMO      128
#define XB_XCNT(j)  (256  + 64 * (j))
#define XB_XSUB(j)  (1280 + 64 * (j))
#define XB_XGEN(j)  (2304 + 64 * (j))
#define XB_TOP      3328
#define XB_TOPGEN   3392
#define XCD_BAR_WORDS 3456
#define XB_SPIN_CAP (1u << 18)
__device__ __forceinline__ unsigned xb_ld(unsigned* p)              { return __hip_atomic_load(p, __ATOMIC_RELAXED, __HIP_MEMORY_SCOPE_AGENT); }
__device__ __forceinline__ unsigned xb_add(unsigned* p, unsigned v) { return __hip_atomic_fetch_add(p, v, __ATOMIC_RELAXED, __HIP_MEMORY_SCOPE_AGENT); }
__device__ __forceinline__ unsigned xb_xcc_id() { return (unsigned)__builtin_amdgcn_s_getreg((3 << 11) | 20) & 0xFu; }
#define XB_SPIN(cond, bar) do { unsigned _sp = 0; while (cond) { __builtin_amdgcn_s_sleep(1); \
    if ((++_sp & 255u) == 0u) { if (xb_ld(&(bar)[XB_TMO])) break; if (_sp > XB_SPIN_CAP) { atomicAdd(&(bar)[XB_TMO], 1u); break; } } } } while (0)
struct XcdBarrier { unsigned* bar; unsigned x; volatile LAS unsigned* st; int wv; };
__device__ __forceinline__ XcdBarrier xcd_barrier_post(unsigned* bar, volatile LAS unsigned* st, int wv) {
    XcdBarrier b; b.bar = bar; b.x = xb_xcc_id(); b.st = st; b.wv = wv;
    if (threadIdx.x == 0) (void)xb_add(&bar[XB_XCNT(b.x)], 1u);
    return b;
}
__device__ __forceinline__ void xcd_barrier_complete(unsigned* bar, unsigned x, unsigned& nloc, unsigned& nx) {
    const unsigned G = gridDim.x * gridDim.y * gridDim.z;
    unsigned sum, cnt, mine, sp = 0u;
    for (;;) {
        sum = 0u; cnt = 0u; mine = 0u;
#pragma unroll
        for (unsigned j = 0; j < 16; ++j) { const unsigned c = xb_ld(&bar[XB_XCNT(j)]); sum += c; cnt += (c > 0u) ? 1u : 0u; mine = (j == x) ? c : mine; }
        if (sum == G) break;
        __builtin_amdgcn_s_sleep(1);
        if ((++sp & 255u) == 0u) { if (xb_ld(&bar[XB_TMO])) break; if (sp > XB_SPIN_CAP) { atomicAdd(&bar[XB_TMO], 1u); break; } }
    }
    nloc = mine > 0u ? mine : 1u; nx = cnt > 0u ? cnt : 1u;
}
__device__ __forceinline__ void xcd_barrier(const XcdBarrier& b) {
    asm volatile("s_waitcnt vmcnt(0)" ::: "memory");
    __syncthreads();
    if (threadIdx.x == 0) {
        unsigned* bar = b.bar;
        __builtin_amdgcn_s_waitcnt(0);
        unsigned nloc = b.st[0], nx = b.st[1];
        if (nloc == 0u) { xcd_barrier_complete(bar, b.x, nloc, nx); b.st[0] = nloc; b.st[1] = nx; }
        const unsigned old = xb_add(&bar[XB_XSUB(b.x)], 1u);
        const unsigned gen = old / nloc;
        if (old + 1u == (gen + 1u) * nloc) {
            __builtin_amdgcn_fence(__ATOMIC_RELEASE, "agent");
            asm volatile("s_waitcnt vmcnt(0)" ::: "memory");
            const unsigned og = xb_add(&bar[XB_TOP], 1u);
            const unsigned tg = og / nx;
            if (og + 1u == (tg + 1u) * nx) xb_add(&bar[XB_TOPGEN], 1u);
            else XB_SPIN(xb_ld(&bar[XB_TOPGEN]) == tg, bar);
            __builtin_amdgcn_fence(__ATOMIC_ACQUIRE, "agent");
            xb_add(&bar[XB_XGEN(b.x)], 1u);
            asm volatile("s_waitcnt vmcnt(0)" ::: "memory");
        } else {
            XB_SPIN(xb_ld(&bar[XB_XGEN(b.x)]) == gen, bar);
            __builtin_amdgcn_fence(__ATOMIC_ACQUIRE, "agent");
            asm volatile("s_waitcnt vmcnt(0)" ::: "memory");
        }
    }
    __syncthreads();
}

namespace pg8 {
constexpr int BM = 256, BK = 64, HALF = 128, HTB = HALF * BK * 2, STAGE_BYTES = 8 * HTB, NXCD = 8, WGM = 8;
__host__ __device__ __forceinline__ int lds_byte(int r, int c) { const int st = (r >> 4) * 2 + (c >> 5), rr = r & 15, cc = c & 31, ob = rr * 64 + cc * 2; return st * 1024 + (ob ^ (((ob >> 9) & 1) << 5)); }
__host__ __device__ __forceinline__ void stage_rc(int b, int& R, int& C) { const int st = b / 1024, sb = b % 1024, swz = sb ^ (((sb >> 9) & 1) << 5); R = (st >> 1) * 16 + swz / 64; C = (st & 1) * 32 + (swz % 64) / 2; }
__host__ __device__ __forceinline__ int perm32(int rho) { const int n = rho >> 4, i = rho & 15; return 8 * (i >> 2) + 4 * n + (i & 3); }
struct Unit { int pm, pn; int half; };
struct Gemm { const bf16_t* A; const bf16_t* Bt; int lda, ldb, K; int kmod, kstride; };
struct StaticOrder {
    int nM, nN, nwg, G, c, l0, maxi;
    __device__ void init(int M, int N, int G_, int c_, int l0_ = 0, int maxi_ = 0x7fffffff) { nM = M / BM; nN = N / BM; nwg = nM * nN; G = G_; c = c_; l0 = l0_; maxi = maxi_; }
    __device__ bool next(int i, Unit& u) const {
        if (i >= maxi || c < 0) return false;
        const long L = (long)l0 + (long)i * G + c; if (L >= nwg) return false;
        int wgid = (int)L; { const int q = nwg / NXCD, r = nwg % NXCD, xcd = wgid % NXCD, off = wgid / NXCD; wgid = (xcd < r ? xcd * (q + 1) : r * (q + 1) + (xcd - r) * q) + off; }
        const int nig = WGM * nN, gid = wgid / nig, fm = gid * WGM, gsz = (nM - fm) < WGM ? (nM - fm) : WGM;
        u.pm = fm + ((wgid % nig) % gsz); u.pn = (wgid % nig) / gsz; u.half = 0; return true;
    }
    __device__ __forceinline__ void a_ready(const Unit&) const {}
};
struct MoeOrder {
    const int* tstart; const int* tiles; int nct, G, c;
    __device__ bool next(int i, Unit& u) const {
        const int total = ld_agent_i(tstart + 16);
        const long L = (long)i * G + c; if (L >= (long)total * nct) return false;
        const int q = (int)(L / nct), ct = (int)(L % nct), p = ld_agent_i(tiles + q), e = ld_agent_i(tiles + 96 + p);
        u.pm = p; u.pn = e * nct + ct; u.half = ld_agent_i(tiles + 192 + p); return true;
    }
    __device__ __forceinline__ void a_ready(const Unit&) const {}
};
struct MoeOrder2 {
    const int* tstart; const int* tiles; unsigned* cnt; unsigned* tmo; int G, c;
    __device__ bool next(int i, Unit& u) const {
        const int T = ld_agent_i(tstart + 16); const int n1 = 4 * T, nh = n1 > G ? (n1 - G < G ? n1 - G : G - 1) : 0;
        if (c < nh) return false;
        const long L = (long)i * (G - nh) + (c - nh); if (L >= (long)T * 8) return false;
        const int q = (int)(L >> 3), ct = (int)(L & 7), p = ld_agent_i(tiles + q), e = ld_agent_i(tiles + 96 + p);
        u.pm = p; u.pn = e * 8 + ct; u.half = ld_agent_i(tiles + 192 + p); return true;
    }
    __device__ __forceinline__ void a_ready(const Unit& u) const {
        if (threadIdx.x < 64) {
            unsigned sp = 0;
            while ((unsigned)__builtin_amdgcn_readfirstlane(__hip_atomic_load(cnt + 64 * u.pm, __ATOMIC_RELAXED, __HIP_MEMORY_SCOPE_AGENT)) < 32u) {
                __builtin_amdgcn_s_sleep(2);
                if ((++sp & 255u) == 0u) { if (__hip_atomic_load(tmo, __ATOMIC_RELAXED, __HIP_MEMORY_SCOPE_AGENT)) break; if (sp > (1u << 20)) { atomicAdd(tmo, 1u); break; } } }
            __builtin_amdgcn_fence(__ATOMIC_ACQUIRE, "agent");
            asm volatile("s_waitcnt vmcnt(0)" ::: "memory");
        }
        asm volatile("" ::: "memory"); __builtin_amdgcn_s_barrier(); asm volatile("" ::: "memory");
    }
};
struct EpiBf16 {
    static constexpr bool PERM = true;
    __device__ __forceinline__ void done(const Unit&) const {}
    bf16_t* O; int ldc; int pnmask;
    __device__ __forceinline__ void operator()(const f32x4 (&acc)[2][2][4][2], const Unit& u, int wr, int wc, int fr, int fq) const {
        const int row0 = u.pm * BM + wr * 64 + fr; const int col0 = (u.pn & pnmask) * BM + wc * 32 + 8 * fq;
#pragma unroll
        for (int ai = 0; ai < 2; ++ai)
#pragma unroll
            for (int m = 0; m < 4; ++m) { bf16_t* rowp = O + (size_t)(row0 + ai * HALF + m * 16) * ldc + col0;
#pragma unroll
                for (int bj = 0; bj < 2; ++bj) { const f32x4 v0 = acc[ai][bj][m][0], v1 = acc[ai][bj][m][1];
                    u32x4 w; w.x = cvtpk(v0[0], v0[1]); w.y = cvtpk(v0[2], v0[3]); w.z = cvtpk(v1[0], v1[1]); w.w = cvtpk(v1[2], v1[3]);
                    *(u32x4*)(rowp + bj * HALF) = w; } }
    }
};
struct EpiResid {
    static constexpr bool PERM = false;
    __device__ __forceinline__ void done(const Unit&) const {}
    float* C; const float* R; int ldc;
    __device__ __forceinline__ void operator()(const f32x4 (&acc)[2][2][4][2], const Unit& u, int wr, int wc, int fr, int fq) const {
        const int row0 = u.pm * BM + wr * 64 + fr, col0 = u.pn * BM + wc * 32 + 4 * fq;
#pragma unroll
        for (int ai = 0; ai < 2; ++ai)
#pragma unroll
            for (int m = 0; m < 4; ++m) { const size_t off = (size_t)(row0 + ai * HALF + m * 16) * ldc + col0;
#pragma unroll
                for (int bj = 0; bj < 2; ++bj)
#pragma unroll
                    for (int n = 0; n < 2; ++n) { const f32x4 rv = *(const f32x4*)(R + off + bj * HALF + n * 16); *(f32x4*)(C + off + bj * HALF + n * 16) = acc[ai][bj][m][n] + rv; } }
    }
};
struct EpiMoe1 {
    static constexpr bool PERM = false;
    bf16_t* H; const float* slotw; const float* slotr; unsigned* cnt;
    __device__ __forceinline__ void done(const Unit& u) const {
        if (cnt) { asm volatile("s_waitcnt vmcnt(0)" ::: "memory"); if (lane_id() == 0) __hip_atomic_fetch_add(cnt + 64 * u.pm, 1u, __ATOMIC_RELAXED, __HIP_MEMORY_SCOPE_AGENT); } }
    __device__ __forceinline__ void operator()(const f32x4 (&acc)[2][2][4][2], const Unit& u, int wr, int wc, int fr, int fq) const {
        const int row0 = u.pm * BM + wr * 64 + fr; const int ct = u.pn & 3;
        const __amdgpu_buffer_rsrc_t rsrc = __builtin_amdgcn_make_buffer_rsrc((void*)H, (short)0, MAXSLOT * 512 * 2, 0x00020000);
#pragma unroll
        for (int ai = 0; ai < 2; ++ai)
#pragma unroll
            for (int m = 0; m < 4; ++m) { const int row = row0 + ai * HALF + m * 16; const float w = slotw[row], rs = slotr[row]; u32x4 o;
#pragma unroll
                for (int bj = 0; bj < 2; ++bj) { const f32x4 g = acc[ai][bj][m][0], up = acc[ai][bj][m][1]; float hv[4];
#pragma unroll
                    for (int j = 0; j < 4; ++j) { const float gj = g[j] * rs; hv[j] = gj / (1.0f + __expf(-gj)) * (up[j] * rs) * w; }
                    o[2 * bj] = cvtpk(hv[0], hv[1]); o[2 * bj + 1] = cvtpk(hv[2], hv[3]); }
                __builtin_amdgcn_raw_buffer_store_b128(o, rsrc, (row * 512 + ct * 128 + wc * 32 + 8 * fq) * 2, 0, 16); }
    }
};

template <bool GATHER = false, bool HALFSKIP = false, class Epi, class Sched>
__device__ __forceinline__ void gemm_phase(LAS unsigned char* lds, const Gemm g, const Sched& S, const Epi& E, int wv, const int* perm = nullptr) {
    const int tid = otid(wv), wid = __builtin_amdgcn_readfirstlane(tid >> 6), lane = tid & 63, wr = wid >> 2, wc = wid & 3, fr = lane & 15, fq = lane >> 4;
    const int K = g.K, nt = K / BK;
    unsigned voffA[2], voffB[2]; int rA[2], cA2[2];
#pragma unroll
    for (int i = 0; i < 2; ++i) { int R, C; stage_rc(tid * 16 + i * 8192, R, C); const int Rb = Epi::PERM ? ((R & ~31) + perm32(R & 31)) : R; rA[i] = R; cA2[i] = C * 2;
        voffA[i] = (unsigned)(R * g.lda + C) * 2u; voffB[i] = (unsigned)(Rb * g.ldb + C) * 2u; }
    const size_t kstep = (size_t)(BK * 2);
    const size_t hstepA = (size_t)HALF * g.lda * 2, hstepB = (size_t)HALF * g.ldb * 2;
    const size_t tstepA = 2 * hstepA, tstepB = 2 * hstepB;
    const unsigned ldsw = (unsigned)wid * 1024u;
    const int aoff = lds_byte(wr * 64 + fr, fq * 8), boff = lds_byte(wc * 32 + fr, fq * 8);
#define PG8_SA(b, h) (((b) * 2 + (h)) * HTB)
#define PG8_SB(b, h) ((4 + (b) * 2 + (h)) * HTB)
#define PG8_STAGE(bufoff, gbase, voff) do { _Pragma("unroll") for (int _i = 0; _i < 2; ++_i) \
        __builtin_amdgcn_global_load_lds((const unsigned*)((const char*)(gbase) + (voff)[_i]), (LAS unsigned*)(lds + (bufoff) + ldsw + _i * 8192), 16, 0, 0); } while (0)
#define PG8_STAGE_A(bufoff, h, kb, nx) do { if constexpr (GATHER) { _Pragma("unroll") for (int _i = 0; _i < 2; ++_i) \
        __builtin_amdgcn_global_load_lds((const unsigned*)((const char*)g.A + (kb) + ((nx) ? vN[h][_i] : vC[h][_i])), (LAS unsigned*)(lds + (bufoff) + ldsw + _i * 8192), 16, 0, 0); } \
        else { PG8_STAGE(bufoff, ((nx) ? nA : cA) + (h) * hstepA + (kb), voffA); } } while (0)
#define PG8_VOFF(v, u) do { _Pragma("unroll") for (int _h = 0; _h < 2; ++_h) _Pragma("unroll") for (int _i = 0; _i < 2; ++_i) \
        v[_h][_i] = (unsigned)perm[(u).pm * BM + _h * HALF + rA[_i]] * (unsigned)(g.lda * 2) + (unsigned)cA2[_i]; } while (0)
#define PG8_LDA(dst, b, h) do { _Pragma("unroll") for (int m = 0; m < 4; ++m) _Pragma("unroll") for (int k = 0; k < 2; ++k) dst[m][k] = *(const LAS bf16x8*)(lds + PG8_SA(b, h) + aoff + m * 2048 + k * 1024); } while (0)
#define PG8_LDB(dst, b, h) do { _Pragma("unroll") for (int n = 0; n < 2; ++n) _Pragma("unroll") for (int k = 0; k < 2; ++k) dst[n][k] = *(const LAS bf16x8*)(lds + PG8_SB(b, h) + boff + n * 2048 + k * 1024); } while (0)
#define PG8_MMA(ai, bj, At, Bt) do { __builtin_amdgcn_s_setprio(1); _Pragma("unroll") for (int m = 0; m < 4; ++m) _Pragma("unroll") for (int n = 0; n < 2; ++n) _Pragma("unroll") for (int k = 0; k < 2; ++k) \
        acc[ai][bj][m][n] = __builtin_amdgcn_mfma_f32_16x16x32_bf16(Bt[n][k], At[m][k], acc[ai][bj][m][n], 0, 0, 0); __builtin_amdgcn_s_setprio(0); } while (0)
#define PG8_WAIT_V(n) asm volatile("s_waitcnt vmcnt(" #n ")" ::: "memory")
#define PG8_WAIT_L(n) asm volatile("s_waitcnt lgkmcnt(" #n ")" ::: "memory")
#define PG8_BAR __builtin_amdgcn_s_barrier()
#define PG8_SCHED __builtin_amdgcn_sched_barrier(0)
    Unit cur, nxt; int ui = 0;
    if (!S.next(0, cur)) return;
    f32x4 acc[2][2][4][2];
#pragma unroll
    for (int a = 0; a < 2; ++a)
#pragma unroll
        for (int b = 0; b < 2; ++b)
#pragma unroll
            for (int m = 0; m < 4; ++m)
#pragma unroll
                for (int n = 0; n < 2; ++n) acc[a][b][m][n] = (f32x4){0.f, 0.f, 0.f, 0.f};
    bf16x8 At[4][2], B0[2][2], B1[2][2];
    unsigned vC[2][2] = {{0u, 0u}, {0u, 0u}}, vN[2][2] = {{0u, 0u}, {0u, 0u}};
    S.a_ready(cur);
    if constexpr (GATHER) PG8_VOFF(vC, cur);
    const char* cA = (const char*)g.A + (GATHER ? (size_t)0 : (size_t)cur.pm * tstepA) + (size_t)((cur.pn % g.kmod) * g.kstride) * 2; const char* cB = (const char*)g.Bt + (size_t)cur.pn * tstepB + (size_t)((cur.pn % g.kmod) * g.kstride) * 2; const char* nA = cA;
    PG8_STAGE(PG8_SB(0, 0), cB, voffB); PG8_STAGE_A(PG8_SA(0, 0), 0, (size_t)0, false); PG8_STAGE(PG8_SB(0, 1), cB + hstepB, voffB); PG8_STAGE_A(PG8_SA(0, 1), 1, (size_t)0, false);
    if (wr == 1) PG8_BAR;
    PG8_WAIT_V(4); PG8_BAR;
    PG8_STAGE(PG8_SB(1, 0), cB + kstep, voffB); PG8_STAGE_A(PG8_SA(1, 0), 0, kstep, false); PG8_STAGE(PG8_SB(1, 1), cB + hstepB + kstep, voffB);
    PG8_WAIT_V(6); PG8_BAR;
    for (;;) {
        const bool has_next = S.next(ui + 1, nxt);
        if constexpr (GATHER) { if (has_next) PG8_VOFF(vN, nxt); else { vN[0][0] = vC[0][0]; vN[0][1] = vC[0][1]; vN[1][0] = vC[1][0]; vN[1][1] = vC[1][1]; } }
        const size_t nko = has_next ? (size_t)((nxt.pn % g.kmod) * g.kstride) * 2 : 0;
        nA = (has_next && !GATHER) ? (const char*)g.A + (size_t)nxt.pm * tstepA + nko : cA; const char* nB = has_next ? (const char*)g.Bt + (size_t)nxt.pn * tstepB + nko : cB;
        for (int t = 0; t < nt; t += 2) {
            const bool last = (t == nt - 2);
            if (last && has_next) S.a_ready(nxt);
            const size_t k1 = (size_t)(t + 1) * kstep, k2 = last ? (size_t)0 : (size_t)(t + 2) * kstep, k3 = k2 + kstep;
            const char* b2 = last ? nB : cB + (size_t)(t + 2) * kstep; const char* b3 = b2 + kstep;
            PG8_LDB(B0, 0, 0); PG8_SCHED; PG8_LDA(At, 0, 0); PG8_STAGE_A(PG8_SA(1, 1), 1, k1, false);
            PG8_WAIT_L(8); PG8_BAR; PG8_WAIT_L(0); PG8_MMA(0, 0, At, B0); PG8_BAR; PG8_SCHED;
            PG8_LDB(B1, 0, 1); PG8_STAGE(PG8_SB(0, 0), b2, voffB);
            PG8_BAR; PG8_WAIT_L(0); PG8_MMA(0, 1, At, B1); PG8_BAR;
            PG8_LDA(At, 0, 1); PG8_STAGE_A(PG8_SA(0, 0), 0, k2, last);
            PG8_BAR; PG8_WAIT_L(0); if (!(HALFSKIP && cur.half)) PG8_MMA(1, 0, At, B0); PG8_BAR; PG8_SCHED;
            PG8_STAGE(PG8_SB(0, 1), b2 + hstepB, voffB);
            PG8_WAIT_V(6); PG8_BAR; if (!(HALFSKIP && cur.half)) PG8_MMA(1, 1, At, B1); PG8_BAR;
            PG8_LDB(B0, 1, 0); PG8_SCHED; PG8_LDA(At, 1, 0); PG8_STAGE_A(PG8_SA(0, 1), 1, k2, last);
            PG8_WAIT_L(8); PG8_BAR; PG8_WAIT_L(0); PG8_MMA(0, 0, At, B0); PG8_BAR; PG8_SCHED;
            PG8_LDB(B1, 1, 1); PG8_STAGE(PG8_SB(1, 0), b3, voffB);
            PG8_BAR; PG8_WAIT_L(0); PG8_MMA(0, 1, At, B1); PG8_BAR;
            PG8_LDA(At, 1, 1); PG8_STAGE_A(PG8_SA(1, 0), 0, k3, last);
            PG8_BAR; PG8_WAIT_L(0); if (!(HALFSKIP && cur.half)) PG8_MMA(1, 0, At, B0); PG8_BAR; PG8_SCHED;
            PG8_STAGE(PG8_SB(1, 1), b3 + hstepB, voffB);
            PG8_WAIT_V(6); PG8_BAR; if (!(HALFSKIP && cur.half)) PG8_MMA(1, 1, At, B1); PG8_BAR;
        }
        E(acc, cur, wr, wc, fr, fq); E.done(cur);
        if (!has_next) break;
#pragma unroll
        for (int a = 0; a < 2; ++a)
#pragma unroll
            for (int b = 0; b < 2; ++b)
#pragma unroll
                for (int m = 0; m < 4; ++m)
#pragma unroll
                    for (int n = 0; n < 2; ++n) acc[a][b][m][n] = (f32x4){0.f, 0.f, 0.f, 0.f};
        cur = nxt; cA = nA; cB = nB; ++ui;
        if constexpr (GATHER) { vC[0][0] = vN[0][0]; vC[0][1] = vN[0][1]; vC[1][0] = vN[1][0]; vC[1][1] = vN[1][1]; }
    }
    PG8_WAIT_V(0);
    if (wr == 0) PG8_BAR;
    PG8_BAR;
#undef PG8_SA
#undef PG8_SB
#undef PG8_STAGE
#undef PG8_STAGE_A
#undef PG8_VOFF
#undef PG8_LDA
#undef PG8_LDB
#undef PG8_MMA
#undef PG8_WAIT_V
#undef PG8_WAIT_L
#undef PG8_BAR
#undef PG8_SCHED
}
}

struct Args {
    const float* x; const int* pos; const float* rel_bias; const float* norm_mix; const float* w_in; const float* g_cq; const float* w_uq; const float* g_ckv; const float* w_ukv;
    const float* g_q; const float* g_k; const float* dg_q; const float* dg_k; const float* conv_w; const float* conv_b; const float* ml_wq; const float* ml_wk; const float* gate_bias;
    const float* g_out; const float* w_out; const float* norm_ffn; const float* wg; const float* bg; const float* we; const float* be; const float* w_gate; const float* w_up; const float* w_down;
    float* out; unsigned char* ws; int ph_lo, ph_hi;
};
typedef __attribute__((address_space(1))) unsigned char gchar_t;
DEV gchar_t* ows(const Args& a) { gchar_t* p = (gchar_t*)a.ws; asm volatile("" : "+s"(p)); return p; }
#define WSP(T, off) ((T*)(ows(a) + (off)))

__constant__ unsigned char c_bucket[3][129] = {
{11,11,11,11,11,11,11,11,11,11,11,11,11,11,11,10,10,10,10,10,10,10,10,10,10,10,10,10,10,10,10,10,10,10,10,10,10,10,9,9,9,9,9,9,9,9,9,9,9,9,8,8,8,8,8,8,8,7,6,5,4,3,2,1,0,17,18,19,20,21,22,23,24,24,24,24,24,24,24,25,25,25,25,25,25,25,25,25,25,25,25,26,26,26,26,26,26,26,26,26,26,26,26,26,26,26,26,26,26,26,26,26,26,26,27,27,27,27,27,27,27,27,27,27,27,27,27,27,27},
{13,13,13,13,13,13,13,13,13,13,13,13,13,13,13,13,13,13,13,13,13,13,13,12,12,12,12,12,12,12,12,12,12,12,12,12,12,12,12,12,12,12,11,11,11,11,11,11,11,11,11,11,10,10,10,10,10,10,9,9,9,8,8,4,0,20,24,24,25,25,25,26,26,26,26,26,26,27,27,27,27,27,27,27,27,27,27,28,28,28,28,28,28,28,28,28,28,28,28,28,28,28,28,28,28,28,29,29,29,29,29,29,29,29,29,29,29,29,29,29,29,29,29,29,29,29,29,29,29},
{15,15,15,15,15,15,15,15,15,15,15,15,15,15,15,15,15,15,15,15,15,15,15,15,15,15,15,15,15,15,14,14,14,14,14,14,14,14,14,14,14,14,14,14,14,13,13,13,13,13,13,13,13,13,12,12,12,12,12,11,11,10,10,9,0,25,26,26,27,27,28,28,28,28,28,29,29,29,29,29,29,29,29,29,30,30,30,30,30,30,30,30,30,30,30,30,30,30,30,31,31,31,31,31,31,31,31,31,31,31,31,31,31,31,31,31,31,31,31,31,31,31,31,31,31,31,31,31,31}};

DEV void cvt_item(const float* src, size_t ldsrc, int k0, int n0, int nvalid, bf16_t* dst, size_t lddst, int drow0, int dcol0, bool mode16, float scale, LAS float* scr, int lane, bool remap = false) {
    if (src) {
        f32x4 v[16];
        const int c4 = lane & 15, rq = lane >> 4; const int sn = remap ? win_src_col(n0 + c4 * 4) : n0 + c4 * 4; const bool ok = sn >= 0 && sn < nvalid;
#pragma unroll
        for (int i = 0; i < 16; ++i) v[i] = ok ? __builtin_nontemporal_load((const f32x4*)(src + (size_t)(k0 + i * 4 + rq) * ldsrc + sn)) : __builtin_bit_cast(f32x4, zero4());
#pragma unroll
        for (int i = 0; i < 16; ++i) { LAS float* d = scr + (i * 4 + rq) * 65 + c4 * 4; d[0] = v[i][0] * scale; d[1] = v[i][1] * scale; d[2] = v[i][2] * scale; d[3] = v[i][3] * scale; }
    }
    asm volatile("s_waitcnt lgkmcnt(0)" ::: "memory");
    const int c = lane & 7;
#pragma unroll
    for (int j = 0; j < 8; ++j) { const int n = (lane >> 3) + 8 * j; const LAS float* s = scr + (8 * c) * 65 + n;
        u32x4 o = zero4();
        if (src) { o.x = cvtpk(s[0 * 65], s[1 * 65]); o.y = cvtpk(s[2 * 65], s[3 * 65]); o.z = cvtpk(s[4 * 65], s[5 * 65]); o.w = cvtpk(s[6 * 65], s[7 * 65]); }
        const int dr = drow0 + (mode16 ? (((n >> 2) & 1) * 128 + (n >> 5) * 32 + ((n >> 3) & 3) * 4 + (n & 3)) : n);
        *(u32x4*)(dst + (size_t)dr * lddst + dcol0 + 8 * c) = o; }
    asm volatile("s_waitcnt lgkmcnt(0)" ::: "memory");
}
DEV void phase_cvt_a(const Args& a, int l, LAS unsigned char* lds, int wv) {
    const int wid = __builtin_amdgcn_readfirstlane(otid(wv) >> 6), lane = otid(wv) & 63;
    LAS float* scr = (LAS float*)(lds + wid * 16640);
    const int gw = blockIdx.x * 8 + wid, NGW = gridDim.x * 8;
    constexpr int I_IN = 84 * 32, I_OUT = 32 * 32, I_BD1 = 28 * 8, I_BD2 = 24 * 12, NIT = I_IN + I_OUT + I_BD1 + I_BD2;
    bf16_t* WinT = WSP(bf16_t, A_WIN); bf16_t* WoutT = WSP(bf16_t, A_WOUT); bf16_t* BD1 = WSP(bf16_t, A_BD1); bf16_t* BD2 = WSP(bf16_t, A_BD2);
    for (int it = gw; it < NIT; it += NGW) {
        int r = it;
        if (r < I_IN) { const int nb = r % 84, kb = r / 84;
            cvt_item(a.w_in + (size_t)l * DM * CIN, CIN, kb * 64, nb * 64, CIN, WinT, DM, nb * 64, kb * 64, false, 1.f, scr, lane, true); continue; } r -= I_IN;
        if (r < I_OUT) { const int nb = r % 32, kb = r / 32;
            cvt_item(a.w_out + (size_t)l * DM * DM, DM, kb * 64, nb * 64, DM, WoutT, DM, nb * 64, kb * 64, false, 1.f, scr, lane); continue; } r -= I_OUT;
        if (r < I_BD1) { const int nb = r % 28, kb = r / 28;
            const float* src = nullptr; size_t lds_ = 0; int k0 = 0, n0 = 0, nv = 0;
            if (nb < 12) { if (kb < 6) { src = a.w_uq + (size_t)l * 384 * 768; lds_ = 768; k0 = kb * 64; n0 = nb * 64; nv = 768; } }
            else { if (kb >= 6) { src = a.w_ukv + (size_t)l * 128 * 1024; lds_ = 1024; k0 = (kb - 6) * 64; n0 = (nb - 12) * 64; nv = 1024; } }
            cvt_item(src, lds_, k0, n0, nv, BD1, 512, nb * 64, kb * 64, false, 1.f, scr, lane); continue; } r -= I_BD1;
        { const int nb = r % 24, kb = r / 24;
            const int n = nb * 64, which = n / 768, np = n % 768, hd = np / 192, e0 = np % 192, hk = kb / 3;
            const float* src = nullptr; int k0 = 0;
            if (hk == hd) { src = (which ? a.ml_wk : a.ml_wq) + ((size_t)l * 4 + hd) * 192 * 192; k0 = (kb % 3) * 64; }
            cvt_item(src, 192, k0, e0, 192, BD2, 768, nb * 64, kb * 64, false, which ? 0.07216878364870322f : 1.f, scr, lane); }
    }
}
DEV void phase_cvt_router(const Args& a, int l, int wv) {
    f32x4* WR3 = WSP(f32x4, WS_WR3); const float* wg = a.wg + (size_t)l * DM * 4; const float* we = a.we + (size_t)l * DM * 16;
    for (int it = blockIdx.x * 512 + otid(wv); it < 8 * 20 * 64; it += gridDim.x * 512) { const int ln = it & 63, q = (it >> 6) % 20, i = it / (64 * 20), c = q / 5, qq = q % 5, e = (i * 64 + ln) * 4 + c;
        WR3[it] = (qq == 0) ? *(const f32x4*)(wg + (size_t)e * 4) : *(const f32x4*)(we + (size_t)e * 16 + (qq - 1) * 4); }
}
DEV void phase_cvt_b(const Args& a, int l, LAS unsigned char* lds, int b0, int wv) {
    const int wid = __builtin_amdgcn_readfirstlane(otid(wv) >> 6), lane = otid(wv) & 63;
    LAS float* scr = (LAS float*)(lds + wid * 16640);
    if ((int)blockIdx.x < b0) return;
    const int gw = ((int)blockIdx.x - b0) * 8 + wid, NGW = ((int)gridDim.x - b0) * 8;
    constexpr int I_W1 = 16 * 2 * 8 * 32, I_W2 = 16 * 32 * 8;
    bf16_t* W1 = WSP(bf16_t, B_W1); bf16_t* W2 = WSP(bf16_t, B_W2);
    for (int it = gw; it < I_W1 + I_W2; it += NGW) {
        int r = it;
        if (r < I_W1) { const int fb = r % 8; r /= 8; const int kb = r % 32; r /= 32; const int mat = r % 2, e = r / 2;
            const float* src = (mat ? a.w_up : a.w_gate) + ((size_t)l * 16 + e) * 2048 * 512;
            cvt_item(src, 512, kb * 64, fb * 64, 512, W1, 2048, e * 1024 + (fb >> 1) * 256 + (fb & 1) * 64 + mat * 16, kb * 64, true, 1.f, scr, lane); continue; } r -= I_W1;
        { const int nb = r % 32; r /= 32; const int kb = r % 8, e = r / 8;
            const float* src = a.w_down + ((size_t)l * 16 + e) * 512 * 2048;
            cvt_item(src, 2048, kb * 64, nb * 64, 2048, W2, 512, e * 2048 + nb * 64, kb * 64, false, 1.f, scr, lane); }
    }
}

__constant__ float c_invfreq[16] = {1.0f, 0.5623413f, 0.31622776f, 0.17782794f, 0.1f, 0.056234132f, 0.031622775f, 0.017782794f, 0.01f, 0.0056234132f, 0.0031622776f, 0.0017782794f, 0.001f, 0.00056234133f, 0.00031622776f, 0.00017782794f};
DEV void phase_rope(const Args& a, int wv) {
    float* COS = WSP(float, WS_COS); float* SIN = WSP(float, WS_SIN);
    for (int i = blockIdx.x * 512 + otid(wv); i < S_ * 16; i += gridDim.x * 512) {
        const int t = i >> 4, f = i & 15;
        const float ang = (float)a.pos[t] * c_invfreq[f];
        const double rev = (double)ang * 0.15915494309189535;
        const float fr = (float)(rev - __builtin_rint(rev));
        COS[i] = __builtin_amdgcn_cosf(fr); SIN[i] = __builtin_amdgcn_sinf(fr);
    }
}

DEV void phase_norm1(const Args& a, int l, int mode, int wv) {
    const int wid = __builtin_amdgcn_readfirstlane(otid(wv) >> 6), lane = otid(wv) & 63;
    const float* src = mode == 2 ? (const float*)a.out : a.x; const bf16_t* DLT = WSP(bf16_t, WS_XB);
    const bf16_t* YS = WSP(bf16_t, B_YS); const int* SLOTOF = WSP(int, WS_SLOTOF); bf16_t* XN = WSP(bf16_t, WS_XN);
    const float* gain = a.norm_mix + (size_t)(mode == 2 ? 0 : l) * DM;
    const int nw = gridDim.x * 8;
    for (int row0 = blockIdx.x * 8 + wid; row0 < S_; row0 += 2 * nw) {
        f32x4 v[2][8]; int sl[2][2] = {{0, 0}, {0, 0}}; const int rws[2] = {row0, row0 + nw < S_ ? row0 + nw : row0};
        if (mode != 0) {
#pragma unroll
            for (int rr = 0; rr < 2; ++rr) { sl[rr][0] = SLOTOF[rws[rr] * 2]; sl[rr][1] = SLOTOF[rws[rr] * 2 + 1]; } }
#pragma unroll
        for (int rr = 0; rr < 2; ++rr)
#pragma unroll
            for (int i = 0; i < 8; ++i) v[rr][i] = (mode == 0) ? __builtin_nontemporal_load((const f32x4*)(src + (size_t)rws[rr] * DM + (i * 64 + lane) * 4)) : ld_h4nt(src, DLT, (size_t)rws[rr] * DM + (i * 64 + lane) * 4);
        if (mode != 0) {
#pragma unroll
            for (int rr = 0; rr < 2; ++rr) { const int row = rws[rr];
#pragma unroll
                for (int i = 0; i < 8; ++i) { const u32x2 y0 = __builtin_nontemporal_load((const u32x2*)(YS + (size_t)sl[rr][0] * DM + (i * 64 + lane) * 4)), y1 = __builtin_nontemporal_load((const u32x2*)(YS + (size_t)sl[rr][1] * DM + (i * 64 + lane) * 4));
                    v[rr][i][0] += __uint_as_float(y0.x << 16) + __uint_as_float(y1.x << 16); v[rr][i][1] += __uint_as_float(y0.x & 0xffff0000u) + __uint_as_float(y1.x & 0xffff0000u);
                    v[rr][i][2] += __uint_as_float(y0.y << 16) + __uint_as_float(y1.y << 16); v[rr][i][3] += __uint_as_float(y0.y & 0xffff0000u) + __uint_as_float(y1.y & 0xffff0000u);
                    if (mode == 2) __builtin_nontemporal_store(v[rr][i], (f32x4*)(a.out + (size_t)row * DM + (i * 64 + lane) * 4)); else *(f32x4*)(a.out + (size_t)row * DM + (i * 64 + lane) * 4) = v[rr][i]; } } }
        if (mode == 2) continue;
#pragma unroll
        for (int rr = 0; rr < 2; ++rr) { const int row = rws[rr]; float ss = 0.f;
#pragma unroll
            for (int i = 0; i < 8; ++i) ss += (v[rr][i][0] * v[rr][i][0] + v[rr][i][1] * v[rr][i][1]) + (v[rr][i][2] * v[rr][i][2] + v[rr][i][3] * v[rr][i][3]);
            const float rstd = rsqrtf(wave_sum(ss) * (1.f / DM) + EPS);
#pragma unroll
            for (int i = 0; i < 8; ++i) { const f32x4 g = *(const f32x4*)(gain + (i * 64 + lane) * 4); u32x2 o;
                o.x = cvtpk(v[rr][i][0] * rstd * g[0], v[rr][i][1] * rstd * g[1]); o.y = cvtpk(v[rr][i][2] * rstd * g[2], v[rr][i][3] * rstd * g[3]);
                *(u32x2*)(XN + (size_t)row * DM + (i * 64 + lane) * 4) = o; } }
    }
}

DEV float logsigmoidf(float x) { return fminf(x, 0.f) - __logf(1.f + __expf(-fabsf(x))); }

DEV void phase_p3a(const Args& a, int l, int wv) {
    const int wid = __builtin_amdgcn_readfirstlane(otid(wv) >> 6), lane = otid(wv) & 63, l16 = lane & 15;
    const bf16_t* PROJ = WSP(bf16_t, A_PROJ); bf16_t* CQKV = WSP(bf16_t, A_CQKV); bf16_t* UC = WSP(bf16_t, A_UC);
    float* KR = WSP(float, WS_KR); float* GLI = WSP(float, WS_GLI); float* GLF = WSP(float, WS_GLF);
    const float* COS = WSP(float, WS_COS); const float* SIN = WSP(float, WS_SIN);
    const float* gcq = a.g_cq + l * 384; const float* gckv = a.g_ckv + l * 128; const float* cw = a.conv_w + (size_t)l * 5 * 768; const float* cb = a.conv_b + l * 768; const float* gb = a.gate_bias + l * 16;
    float2 wcv[6][5], bv[6], gq2[3], gk2;
#pragma unroll
    for (int i = 0; i < 6; ++i) { const int ch = 2 * lane + 128 * i; bv[i] = *(const float2*)(cb + ch);
#pragma unroll
        for (int j = 0; j < 5; ++j) wcv[i][j] = *(const float2*)(cw + j * 768 + ch); }
#pragma unroll
    for (int i = 0; i < 3; ++i) gq2[i] = *(const float2*)(gcq + 2 * lane + 128 * i);
    gk2 = *(const float2*)(gckv + 2 * lane);
    const float gbias = gb[l16];
    for (int t = blockIdx.x * 8 + wid; t < S_; t += gridDim.x * 8) {
        const bf16_t* pr = PROJ + (size_t)t * CINP;
        float2 cq[3], u[6][5];
#pragma unroll
        for (int i = 0; i < 3; ++i) cq[i] = ld_bf2(pr + OFF_CQ + 2 * lane + 128 * i);
        const float2 ck = ld_bf2(pr + OFF_CKV + 2 * lane);
        const float x1 = bf2f(pr[OFF_KR + l16]), x2 = bf2f(pr[OFF_KR + 16 + l16]), cs = COS[t * 16 + l16], sn = SIN[t * 16 + l16];
        const float pre = bf2f(pr[OFF_MG + l16]) + gbias;
#pragma unroll
        for (int j = 0; j < 5; ++j) { const int tt = t + j - 2, tc = tt < 0 ? 0 : (tt >= S_ ? S_ - 1 : tt);
#pragma unroll
            for (int i = 0; i < 6; ++i) u[i][j] = ld_bf2(PROJ + (size_t)tc * CINP + OFF_MU + 2 * lane + 128 * i); }
        { float ss = 0.f;
#pragma unroll
          for (int i = 0; i < 3; ++i) ss += cq[i].x * cq[i].x + cq[i].y * cq[i].y;
          const float rq = rsqrtf(wave_sum(ss) * (1.f / 384.f) + EPS);
#pragma unroll
          for (int i = 0; i < 3; ++i) st_bf2(CQKV + (size_t)t * 512 + 2 * lane + 128 * i, cq[i].x * rq * gq2[i].x, cq[i].y * rq * gq2[i].y); }
        { const float rk = rsqrtf(wave_sum(ck.x * ck.x + ck.y * ck.y) * (1.f / 128.f) + EPS);
          st_bf2(CQKV + (size_t)t * 512 + 384 + 2 * lane, ck.x * rk * gk2.x, ck.y * rk * gk2.y); }
        if (lane < 16) { KR[t * 32 + lane] = x1 * cs - x2 * sn; KR[t * 32 + 16 + lane] = x1 * sn + x2 * cs; }
#pragma unroll
        for (int i = 0; i < 6; ++i) { float a0 = bv[i].x, a1 = bv[i].y;
#pragma unroll
            for (int j = 0; j < 5; ++j) { const int tt = t + j - 2; const float ok = (tt >= 0 && tt < S_) ? 1.f : 0.f; a0 += ok * u[i][j].x * wcv[i][j].x; a1 += ok * u[i][j].y * wcv[i][j].y; }
            a0 = a0 / (1.f + __expf(-a0)); a1 = a1 / (1.f + __expf(-a1));
            st_bf2(UC + (size_t)t * 768 + 2 * lane + 128 * i, a0, a1); }
        if (lane < 16) { const int dir = lane >> 3, isf = (lane >> 2) & 1, hd = lane & 3;
            if (!isf) GLI[(size_t)(dir * 4 + hd) * S_ + t] = pre; else GLF[(size_t)(dir * 4 + hd) * S_ + t] = logsigmoidf(pre); }
    }
}

constexpr float MLA_QSCALE = 0.10206207261596575f * 1.4426950408889634f;
DEV void phase_p3c(const Args& a, int l, bool do_dil, int wv) {
    const int wid = __builtin_amdgcn_readfirstlane(otid(wv) >> 6), lane = otid(wv) & 63, h8 = lane >> 3, l8 = lane & 7, hh = lane >> 4, l16 = lane & 15;
    bf16_t* PROJ = WSP(bf16_t, A_PROJ); const bf16_t* RAW = WSP(bf16_t, A_RAW); bf16_t* QM = WSP(bf16_t, A_QM); bf16_t* KM = WSP(bf16_t, A_KM);
    const float* KR = WSP(float, WS_KR); const float* COS = WSP(float, WS_COS); const float* SIN = WSP(float, WS_SIN);
    const float* gq = a.g_q + l * 96; const float* gk = a.g_k + l * 96; const float* dgq = a.dg_q + l * 64; const float* dgk = a.dg_k + l * 64;
    float gqn[8], gkn[8]; float2 gq1, gq2, gk1, gk2; f32x4 dq4, dk4;
#pragma unroll
    for (int j = 0; j < 8; ++j) { gqn[j] = gq[8 * l8 + j]; gkn[j] = gk[8 * l8 + j]; }
    gq1 = *(const float2*)(gq + 64 + 2 * l8); gq2 = *(const float2*)(gq + 80 + 2 * l8); gk1 = *(const float2*)(gk + 64 + 2 * l8); gk2 = *(const float2*)(gk + 80 + 2 * l8);
    dq4 = *(const f32x4*)(dgq + 4 * l16); dk4 = *(const f32x4*)(dgk + 4 * l16);
    for (int t = blockIdx.x * 8 + wid; t < S_; t += gridDim.x * 8) {
        const bf16_t* rq = RAW + (size_t)t * 1792; bf16_t* pr = PROJ + (size_t)t * CINP;
        const u32x4 qn = *(const u32x4*)(rq + h8 * 96 + 8 * l8); const float2 qx1 = ld_bf2(rq + h8 * 96 + 64 + 2 * l8), qx2 = ld_bf2(rq + h8 * 96 + 80 + 2 * l8);
        const u32x4 kn = *(const u32x4*)(rq + 768 + h8 * 128 + 8 * l8);
        const float2 cs = *(const float2*)(COS + t * 16 + 2 * l8), sn = *(const float2*)(SIN + t * 16 + 2 * l8);
        const float2 kr1 = *(const float2*)(KR + t * 32 + 2 * l8), kr2 = *(const float2*)(KR + t * 32 + 16 + 2 * l8);
        u32x2 dq[3], dk[3];
        if (do_dil) {
#pragma unroll
            for (int ps = 0; ps < 3; ++ps) { dq[ps] = *(const u32x2*)(pr + OFF_DQ + (ps * 4 + hh) * 64 + 4 * l16); dk[ps] = *(const u32x2*)(pr + OFF_DK + (ps * 4 + hh) * 64 + 4 * l16); } }
        { float v[8];
#pragma unroll
          for (int j = 0; j < 4; ++j) { v[2 * j] = __uint_as_float(qn[j] << 16); v[2 * j + 1] = __uint_as_float(qn[j] & 0xffff0000u); }
          const float o1x = qx1.x * cs.x - qx2.x * sn.x, o1y = qx1.y * cs.y - qx2.y * sn.y, o2x = qx1.x * sn.x + qx2.x * cs.x, o2y = qx1.y * sn.y + qx2.y * cs.y;
          float ss = o1x * o1x + o1y * o1y + o2x * o2x + o2y * o2y;
#pragma unroll
          for (int j = 0; j < 8; ++j) ss += v[j] * v[j];
          ss += __shfl_xor(ss, 1); ss += __shfl_xor(ss, 2); ss += __shfl_xor(ss, 4);
          const float r = rsqrtf(ss * (1.f / 96.f) + EPS) * MLA_QSCALE;
          bf16_t* qo = QM + (size_t)t * 768 + h8 * 96; u32x4 w;
          w.x = cvtpk(v[0] * r * gqn[0], v[1] * r * gqn[1]); w.y = cvtpk(v[2] * r * gqn[2], v[3] * r * gqn[3]); w.z = cvtpk(v[4] * r * gqn[4], v[5] * r * gqn[5]); w.w = cvtpk(v[6] * r * gqn[6], v[7] * r * gqn[7]);
          *(u32x4*)(qo + 8 * l8) = w; st_bf2(qo + 64 + 2 * l8, o1x * r * gq1.x, o1y * r * gq1.y); st_bf2(qo + 80 + 2 * l8, o2x * r * gq2.x, o2y * r * gq2.y); }
        { float v[8];
#pragma unroll
          for (int j = 0; j < 4; ++j) { v[2 * j] = __uint_as_float(kn[j] << 16); v[2 * j + 1] = __uint_as_float(kn[j] & 0xffff0000u); }
          float ss = kr1.x * kr1.x + kr1.y * kr1.y + kr2.x * kr2.x + kr2.y * kr2.y;
#pragma unroll
          for (int j = 0; j < 8; ++j) ss += v[j] * v[j];
          ss += __shfl_xor(ss, 1); ss += __shfl_xor(ss, 2); ss += __shfl_xor(ss, 4);
          const float r = rsqrtf(ss * (1.f / 96.f) + EPS);
          bf16_t* ko = KM + (size_t)t * 768 + h8 * 96; u32x4 w;
          w.x = cvtpk(v[0] * r * gkn[0], v[1] * r * gkn[1]); w.y = cvtpk(v[2] * r * gkn[2], v[3] * r * gkn[3]); w.z = cvtpk(v[4] * r * gkn[4], v[5] * r * gkn[5]); w.w = cvtpk(v[6] * r * gkn[6], v[7] * r * gkn[7]);
          *(u32x4*)(ko + 8 * l8) = w; st_bf2(ko + 64 + 2 * l8, kr1.x * r * gk1.x, kr1.y * r * gk1.y); st_bf2(ko + 80 + 2 * l8, kr2.x * r * gk2.x, kr2.y * r * gk2.y); }
        if (do_dil) {
#pragma unroll
            for (int ps = 0; ps < 3; ++ps) {
                { const float x0 = __uint_as_float(dq[ps].x << 16), x1 = __uint_as_float(dq[ps].x & 0xffff0000u), x2 = __uint_as_float(dq[ps].y << 16), x3 = __uint_as_float(dq[ps].y & 0xffff0000u);
                  float ss = x0 * x0 + x1 * x1 + x2 * x2 + x3 * x3; ss += __shfl_xor(ss, 1); ss += __shfl_xor(ss, 2); ss += __shfl_xor(ss, 4); ss += __shfl_xor(ss, 8);
                  const float r = rsqrtf(ss * (1.f / 64.f) + EPS); u32x2 w; w.x = cvtpk(x0 * r * dq4[0], x1 * r * dq4[1]); w.y = cvtpk(x2 * r * dq4[2], x3 * r * dq4[3]);
                  *(u32x2*)(pr + OFF_DQ + (ps * 4 + hh) * 64 + 4 * l16) = w; }
                { const float x0 = __uint_as_float(dk[ps].x << 16), x1 = __uint_as_float(dk[ps].x & 0xffff0000u), x2 = __uint_as_float(dk[ps].y << 16), x3 = __uint_as_float(dk[ps].y & 0xffff0000u);
                  float ss = x0 * x0 + x1 * x1 + x2 * x2 + x3 * x3; ss += __shfl_xor(ss, 1); ss += __shfl_xor(ss, 2); ss += __shfl_xor(ss, 4); ss += __shfl_xor(ss, 8);
                  const float r = rsqrtf(ss * (1.f / 64.f) + EPS); u32x2 w; w.x = cvtpk(x0 * r * dk4[0], x1 * r * dk4[1]); w.y = cvtpk(x2 * r * dk4[2], x3 * r * dk4[3]);
                  *(u32x2*)(pr + OFF_DK + (ps * 4 + hh) * 64 + 4 * l16) = w; } } }
    }
}

DEV void phase_router(const Args& a, int l, LAS char* lds, int wv) {
    const int wid = __builtin_amdgcn_readfirstlane(otid(wv) >> 6), lane = otid(wv) & 63, tid = otid(wv);
    const float* RS = (l == 0) ? a.x : (const float*)a.out; const bf16_t* DLT = WSP(bf16_t, WS_XB); bf16_t* HN = WSP(bf16_t, WS_XN); int* EID = WSP(int, WS_EID); float* WGT = WSP(float, WS_WGT);
    const float* gain = a.norm_ffn + (size_t)l * DM; const f32x4* WR3 = WSP(f32x4, WS_WR3); const float* bg = a.bg + l * 4; const float* be = a.be + l * 16;
    LAS f32x4* WL = (LAS f32x4*)lds;
    const __amdgpu_buffer_rsrc_t rsW = __builtin_amdgcn_make_buffer_rsrc((void*)WR3, (short)0, 10240 * 16, 0x00020000);
    const int ntrip = (S_ / 32 + (int)gridDim.x - 1) / (int)gridDim.x;
    for (int trip = 0; trip < ntrip; ++trip) { const int row0 = ((blockIdx.x + trip * gridDim.x) * 8 + wid) * 4; const bool live = row0 < S_;
        if (trip > 0) __syncthreads();
#pragma unroll
        for (int b = 0; b < 2; ++b) { f32x4 wst[9];
#pragma unroll
            for (int m = 0; m < 9; ++m) wst[m] = __builtin_bit_cast(f32x4, __builtin_amdgcn_raw_buffer_load_b128(rsW, tid * 16, 512 * 16 * (b * 9 + m), 0));
#pragma unroll
            for (int m = 0; m < 9; ++m) { const int idx = tid + 512 * (b * 9 + m); if (idx < 8960) WL[idx] = wst[m]; }
            SBAR(); }
        f32x4 wl7[3];
        float ss[4] = {0.f, 0.f, 0.f, 0.f};
        float lg[4][20];
#pragma unroll
        for (int rr = 0; rr < 4; ++rr)
#pragma unroll
            for (int j = 0; j < 20; ++j) lg[rr][j] = 0.f;
        __syncthreads();
#pragma unroll 1
        for (int i = 0; i < 8; ++i) { const int e0 = (i * 64 + lane) * 4;
            if (i == 1) { __syncthreads(); f32x4 wl7[3];
#pragma unroll
                for (int m = 0; m < 3; ++m) wl7[m] = __builtin_bit_cast(f32x4, __builtin_amdgcn_raw_buffer_load_b128(rsW, tid * 16, (8960 + 512 * m) * 16, 0));
#pragma unroll
                for (int m = 0; m < 3; ++m) { const int idx = tid + 512 * m; if (idx < 1280) WL[idx] = wl7[m]; } }
            if (i == 7) __syncthreads();
            if (live) {
            const f32x4 g = *(const f32x4*)(gain + e0);
            float hn[4][4];
#pragma unroll
            for (int rr = 0; rr < 4; ++rr) { const f32x4 v = ld_h4nt(RS, DLT, (size_t)(row0 + rr) * DM + e0);
                ss[rr] += (v[0] * v[0] + v[1] * v[1]) + (v[2] * v[2] + v[3] * v[3]);
#pragma unroll
                for (int c = 0; c < 4; ++c) hn[rr][c] = v[c] * g[c];
                u32x2 o; o.x = cvtpk(hn[rr][0], hn[rr][1]); o.y = cvtpk(hn[rr][2], hn[rr][3]); *(u32x2*)(HN + (size_t)(row0 + rr) * DM + e0) = o; }
#pragma unroll
            for (int c = 0; c < 4; ++c) { const f32x4 w4 = WL[((i % 7) * 20 + c * 5) * 64 + lane];
#pragma unroll
                for (int rr = 0; rr < 4; ++rr)
#pragma unroll
                    for (int j = 0; j < 4; ++j) lg[rr][j] += hn[rr][c] * w4[j];
#pragma unroll
                for (int q = 0; q < 4; ++q) { const f32x4 w16 = WL[((i % 7) * 20 + c * 5 + 1 + q) * 64 + lane];
#pragma unroll
                    for (int rr = 0; rr < 4; ++rr)
#pragma unroll
                        for (int j = 0; j < 4; ++j) lg[rr][4 + q * 4 + j] += hn[rr][c] * w16[j]; } } } }
        float rstd[4];
#pragma unroll
        for (int rr = 0; rr < 4; ++rr) rstd[rr] = rsqrtf(wave_sum(ss[rr]) * (1.f / DM) + EPS);
#pragma unroll
        for (int rr = 0; rr < 4; ++rr)
#pragma unroll
            for (int j = 0; j < 20; ++j) lg[rr][j] = wave_sum(lg[rr][j]) * rstd[rr];
        if (live && lane < 4) WSP(float, WS_RSTD)[row0 + lane] = lane == 0 ? rstd[0] : (lane == 1 ? rstd[1] : (lane == 2 ? rstd[2] : rstd[3]));
        if (live && lane < 4) {
            float lgs[20];
#pragma unroll
            for (int j = 0; j < 20; ++j) lgs[j] = lane == 0 ? lg[0][j] : (lane == 1 ? lg[1][j] : (lane == 2 ? lg[2][j] : lg[3][j]));
            const int row = row0 + lane;
            float gl[4]; int grp = 0; float gmax;
#pragma unroll
            for (int j = 0; j < 4; ++j) gl[j] = lgs[j] + bg[j];
            gmax = gl[0];
#pragma unroll
            for (int j = 1; j < 4; ++j) if (gl[j] > gmax) { gmax = gl[j]; grp = j; }
            float den = 0.f;
#pragma unroll
            for (int j = 0; j < 4; ++j) den += expf(gl[j] - gmax);
            const float pgrp = 1.f / den;
            float el[4];
#pragma unroll
            for (int j = 0; j < 4; ++j) { float sv = 0.f;
#pragma unroll
                for (int q = 0; q < 4; ++q) sv = (grp == q) ? (lgs[4 + q * 4 + j] + be[q * 4 + j]) : sv;
                el[j] = sv; }
            int i0 = 0; float v0 = el[0];
#pragma unroll
            for (int j = 1; j < 4; ++j) if (el[j] > v0) { v0 = el[j]; i0 = j; }
            int i1 = -1; float v1 = 0.f;
#pragma unroll
            for (int j = 0; j < 4; ++j) if (j != i0 && (i1 < 0 || el[j] > v1)) { v1 = el[j]; i1 = j; }
            const float e1 = expf(v1 - v0), inv = 1.f / (1.f + e1);
            EID[row * 2] = grp * 4 + i0; EID[row * 2 + 1] = grp * 4 + i1; WGT[row * 2] = inv * pgrp; WGT[row * 2 + 1] = e1 * inv * pgrp;
        }
    }
}

DEV void phase_lists(const Args& a, LAS char* lds, int wv) {
    if (blockIdx.x >= 16) return;
    const int e = blockIdx.x, tid = otid(wv), lane = tid & 63, wid = tid >> 6;
    LAS int* cnt = (LAS int*)lds; LAS int* ts = cnt + 16; LAS int* wtot = ts + 32;
    const int* EID = WSP(int, WS_EID); const float* WGT = WSP(float, WS_WGT); int* SLOTOF = WSP(int, WS_SLOTOF); int* PERM = WSP(int, WS_PERM); float* SLOTW = WSP(float, WS_SLOTW); int* TST = WSP(int, WS_TSTART); float* SLOTR = WSP(float, WS_SLOTR); const float* RSTD = WSP(float, WS_RSTD);
    if (tid < 16) cnt[tid] = 0;
    __syncthreads();
    int mine = 0;
    for (int i = 0; i < 16; ++i) { const int t = tid * 16 + i; const int e0 = EID[t * 2], e1 = EID[t * 2 + 1];
        __hip_atomic_fetch_add(&cnt[e0], 1, __ATOMIC_RELAXED, __HIP_MEMORY_SCOPE_WORKGROUP); __hip_atomic_fetch_add(&cnt[e1], 1, __ATOMIC_RELAXED, __HIP_MEMORY_SCOPE_WORKGROUP);
        mine += (e0 == e || e1 == e) ? 1 : 0; }
    int incl = mine;
#pragma unroll
    for (int o = 1; o < 64; o <<= 1) { const int y = __shfl_up(incl, o); if (lane >= o) incl += y; }
    if (lane == 63) wtot[wid] = incl;
    __syncthreads();
    if (tid == 0) { int acc = 0; for (int j = 0; j < 16; ++j) { ts[j] = acc; acc += (cnt[j] + 255) / 256; } ts[16] = acc;
        if (e == 0) { for (int j = 0; j <= 16; ++j) TST[j] = ts[j];
            int* TL = WSP(int, WS_TILES); int n = 0;
            for (int pass = 0; pass < 2; ++pass)
                for (int j = 0; j < 16; ++j) { const int nt = ts[j + 1] - ts[j];
                    for (int t = 0; t < nt; ++t) { const int p = ts[j] + t, rows = cnt[j] - 256 * t, hf = (rows <= 128) ? 1 : 0;
                        if (pass == 0) { TL[96 + p] = j; TL[192 + p] = hf; } if (hf == pass) TL[n++] = p; } } } }
    __syncthreads();
    int base = incl - mine; for (int w = 0; w < wid; ++w) base += wtot[w];
    const int start = ts[e] * 256, n_e = cnt[e], end = ts[e + 1] * 256;
    int slot = start + base;
    for (int i = 0; i < 16; ++i) { const int t = tid * 16 + i; const int e0 = EID[t * 2], e1 = EID[t * 2 + 1];
        if (e0 == e) { PERM[slot] = t; SLOTW[slot] = WGT[t * 2]; SLOTR[slot] = RSTD[t]; SLOTOF[t * 2] = slot; ++slot; }
        else if (e1 == e) { PERM[slot] = t; SLOTW[slot] = WGT[t * 2 + 1]; SLOTR[slot] = RSTD[t]; SLOTOF[t * 2 + 1] = slot; ++slot; } }
    for (int s = start + n_e + tid; s < end; s += 512) { PERM[s] = 0; SLOTW[s] = 0.f; SLOTR[s] = 0.f; }
}
DEV void phase_gather(const Args& a, int wv) {
    const int wid = __builtin_amdgcn_readfirstlane(otid(wv) >> 6), lane = otid(wv) & 63;
    const int* PERM = WSP(int, WS_PERM); const bf16_t* HN = WSP(bf16_t, WS_XN); bf16_t* AP = WSP(bf16_t, B_APERM);
    const int rows = ld_agent_i(WSP(int, WS_TSTART) + 16) * 256;
    for (int r = blockIdx.x * 8 + wid; r < rows; r += gridDim.x * 8) { const int t = PERM[r];
        const u32x4* s = (const u32x4*)(HN + (size_t)t * DM); u32x4* d = (u32x4*)(AP + (size_t)r * DM);
#pragma unroll
        for (int i = 0; i < 4; ++i) d[lane + 64 * i] = s[lane + 64 * i]; }
}

DEV int v_st2(int k, int c) { const int kk = (k & ~0xC) | ((k & 4) << 1) | ((k & 8) >> 1); return ((kk >> 3) * 2 + (c >> 5)) * 512 + ((kk & 7) * 32 + (c & 31)) * 2; }
DEV int v_rd_base(int lane) { return ((lane & 3) << 3) | (((lane >> 2) & 3) << 6) | (((lane >> 4) & 1) << 5) | (((lane >> 5) & 1) << 8); }
template <int OFF> DEV s16x4 tr_read(int vb) { s16x4 r; asm volatile("ds_read_b64_tr_b16 %0, %1 offset:%2" : "=&v"(r) : "v"(vb), "i"(OFF) : "memory"); return r; }
template <int OFF> DEV s16x4 tr_rd(const LAS char* b) { return __builtin_amdgcn_ds_read_tr16_b64_v4i16((LAS s16x4*)(b + OFF)); }
#define PKV(L, H) (bf16x8){L[0], L[1], L[2], L[3], H[0], H[1], H[2], H[3]}

namespace mla {
constexpr int LDQ = 768, LDK = 768, LDV = 1792, LDO = 2048, KVBLK = 64, QBLK = 32;
constexpr float SCALE = 0.10206207261596575f, THR = 8.f;
constexpr int SHM_V = 8192, SHM_K = 16384;
#define KSWZ(row, colB) ((row) * 256 + ((colB) ^ (((row) & 15) << 4)))
template <bool NOMAX, int PRB = 0, bool EXPDONE = false> DEV void partialSM(f32x16& p0, f32x16& p1, float& m_reg, float& mn, float& alpha) {
  if constexpr (NOMAX) {
    mn = 0.f; alpha = 1.f;
    if constexpr (PRB != 2 && !EXPDONE) {
#pragma unroll
    for (int r = 0; r < 16; ++r) p0[r] = __builtin_amdgcn_exp2f(p0[r]); }
    return;
  }
  float pmax = p0[0];
#pragma unroll
  for (int r = 1; r < 16; ++r) pmax = fmaxf(pmax, p0[r]);
#pragma unroll
  for (int r = 0; r < 16; ++r) pmax = fmaxf(pmax, p1[r]);
  { auto rr = __builtin_amdgcn_permlane32_swap(__float_as_uint(pmax), __float_as_uint(pmax), false, false);
    pmax = fmaxf(__uint_as_float(rr[0]), __uint_as_float(rr[1])); }
  if (__builtin_expect(__all(pmax - m_reg <= THR * LOG2E), 1)) { mn = m_reg; alpha = 1.f; }
  else { mn = fmaxf(m_reg, pmax); alpha = __builtin_amdgcn_exp2f(m_reg - mn); m_reg = mn; }
#pragma unroll
  for (int r = 0; r < 16; ++r) p0[r] = p0[r] - mn;
#pragma unroll
  for (int r = 0; r < 16; ++r) p1[r] = p1[r] - mn;
#pragma unroll
  for (int r = 0; r < 16; ++r) p0[r] = __builtin_amdgcn_exp2f(p0[r]);
}
DEV void finishSM(f32x16& p0, f32x16& p1, float alpha, float& l_reg, bf16x8& pa0, bf16x8& pa1, bf16x8& pa2, bf16x8& pa3) {
#pragma unroll
  for (int r = 0; r < 16; ++r) p1[r] = __builtin_amdgcn_exp2f(p1[r]);
  f32x2 ps2 = {0.f, 0.f};
#pragma unroll
  for (int r = 0; r < 16; r += 2) ps2 += mk2(p0[r], p0[r + 1]);
#pragma unroll
  for (int r = 0; r < 16; r += 2) ps2 += mk2(p1[r], p1[r + 1]);
  float ps = ps2[0] + ps2[1];
  { auto rr = __builtin_amdgcn_permlane32_swap(__float_as_uint(ps), __float_as_uint(ps), false, false);
    ps = __uint_as_float(rr[0]) + __uint_as_float(rr[1]); }
  l_reg = l_reg * alpha + ps;
  PK4(p0, 0, pa0); PK4(p0, 8, pa1); PK4(p1, 0, pa2); PK4(p1, 8, pa3);
}
DEV void qkt(f32x16& p0, f32x16& p1, const LAS char* Ks, const bf16x8* qr, int r32, int hi) {
  p0 = f32x16{}; p1 = f32x16{};
  bf16x8 b0 = *(const LAS bf16x8*)(Ks + KSWZ(r32, hi * 16)), b1 = *(const LAS bf16x8*)(Ks + KSWZ(32 + r32, hi * 16));
#pragma unroll
  for (int d0 = 0; d0 < 6; ++d0) {
    bf16x8 n0 = b0, n1 = b1;
    if (d0 + 1 < 6) { const int cb = ((d0 + 1) * 16 + hi * 8) * 2; n0 = *(const LAS bf16x8*)(Ks + KSWZ(r32, cb)); n1 = *(const LAS bf16x8*)(Ks + KSWZ(32 + r32, cb)); }
    SBAR();
    p0 = MFMA32(b0, qr[d0], p0); p1 = MFMA32(b1, qr[d0], p1);
    SBAR();
    b0 = n0; b1 = n1; }
}
template <int PRB = 0> DEV void qkt_fin(f32x16& n0, f32x16& n1, const LAS char* Ks, const bf16x8* qr, int r32, int hi, bf16x8 b0, bf16x8 b1,
                 f32x16& p0, f32x16& p1, float alpha, float& l_reg, bf16x8& pa0, bf16x8& pa1, bf16x8& pa2, bf16x8& pa3) {
  n0 = f32x16{}; n1 = f32x16{};
  bf16x8 c0, c1;
  f32x2 ps2; float ps;
#define QF_STEP(D0, CUR0, CUR1, NXT0, NXT1, WORK) do { \
    if ((D0) + 1 < 6) { const int cb_ = (((D0) + 1) * 16 + hi * 8) * 2; NXT0 = *(const LAS bf16x8*)(Ks + KSWZ(r32, cb_)); NXT1 = *(const LAS bf16x8*)(Ks + KSWZ(32 + r32, cb_)); } \
    SBAR(); if constexpr (PRB != 5) { n0 = MFMA32(CUR0, qr[D0], n0); n1 = MFMA32(CUR1, qr[D0], n1); } else { asm volatile("" :: "v"(CUR0), "v"(CUR1)); } WORK; SBAR(); } while (0)
  QF_STEP(0, b0, b1, c0, c1, { _Pragma("unroll") for (int r = 0; r < 6; ++r) p1[r] = (PRB == 2) ? p1[r] : __builtin_amdgcn_exp2f(p1[r]); });
  QF_STEP(1, c0, c1, b0, b1, { _Pragma("unroll") for (int r = 6; r < 12; ++r) p1[r] = (PRB == 2) ? p1[r] : __builtin_amdgcn_exp2f(p1[r]); });
  QF_STEP(2, b0, b1, c0, c1, { _Pragma("unroll") for (int r = 12; r < 16; ++r) p1[r] = (PRB == 2) ? p1[r] : __builtin_amdgcn_exp2f(p1[r]); ps2 = mk2(p0[0], p0[1]); _Pragma("unroll") for (int r = 2; r < 8; r += 2) ps2 += mk2(p0[r], p0[r + 1]); });
  QF_STEP(3, c0, c1, b0, b1, { _Pragma("unroll") for (int r = 8; r < 16; r += 2) ps2 += mk2(p0[r], p0[r + 1]); _Pragma("unroll") for (int r = 0; r < 8; r += 2) ps2 += mk2(p1[r], p1[r + 1]); });
  QF_STEP(4, b0, b1, c0, c1, { _Pragma("unroll") for (int r = 8; r < 16; r += 2) ps2 += mk2(p1[r], p1[r + 1]); ps = ps2[0] + ps2[1];
      { auto rr = __builtin_amdgcn_permlane32_swap(__float_as_uint(ps), __float_as_uint(ps), false, false); ps = __uint_as_float(rr[0]) + __uint_as_float(rr[1]); }
      l_reg = l_reg * alpha + ps; PK4(p0, 0, pa0); PK4(p0, 8, pa1); });
  QF_STEP(5, c0, c1, b0, b1, { PK4(p1, 0, pa2); PK4(p1, 8, pa3); });
#undef QF_STEP
}
constexpr int v_rd_off(int d0, int ks, int half) { return d0 * 512 + ks * 2048 + half * 1024; }
template <int D0, int BO = 0, int PRB = 0> DEV void pv_one(f32x16& od, int vb, bf16x8 pa0, bf16x8 pa1, bf16x8 pa2, bf16x8 pa3) {
  const s16x4 l0 = tr_read<BO + v_rd_off(D0, 0, 0)>(vb), h0 = tr_read<BO + v_rd_off(D0, 0, 1)>(vb), l1 = tr_read<BO + v_rd_off(D0, 1, 0)>(vb), h1 = tr_read<BO + v_rd_off(D0, 1, 1)>(vb);
  const s16x4 l2 = tr_read<BO + v_rd_off(D0, 2, 0)>(vb), h2 = tr_read<BO + v_rd_off(D0, 2, 1)>(vb), l3 = tr_read<BO + v_rd_off(D0, 3, 0)>(vb), h3 = tr_read<BO + v_rd_off(D0, 3, 1)>(vb);
  asm volatile("s_waitcnt lgkmcnt(0)" ::: "memory"); SBAR();
  if constexpr (PRB != 5) { od = MFMA32(pa0, PKV(l0, h0), od); od = MFMA32(pa1, PKV(l1, h1), od); od = MFMA32(pa2, PKV(l2, h2), od); od = MFMA32(pa3, PKV(l3, h3), od); }
  else asm volatile("" :: "v"(l0), "v"(h0), "v"(l1), "v"(h1), "v"(l2), "v"(h2), "v"(l3), "v"(h3), "v"(pa0), "v"(pa1), "v"(pa2), "v"(pa3));
}
#define KFR(Ks_, D_, A_, B_) do { const int cb_ = ((D_) * 16 + hi * 8) * 2; A_ = *(const LAS bf16x8*)((Ks_) + KSWZ(r32, cb_)); B_ = *(const LAS bf16x8*)((Ks_) + KSWZ(32 + r32, cb_)); } while (0)
#define VRD8(VF, D0, BO) do { VF[0] = tr_rd<(BO) + v_rd_off(D0, 0, 0)>(vbp); VF[1] = tr_rd<(BO) + v_rd_off(D0, 0, 1)>(vbp); VF[2] = tr_rd<(BO) + v_rd_off(D0, 1, 0)>(vbp); VF[3] = tr_rd<(BO) + v_rd_off(D0, 1, 1)>(vbp); \
    VF[4] = tr_rd<(BO) + v_rd_off(D0, 2, 0)>(vbp); VF[5] = tr_rd<(BO) + v_rd_off(D0, 2, 1)>(vbp); VF[6] = tr_rd<(BO) + v_rd_off(D0, 3, 0)>(vbp); VF[7] = tr_rd<(BO) + v_rd_off(D0, 3, 1)>(vbp); } while (0)
template <int PRB, int VBO> DEV void qkt_fin2(f32x16& n0, f32x16& n1, const LAS char* Ks, const bf16x8* qr, int r32, int hi, bf16x8 f0a, bf16x8 f0b, bf16x8 f1a, bf16x8 f1b, const LAS char* vbp, s16x4* vf0,
                 f32x16& p0, f32x16& p1, float alpha, float& l_reg, bf16x8& pa0, bf16x8& pa1, bf16x8& pa2, bf16x8& pa3) {
  n0 = f32x16{}; n1 = f32x16{};
  bf16x8 ga = f0a, gb = f0b; f32x2 ps2; float ps;
#define QF2(D0, CA, CB, NA, NB, PRE, WA, WB) do { if constexpr (PRB < 7) { if ((D0) + 2 < 6) KFR(Ks, (D0) + 2, NA, NB); PRE; } else { asm volatile("" : "+v"(NA), "+v"(NB)); } \
    SBAR(); if constexpr (PRB != 5) n0 = MFMA32(CA, qr[D0], n0); else asm volatile("" :: "v"(CA)); WA; SBAR(); \
    if constexpr (PRB != 5) n1 = MFMA32(CB, qr[D0], n1); else asm volatile("" :: "v"(CB)); WB; SBAR(); } while (0)
#define EX_(r) p1[r] = (PRB == 2 || PRB == 8) ? p1[r] : __builtin_amdgcn_exp2f(p1[r])
  QF2(0, f0a, f0b, ga, gb, {}, { EX_(0); EX_(1); EX_(2); }, { EX_(3); EX_(4); EX_(5); });
  QF2(1, f1a, f1b, f0a, f0b, { VRD8(vf0, 0, VBO); }, { EX_(6); EX_(7); EX_(8); }, { EX_(9); EX_(10); EX_(11); });
  QF2(2, ga, gb, f1a, f1b, {}, { EX_(12); EX_(13); EX_(14); EX_(15); }, { ps2 = mk2(p0[0], p0[1]); _Pragma("unroll") for (int r = 2; r < 8; r += 2) ps2 += mk2(p0[r], p0[r + 1]); });
  QF2(3, f0a, f0b, ga, gb, {}, { _Pragma("unroll") for (int r = 8; r < 16; r += 2) ps2 += mk2(p0[r], p0[r + 1]); }, { _Pragma("unroll") for (int r = 0; r < 8; r += 2) ps2 += mk2(p1[r], p1[r + 1]); });
  QF2(4, f1a, f1b, f0a, f0b, {}, { _Pragma("unroll") for (int r = 8; r < 16; r += 2) ps2 += mk2(p1[r], p1[r + 1]); ps = ps2[0] + ps2[1];
      { auto rr = __builtin_amdgcn_permlane32_swap(__float_as_uint(ps), __float_as_uint(ps), false, false); ps = __uint_as_float(rr[0]) + __uint_as_float(rr[1]); }
      l_reg = l_reg * alpha + ps; }, { PK4(p0, 0, pa0); PK4(p0, 8, pa1); });
  QF2(5, ga, gb, f0a, f0b, {}, { PK4(p1, 0, pa2); }, { PK4(p1, 8, pa3); });
#undef QF2
#undef EX_
}
template <bool NOMAX, int PRB, int VBO> DEV void pv2(f32x16& o0, f32x16& o1, const LAS char* vbp, const s16x4* vf0, bf16x8 pa0, bf16x8 pa1, bf16x8 pa2, bf16x8 pa3, f32x16& pn0) {
  s16x4 vf1[8]; if constexpr (PRB < 7) { VRD8(vf1, 1, VBO); } else { _Pragma("unroll") for (int i = 0; i < 8; ++i) { vf1[i] = vf0[i]; asm volatile("" : "+v"(vf1[i])); } }
#define EX2(r) do { if constexpr (NOMAX && PRB != 2 && PRB != 8) { pn0[r] = __builtin_amdgcn_exp2f(pn0[r]); pn0[(r) + 1] = __builtin_amdgcn_exp2f(pn0[(r) + 1]); } } while (0)
#define PVM(OD, PA, L, H, R) do { SBAR(); if constexpr (PRB != 5) OD = MFMA32(PA, PKV(L, H), OD); else asm volatile("" :: "v"(L), "v"(H), "v"(PA)); EX2(R); SBAR(); } while (0)
  PVM(o0, pa0, vf0[0], vf0[1], 0); PVM(o0, pa1, vf0[2], vf0[3], 2); PVM(o0, pa2, vf0[4], vf0[5], 4); PVM(o0, pa3, vf0[6], vf0[7], 6);
  PVM(o1, pa0, vf1[0], vf1[1], 8); PVM(o1, pa1, vf1[2], vf1[3], 10); PVM(o1, pa2, vf1[4], vf1[5], 12); PVM(o1, pa3, vf1[6], vf1[7], 14);
#undef PVM
#undef EX2
}
template <bool NOMAX, int PRB = 0> DEV void attn_unit(const bf16_t* __restrict__ Qb, const bf16_t* __restrict__ Kh, const bf16_t* __restrict__ Vh, bf16_t* __restrict__ Ob, int seq, LAS char* lds, int wv) {
  const int tid = otid(wv), wid = tid >> 6, lane = tid & 63, r32 = lane & 31, hi = lane >> 5;
  LAS char* K_lds = lds; LAS char* V_lds = lds + 4 * SHM_K;
  LAS float* ws = (LAS float*)(lds + 4 * SHM_V + 4 * SHM_K) + wid * 64; LAS float* li_l = ws; LAS float* al_l = ws + 32;
  float m_reg = -1e30f, l_reg = 0; f32x16 o[2] = {}; bf16x8 qr[6];
  const bf16_t* Qw = Qb + (long)(wid * QBLK + r32) * LDQ + hi * 8;
#pragma unroll
  for (int d0 = 0; d0 < 6; ++d0) qr[d0] = *reinterpret_cast<const bf16x8*>(Qw + d0 * 16);
  const int vrow = tid >> 3, vc8 = (tid & 7) * 8, kc1 = tid, kc2 = 512 + (tid & 255);
  const int kr1 = kc1 / 12, kch1 = kc1 % 12, kr2 = kc2 / 12, kch2 = kc2 % 12;
  const int vst = v_st2(vrow, vc8), kst1 = KSWZ(kr1, kch1 * 16), kst2 = KSWZ(kr2, kch2 * 16);
  const bf16_t* vsrc = Vh + (long)vrow * LDV + vc8; const bf16_t* ksrc1 = Kh + (long)kr1 * LDK + kch1 * 8; const bf16_t* ksrc2 = Kh + (long)kr2 * LDK + kch2 * 8;
  const int vb0 = (int)(unsigned)(uintptr_t)V_lds + v_rd_base(lane);
  struct { bf16x8 vs, k1, k2; } sr_[2];
  const __amdgpu_buffer_rsrc_t rsK = __builtin_amdgcn_make_buffer_rsrc((void*)Kh, (short)0, 0x40000000, 0x00020000), rsV = __builtin_amdgcn_make_buffer_rsrc((void*)Vh, (short)0, 0x40000000, 0x00020000);
  const int vgo = (vrow * LDV + vc8) * 2, kgo1 = (kr1 * LDK + kch1 * 8) * 2, kgo2 = (kr2 * LDK + kch2 * 8) * 2;
#define SLOAD(i, t_) do { sr_[i].vs = __builtin_bit_cast(bf16x8, __builtin_amdgcn_raw_buffer_load_b128(rsV, vgo, (t_) * (KVBLK * LDV * 2), 0)); \
    sr_[i].k1 = __builtin_bit_cast(bf16x8, __builtin_amdgcn_raw_buffer_load_b128(rsK, kgo1, (t_) * (KVBLK * LDK * 2), 0)); sr_[i].k2 = __builtin_bit_cast(bf16x8, __builtin_amdgcn_raw_buffer_load_b128(rsK, kgo2, (t_) * (KVBLK * LDK * 2), 0)); } while (0)
#define SWRITE(b, i) do { *(LAS bf16x8*)(V_lds + (b) * SHM_V + vst) = sr_[i].vs; *(LAS bf16x8*)(K_lds + (b) * SHM_K + kst1) = sr_[i].k1; *(LAS bf16x8*)(K_lds + (b) * SHM_K + kst2) = sr_[i].k2; } while (0)
#define SWAIT() asm volatile("s_waitcnt vmcnt(3)" ::: "memory")
#define RESC(a_) do { if (!NOMAX && __any((a_) < 1.f)) { if (hi == 0) al_l[r32] = (a_); asm volatile("s_waitcnt lgkmcnt(0)" ::: "memory"); \
    _Pragma("unroll") for (int d = 0; d < 2; ++d) _Pragma("unroll") for (int r = 0; r < 16; ++r) o[d][r] *= al_l[crow(r, hi)]; } } while (0)
#define PVD(B_) do { pv_one<0, (B_) * SHM_V, PRB>(o[0], vb0, pa0, pa1, pa2, pa3); pv_one<1, (B_) * SHM_V, PRB>(o[1], vb0, pa0, pa1, pa2, pa3); } while (0)
  f32x16 pA0, pA1, pB0, pB1; float mnA, mnB, alA, alB; bf16x8 pa0, pa1, pa2, pa3; constexpr int NT = S_ / KVBLK;
  constexpr int SE = 0, SO = 1;
  SLOAD(SE, 0); asm volatile("s_waitcnt vmcnt(0)" ::: "memory"); SWRITE(0, SE); __syncthreads();
  qkt(pA0, pA1, K_lds, qr, r32, hi); partialSM<NOMAX>(pA0, pA1, m_reg, mnA, alA);
  SLOAD(SO, 1); SLOAD(SE, 2);
  asm volatile("s_waitcnt vmcnt(0)" ::: "memory"); SWRITE(1, SO); SWRITE(2, SE);
  SLOAD(SO, 3);
  __syncthreads();
  const LAS char* vbp = V_lds + v_rd_base(lane);
#define KPRE(buf) do { KFR(K_lds + (buf) * SHM_K, 0, pre0, pre1); KFR(K_lds + (buf) * SHM_K, 1, pre2, pre3); } while (0)
  bf16x8 pre0, pre1, pre2, pre3; KPRE(1);
  s16x4 vf0[8];
#define HALF(T, BP, BC, B1, BW, PN0, PN1, PO0, PO1, MNN, ALN, ALO, SL, SW, DOLOAD, DOWRITE) do { \
    SBAR(); qkt_fin2<PRB, (BP) * SHM_V>(PN0, PN1, K_lds + (BC) * SHM_K, qr, r32, hi, pre0, pre1, pre2, pre3, vbp, vf0, PO0, PO1, ALO, l_reg, pa0, pa1, pa2, pa3); SBAR(); \
    if (DOLOAD && PRB != 4 && PRB < 7) SLOAD(SL, (T) + 3); SBAR(); \
    pv2<NOMAX, PRB, (BP) * SHM_V>(o[0], o[1], vbp, vf0, pa0, pa1, pa2, pa3, PN0); partialSM<NOMAX, PRB, true>(PN0, PN1, m_reg, MNN, ALN); \
    if constexpr (PRB < 7) { SWAIT(); if (DOWRITE && PRB != 4) SWRITE(BW, SW); KPRE(B1); } \
    RESC(ALN); if constexpr (PRB != 3 && PRB < 7) __syncthreads(); } while (0)
  static_assert(NT % 4 == 0 && NT >= 8, "tile loop is unrolled by four");
  for (int j = 1; j + 6 < NT; j += 4) {
    HALF(j,     0, 1, 2, 3, pB0, pB1, pA0, pA1, mnB, alB, alA, SE, SO, true, true);
    HALF(j + 1, 1, 2, 3, 0, pA0, pA1, pB0, pB1, mnA, alA, alB, SO, SE, true, true);
    HALF(j + 2, 2, 3, 0, 1, pB0, pB1, pA0, pA1, mnB, alB, alA, SE, SO, true, true);
    HALF(j + 3, 3, 0, 1, 2, pA0, pA1, pB0, pB1, mnA, alA, alB, SO, SE, true, true);
  }
  HALF(NT - 3, 0, 1, 2, 3, pB0, pB1, pA0, pA1, mnB, alB, alA, SE, SO, false, true);
  HALF(NT - 2, 1, 2, 3, 0, pA0, pA1, pB0, pB1, mnA, alA, alB, SO, SE, false, false);
  SBAR(); qkt(pB0, pB1, K_lds + 3 * SHM_K, qr, r32, hi);
  finishSM(pA0, pA1, alA, l_reg, pa0, pa1, pa2, pa3); SBAR();
  PVD(2); partialSM<NOMAX>(pB0, pB1, m_reg, mnB, alB);
  RESC(alB);
  finishSM(pB0, pB1, alB, l_reg, pa0, pa1, pa2, pa3); SBAR();
  PVD(3);
#undef HALF
#undef KPRE
  if constexpr (PRB != 0) { asm volatile("" :: "v"(o[0]), "v"(o[1]), "v"(l_reg)); __syncthreads(); return; }
  if (hi == 0) li_l[r32] = l_reg; asm volatile("s_waitcnt lgkmcnt(0)" ::: "memory");
  float rli[16];
#pragma unroll
  for (int r = 0; r < 16; ++r) rli[r] = __builtin_amdgcn_rcpf(li_l[crow(r, hi)]);
  bf16_t* Ow = Ob + (long)(wid * QBLK) * LDO;
#pragma unroll
  for (int r = 0; r < 16; ++r) { const int orow = crow(r, hi);
#pragma unroll
    for (int d0 = 0; d0 < 2; ++d0) Ow[(long)orow * LDO + d0 * 32 + r32] = f2bf(o[d0][r] * rli[r]); }
  __syncthreads();
#undef SLOAD
#undef SWRITE
#undef SWAIT
#undef RESC
#undef PVD
}
DEV bool bound_ok(const float* gq, const float* gk, int lane) {
  float bq = fmaxf(fabsf(gq[lane]), lane < 32 ? fabsf(gq[64 + lane]) : 0.f), bk = fmaxf(fabsf(gk[lane]), lane < 32 ? fabsf(gk[64 + lane]) : 0.f);
#pragma unroll
  for (int o = 1; o < 64; o <<= 1) { bq = fmaxf(bq, __shfl_xor(bq, o)); bk = fmaxf(bk, __shfl_xor(bk, o)); }
  return 9.797958971f * bq * bk * 1.01f * LOG2E <= 64.f;
}
}

DEV int kswz128(int row, int cb) { return row * 128 + (cb ^ (((row >> 1) & 7) << 4)); }
struct DilU { int p, hd, res, B, d, nsub; };
DEV DilU dil_decode(int u) { DilU x; x.p = u / 384; const int v = u % 384, w = v % 32; x.hd = v / 32; const int nb = (x.p == 0) ? 32 : (x.p == 1 ? 8 : 2);
  x.res = w / nb; x.B = w % nb; x.d = (x.p == 0) ? 1 : (x.p == 1 ? 4 : 16); x.nsub = S_ / x.d; return x; }
DEV void dil_load(const bf16_t* PROJ, const DilU& x, int tid, u32x4 (&st)[12]) {
  const int r0 = tid >> 4, ch = tid & 15, j0 = 256 * x.B - 64 + r0;
  const int col = (ch < 8) ? (OFF_DK + x.hd * 64 + ch * 8) : (OFF_DV + x.hd * 64 + (ch - 8) * 8);
  const bf16_t* gp = PROJ + ((long)x.res + (long)x.d * j0) * CINP + col; const long gs = (long)32 * x.d * CINP;
#pragma unroll
  for (int i = 0; i < 12; ++i) { const int jj = j0 + 32 * i; u32x4 v = zero4(); if (jj >= 0 && jj < x.nsub) v = *(const u32x4*)(gp + i * gs); st[i] = v; }
}
DEV void dil_loadq(const bf16_t* PROJ, const DilU& x, int wid, int r32, int hi, bf16x8 (&qr)[4]) {
  const long tokq = (long)x.res + (long)x.d * (256 * x.B + 32 * wid + r32);
#pragma unroll
  for (int d0 = 0; d0 < 4; ++d0) qr[d0] = *reinterpret_cast<const bf16x8*>(PROJ + tokq * CINP + OFF_DQ + x.hd * 64 + d0 * 16 + hi * 8);
}
DEV void phase_dilated(const Args& a, LAS char* lds, int wv) {
  const int tid = otid(wv), wid = tid >> 6, lane = tid & 63, r32 = lane & 31, hi = lane >> 5; const int G = gridDim.x;
  const bf16_t* PROJ = WSP(bf16_t, A_PROJ);
  LAS char* KI = lds; LAS char* VI = lds + 49152; LAS float* wsf = (LAS float*)(lds + 98304) + wid * 64; LAS float* biasall = (LAS float*)(lds + 98304 + 2048); LAS float* bshift = (LAS float*)(lds + 98304 + 2048 + 19008);
  for (int i = tid; i < 36 * 129; i += 512) { const int ph = i / 129, k = i % 129; biasall[ph * 132 + k] = a.rel_bias[(int)c_bucket[ph / 12][k] * 12 + (ph % 12)] * LOG2E; }
  int u = blockIdx.x; if (u >= 1152) return;
  u32x4 st[12];
  { const DilU x0 = dil_decode(u); dil_load(PROJ, x0, tid, st); }
  for (; u < 1152; u += G) {
    const DilU x = dil_decode(u); const int p = x.p, hd = x.hd, res = x.res, B = x.B, d = x.d, nsub = x.nsub;
    bf16_t* DPART = WSP(bf16_t, A_DPART) + (size_t)p * S_ * 768; float* DLSE = WSP(float, A_DLSE) + (size_t)p * S_ * 12;
    bf16x8 qr[4]; dil_loadq(PROJ, x, wid, r32, hi, qr);
    { const LAS float* bsrc = biasall + (p * 12 + hd) * 132;
      for (int i = tid; i < 800; i += 512) { const int sh = i / 200, j = i % 200, k = j + sh - 32; bshift[i] = ((unsigned)k <= 128u) ? bsrc[k] : 0.f; } }
    { const int r0 = tid >> 4, ch = tid & 15;
      LAS char* lb = (ch < 8) ? (KI + kswz128(r0, ch * 16)) : (VI + v_st2(r0, (ch - 8) * 8));
#pragma unroll
      for (int i = 0; i < 12; ++i) *(LAS u32x4*)(lb + i * 4096) = st[i]; }
    asm volatile("s_waitcnt lgkmcnt(0)\n\ts_barrier" ::: "memory");
    asm volatile("" : "+v"(qr[0]), "+v"(qr[1]), "+v"(qr[2]), "+v"(qr[3]));
    if (u + G < 1152) { const DilU xn = dil_decode(u + G); dil_load(PROJ, xn, tid, st); }
    const int j0 = 256 * B - 64;
    constexpr float C = 0.125f * LOG2E;
    float m, l; f32x16 o[2];
    const int vbase = (int)(unsigned)(uintptr_t)VI + v_rd_base(lane) + 2 * wid * 2048;
    for (int rp_ = 0; rp_ < ((DUP_K == 30) ? 2 : 1); ++rp_) {
    f32x16 sc[5]; bf16x8 kfa[4], kfb[4]; float mx = -INFINITY;
#define DIL_KRD(dst, kb_) do { _Pragma("unroll") for (int d0 = 0; d0 < 4; ++d0) dst[d0] = *(const LAS bf16x8*)(KI + kswz128(32 * wid + 32 * (kb_) + r32, (d0 * 16 + hi * 8) * 2)); } while (0)
#define DIL_QK(src, kb_) do { sc[kb_] = f32x16{}; _Pragma("unroll") for (int d0 = 0; d0 < 4; ++d0) sc[kb_] = MFMA32(src[d0], qr[d0], sc[kb_]); } while (0)
#define DIL_TR(kb_) do { _Pragma("unroll") for (int g = 0; g < 4; ++g) { const f32x4 bq_ = *(const LAS f32x4*)(bbase_ + (32 * (kb_) + 8 * g) * 4); \
      _Pragma("unroll") for (int e = 0; e < 4; ++e) { const int i = 4 * g + e, bi = 32 * (kb_) + 8 * g + e - rq_, jj = jq_ + 32 * (kb_) + 8 * g + e; \
        const bool valid = ((unsigned)bi <= 128u) && ((unsigned)jj < (unsigned)nsub); \
        sc[kb_][i] = fmaf(sc[kb_][i], C, bq_[e]) + (valid ? 0.f : -INFINITY); mx = fmaxf(mx, sc[kb_][i]); } } } while (0)
    int rq_ = r32 - 4 * hi, jq_ = j0 + 32 * wid + 4 * hi; asm volatile("" : "+v"(rq_), "+v"(jq_));
    const int sh_ = (32 - rq_) & 3; const LAS char* bbase_ = (const LAS char*)bshift + sh_ * 800 + (32 - rq_ - sh_) * 4;
    DIL_KRD(kfa, 0); SBAR();
    DIL_KRD(kfb, 1); DIL_QK(kfa, 0); SBAR();
    DIL_KRD(kfa, 2); DIL_QK(kfb, 1); DIL_TR(0); SBAR();
    DIL_KRD(kfb, 3); DIL_QK(kfa, 2); DIL_TR(1); SBAR();
    DIL_KRD(kfa, 4); DIL_QK(kfb, 3); DIL_TR(2); SBAR();
    DIL_QK(kfa, 4); DIL_TR(3); SBAR();
    DIL_TR(4); SBAR();
#undef DIL_KRD
#undef DIL_QK
#undef DIL_TR
    mx = fmaxf(mx, __shfl_xor(mx, 32));
    float ps = 0.f;
#pragma unroll
    for (int kb = 0; kb < 5; ++kb)
#pragma unroll
      for (int i = 0; i < 16; ++i) { sc[kb][i] = __builtin_amdgcn_exp2f(sc[kb][i] - mx); ps += sc[kb][i]; }
    ps += __shfl_xor(ps, 32);
    m = mx; l = ps; o[0] = f32x16{}; o[1] = f32x16{};
    s16x4 va[8], vb8[8];
#define DIL_VRD(dst, kb_) do { const int vb_ = vbase + (kb_) * 4096; dst[0] = tr_read<0>(vb_); dst[1] = tr_read<1024>(vb_); dst[2] = tr_read<2048>(vb_); dst[3] = tr_read<3072>(vb_); \
      dst[4] = tr_read<512>(vb_); dst[5] = tr_read<1536>(vb_); dst[6] = tr_read<2560>(vb_); dst[7] = tr_read<3584>(vb_); } while (0)
#define DIL_PV(src, kb_) do { bf16x8 pa0_, pa1_; PK4(sc[kb_], 0, pa0_); PK4(sc[kb_], 8, pa1_); \
      o[0] = MFMA32(pa0_, PKV(src[0], src[1]), o[0]); o[0] = MFMA32(pa1_, PKV(src[2], src[3]), o[0]); o[1] = MFMA32(pa0_, PKV(src[4], src[5]), o[1]); o[1] = MFMA32(pa1_, PKV(src[6], src[7]), o[1]); } while (0)
#define DIL_WAIT() do { asm volatile("s_waitcnt lgkmcnt(0)" ::: "memory"); SBAR(); } while (0)
    DIL_VRD(va, 0); DIL_WAIT(); DIL_VRD(vb8, 1); DIL_PV(va, 0); DIL_WAIT(); DIL_VRD(va, 2); DIL_PV(vb8, 1); DIL_WAIT(); DIL_VRD(vb8, 3); DIL_PV(va, 2); DIL_WAIT(); DIL_VRD(va, 4); DIL_PV(vb8, 3); DIL_WAIT(); DIL_PV(va, 4);
#undef DIL_VRD
#undef DIL_PV
#undef DIL_WAIT
    }
    if (hi == 0) wsf[32 + r32] = l; asm volatile("s_waitcnt lgkmcnt(0)" ::: "memory");
    { const long tokq = (long)res + (long)d * (256 * B + 32 * wid + r32);
      DLSE[tokq * 12 + hd] = (m + __log2f(l)) * LN2; }
#pragma unroll
    for (int r = 0; r < 16; ++r) { const int cr = crow(r, hi); const float rl = __builtin_amdgcn_rcpf(wsf[32 + cr]);
      const long tok = (long)res + (long)d * (256 * B + 32 * wid + cr);
#pragma unroll
      for (int d0 = 0; d0 < 2; ++d0) DPART[tok * 768 + hd * 64 + d0 * 32 + r32] = f2bf(o[d0][r] * rl); }
    asm volatile("s_waitcnt lgkmcnt(0)\n\ts_barrier" ::: "memory");
  }
}
DEV void phase_dilcomb(const Args& a, int wv) {
  const int wid = __builtin_amdgcn_readfirstlane(otid(wv) >> 6), lane = otid(wv) & 63;
  const bf16_t* DPART = WSP(bf16_t, A_DPART); const float* DLSE = WSP(float, A_DLSE); bf16_t* YMIX = WSP(bf16_t, A_YMIX);
  for (int t = blockIdx.x * 8 + wid; t < S_; t += gridDim.x * 8) {
#pragma unroll
    for (int i = 0; i < 6; ++i) { const int c = 2 * lane + 128 * i, hd = c >> 6;
      const float l0 = DLSE[(size_t)t * 12 + hd], l1 = DLSE[((size_t)S_ + t) * 12 + hd], l2 = DLSE[((size_t)2 * S_ + t) * 12 + hd];
      const float mx = fmaxf(l0, fmaxf(l1, l2)), e0 = __expf(l0 - mx), e1 = __expf(l1 - mx), e2 = __expf(l2 - mx), inv = 1.f / (e0 + e1 + e2);
      const float2 o0 = ld_bf2(DPART + (size_t)t * 768 + c), o1 = ld_bf2(DPART + ((size_t)S_ + t) * 768 + c), o2 = ld_bf2(DPART + ((size_t)2 * S_ + t) * 768 + c);
      st_bf2(YMIX + (size_t)t * DM + 512 + c, (e0 * o0.x + e1 * o1.x + e2 * o2.x) * inv, (e0 * o0.y + e1 * o1.y + e2 * o2.y) * inv); }
  }
}

constexpr int ML_ROWB = 272;
DEV float ml_tables(const float* GLI, const float* GLF, int dir, int hd, int T0, int lane, LAS float* Bt, LAS float* Et, LAS float* gt) {
  const size_t base = (size_t)(dir * 4 + hd) * S_ + T0 + 2 * lane;
  const float lf0 = GLF[base], lf1 = GLF[base + 1], li0 = GLI[base], li1 = GLI[base + 1];
  const float ps = lf0 + lf1; float incl = ps;
#pragma unroll
  for (int o = 1; o < 64; o <<= 1) { const float y = __shfl_up(incl, o); if (lane >= o) incl += y; }
  const float excl = incl - ps, total = __shfl(incl, 63);
  float b0, b1;
  if (dir == 0) { b0 = excl + lf0; b1 = incl; }
  else { b0 = total - excl; b1 = total - (excl + lf0); }
  if (Bt) { Bt[2 * lane] = b0; Bt[2 * lane + 1] = b1; Et[2 * lane] = li0 - b0; Et[2 * lane + 1] = li1 - b1; }
  if (gt) { gt[2 * lane] = __expf(total - b0 + li0); gt[2 * lane + 1] = __expf(total - b1 + li1); }
  return total;
}
DEV void ml_stage_vt(const bf16_t* PROJ, int hd, int T0, LAS char* VT, int tid) {
#pragma unroll
  for (int i = 0; i < 6; ++i) { const int idx = tid + 512 * i, s = idx & 127, ch = idx >> 7;
    const bf16x8 v = *reinterpret_cast<const bf16x8*>(PROJ + (size_t)(T0 + s) * CINP + off_mv(hd) + ch * 8);
#pragma unroll
    for (int j = 0; j < 8; ++j) *(LAS short*)(VT + (ch * 8 + j) * ML_ROWB + s * 2) = v[j]; }
}
DEV void ml_m1_unit(const Args& a, int hd, int c, LAS char* lds, int wv) {
  const int tid = otid(wv), wid = tid >> 6, lane = tid & 63, r = lane & 31, h = lane >> 5, T0 = c * 128;
  const bf16_t* PROJ = WSP(bf16_t, A_PROJ); const bf16_t* MLQK = WSP(bf16_t, A_MLQK); const float* GLI = WSP(float, WS_GLI); const float* GLF = WSP(float, WS_GLF);
  bf16_t* DS = WSP(bf16_t, A_DS); float* DN = WSP(float, A_DN); float* CD = WSP(float, WS_CD);
  LAS char* VT = lds; LAS char* GKT = lds + 192 * ML_ROWB; LAS float* gt = (LAS float*)(lds + 2 * 192 * ML_ROWB);
  if (wid < 2) { const float total = ml_tables(GLI, GLF, wid, hd, T0, lane, nullptr, nullptr, gt + wid * 128); if (lane == 0) CD[(wid * 4 + hd) * 64 + c] = __expf(total); }
  ml_stage_vt(PROJ, hd, T0, VT, tid);
  __syncthreads();
  for (int dir = 0; dir < 2; ++dir) {
#pragma unroll
    for (int i = 0; i < 6; ++i) { const int idx = tid + 512 * i, s = idx & 127, ch = idx >> 7; const float g = gt[dir * 128 + s];
      const bf16x8 v = *reinterpret_cast<const bf16x8*>(MLQK + (size_t)(T0 + s) * 1536 + 768 + hd * 192 + ch * 8);
#pragma unroll
      for (int j = 0; j < 8; ++j) *(LAS bf16_t*)(GKT + (ch * 8 + j) * ML_ROWB + s * 2) = f2bf(bf2f((bf16_t)v[j]) * g); }
    __syncthreads();
    const size_t ub = (size_t)((dir * 4 + hd) * 64 + c);
    if (tid < 192) { float sum = 0.f; const LAS char* rowp = GKT + tid * ML_ROWB;
      for (int s = 0; s < 128; s += 2) { const unsigned u = *(const LAS unsigned*)(rowp + s * 2); sum += __uint_as_float(u << 16) + __uint_as_float(u & 0xffff0000u); }
      DN[ub * 192 + tid] = sum; }
    for (int tile = wid; tile < 36; tile += 8) { const int dvb = tile / 6, dkb = tile % 6; f32x16 acc = {};
#pragma unroll
      for (int ks = 0; ks < 8; ++ks) { const bf16x8 av = *(const LAS bf16x8*)(VT + (32 * dvb + r) * ML_ROWB + (16 * ks + 8 * h) * 2);
        const bf16x8 bk = *(const LAS bf16x8*)(GKT + (32 * dkb + r) * ML_ROWB + (16 * ks + 8 * h) * 2); acc = MFMA32(av, bk, acc); }
#pragma unroll
      for (int i = 0; i < 16; ++i) DS[(ub * 192 + 32 * dvb + crow(i, h)) * 192 + 32 * dkb + r] = f2bf(acc[i]); }
    __syncthreads();
  }
}
DEV void phase_ml_scan(const Args& a, int wv) {
  const bf16_t* DS = WSP(bf16_t, A_DS); const float* DN = WSP(float, A_DN); const float* CD = WSP(float, WS_CD); bf16_t* ST = WSP(bf16_t, A_ST); float* SN = WSP(float, A_SN);
  constexpr int NE4 = 8 * 36864 / 4, NN = 8 * 192;
  const int nb_ = (int)gridDim.x, per_ = (((NE4 + NN + nb_ - 1) / nb_) + 63) & ~63, e0_ = (int)blockIdx.x * per_;
  for (int e = e0_ + otid(wv); e < e0_ + per_ && e < NE4 + NN; e += 512) {
    if (e < NE4) { const int dh = e / 9216, idx = (e % 9216) * 4, dir = dh >> 2; const size_t base = (size_t)dh * 64 * 36864 + idx; float S0 = 0.f, S1 = 0.f, S2 = 0.f, S3 = 0.f;
#pragma unroll
      for (int hf = 0; hf < 2; ++hf) {
        u32x2 d[32]; float cd[32];
#pragma unroll
        for (int st = 0; st < 32; ++st) { const int s2 = hf * 32 + st, c = dir ? 63 - s2 : s2; d[st] = __builtin_nontemporal_load((const u32x2*)(DS + base + (size_t)c * 36864)); cd[st] = __uint_as_float(__builtin_amdgcn_readfirstlane(__float_as_uint(CD[dh * 64 + c]))); }
#pragma unroll
        for (int st = 0; st < 32; ++st) { const int s2 = hf * 32 + st, c = dir ? 63 - s2 : s2;
          u32x2 w; w.x = cvtpk(S0, S1); w.y = cvtpk(S2, S3); *(u32x2*)(ST + base + (size_t)c * 36864) = w;
          S0 = cd[st] * S0 + __uint_as_float(d[st].x << 16); S1 = cd[st] * S1 + __uint_as_float(d[st].x & 0xffff0000u); S2 = cd[st] * S2 + __uint_as_float(d[st].y << 16); S3 = cd[st] * S3 + __uint_as_float(d[st].y & 0xffff0000u); } } }
    else { const int e2 = e - NE4, dh = e2 / 192, idx = e2 % 192, dir = dh >> 2; const size_t base = (size_t)dh * 64 * 192 + idx; float Sv = 0.f;
#pragma unroll 8
      for (int st = 0; st < 64; ++st) { const int c = dir ? 63 - st : st; SN[base + (size_t)c * 192] = Sv; Sv = CD[dh * 64 + c] * Sv + DN[base + (size_t)c * 192]; } }
  }
}
DEV void ml_m3_unit(const Args& a, int l, int hd, int c, LAS char* lds, int wv) {
  const int tid = otid(wv), wid = tid >> 6, lane = tid & 63, r = lane & 31, h = lane >> 5, T0 = c * 128;
  const int dir = wid >> 2, rb = wid & 3;
  const bf16_t* PROJ = WSP(bf16_t, A_PROJ); const bf16_t* MLQK = WSP(bf16_t, A_MLQK); const float* GLI = WSP(float, WS_GLI); const float* GLF = WSP(float, WS_GLF);
  const bf16_t* ST = WSP(bf16_t, A_ST); const float* SN = WSP(float, A_SN); bf16_t* YMIX = WSP(bf16_t, A_YMIX);
  constexpr int KROWB = 400;
  LAS char* KL = lds; LAS char* VT = lds + 128 * KROWB; LAS float* tab = (LAS float*)(lds + 128 * KROWB + 192 * ML_ROWB);
  LAS float* Btab = tab; LAS float* Etab = tab + 256; LAS float* nv = tab + 512; LAS float* denx = tab + 512 + 384;
  LAS float* HB = (LAS float*)lds;
  if (wid < 2) (void)ml_tables(GLI, GLF, wid, hd, T0, lane, Btab + wid * 128, Etab + wid * 128, nullptr);
  else if (tid - 128 < 384) { const int i = tid - 128, d2 = i / 192, dk = i % 192; nv[i] = SN[(size_t)((d2 * 4 + hd) * 64 + c) * 192 + dk]; }
#pragma unroll
  for (int i = 0; i < 6; ++i) { const int idx = tid + 512 * i, s = idx / 24, ch = idx % 24;
    *(LAS bf16x8*)(KL + s * KROWB + ch * 16) = *reinterpret_cast<const bf16x8*>(MLQK + (size_t)(T0 + s) * 1536 + 768 + hd * 192 + ch * 8); }
  ml_stage_vt(PROJ, hd, T0, VT, tid);
  bf16x8 qf[12];
#pragma unroll
  for (int k = 0; k < 12; ++k) qf[k] = *reinterpret_cast<const bf16x8*>(MLQK + (size_t)(T0 + 32 * rb + r) * 1536 + hd * 192 + 16 * k + 8 * h);
  __syncthreads();
  const float Bt = Btab[dir * 128 + 32 * rb + r];
  f32x16 o[6] = {}; float den = 0.f;
  const bf16_t* STu = ST + (size_t)((dir * 4 + hd) * 64 + c) * 36864;
  bf16x8 sfp[2][6];
#pragma unroll
  for (int kk = 0; kk < 2; ++kk)
#pragma unroll
    for (int dvb = 0; dvb < 6; ++dvb) sfp[kk][dvb] = *reinterpret_cast<const bf16x8*>(STu + (size_t)(32 * dvb + r) * 192 + 16 * kk + 8 * h);
  const int sb_lo = dir ? rb : 0, sb_hi = dir ? 3 : rb;
  for (int sb = sb_lo; sb <= sb_hi; ++sb) {
    f32x16 p = {};
#pragma unroll
    for (int k = 0; k < 12; ++k) { const bf16x8 kf = *(const LAS bf16x8*)(KL + (32 * sb + r) * KROWB + (16 * k + 8 * h) * 2); p = MFMA32(kf, qf[k], p); }
#pragma unroll
    for (int i = 0; i < 16; ++i) { const int sl = crow(i, h); const float w = __builtin_amdgcn_exp2f((Bt + Etab[dir * 128 + 32 * sb + sl]) * LOG2E);
      const bool keep = (sb != rb) || (dir ? (sl >= r) : (sl <= r));
      p[i] = keep ? p[i] * w : 0.f; den += p[i]; }
    bf16x8 pa0, pa1; PK4(p, 0, pa0); PK4(p, 8, pa1);
#pragma unroll
    for (int dvb = 0; dvb < 6; ++dvb) { const LAS char* vrow = VT + (32 * dvb + r) * ML_ROWB + (32 * sb + 8 * h) * 2;
      const bf16x8 b0 = *(const LAS bf16x8*)(vrow), b1 = *(const LAS bf16x8*)(vrow + 32);
      o[dvb] = MFMA32(pa0, b0, o[dvb]); o[dvb] = MFMA32(pa1, b1, o[dvb]); }
  }
  {
    const float ef = __builtin_amdgcn_exp2f(Bt * LOG2E); float deni = 0.f;
#pragma unroll
    for (int k = 0; k < 12; ++k) { u32x4 w4 = __builtin_bit_cast(u32x4, qf[k]); float f[8];
#pragma unroll
      for (int j = 0; j < 4; ++j) { f[2 * j] = __uint_as_float(w4[j] << 16) * ef; f[2 * j + 1] = __uint_as_float(w4[j] & 0xffff0000u) * ef; }
#pragma unroll
      for (int j = 0; j < 8; ++j) deni += f[j] * nv[dir * 192 + 16 * k + 8 * h + j];
      u32x4 q4; q4.x = cvtpk(f[0], f[1]); q4.y = cvtpk(f[2], f[3]); q4.z = cvtpk(f[4], f[5]); q4.w = cvtpk(f[6], f[7]);
      const bf16x8 qs = __builtin_bit_cast(bf16x8, q4);
#pragma unroll
      for (int dvb = 0; dvb < 6; ++dvb) o[dvb] = MFMA32(qs, sfp[k & 1][dvb], o[dvb]);
      if (k + 2 < 12) {
#pragma unroll
        for (int dvb = 0; dvb < 6; ++dvb) sfp[k & 1][dvb] = *reinterpret_cast<const bf16x8*>(STu + (size_t)(32 * dvb + r) * 192 + 16 * (k + 2) + 8 * h); } }
    den += deni;
  }
  den += __shfl_xor(den, 32);
  if (h == 0) denx[wid * 32 + r] = den;
  asm volatile("s_waitcnt lgkmcnt(0)" ::: "memory");
  float rden[16];
#pragma unroll
  for (int i = 0; i < 16; ++i) rden[i] = 1.f / fmaxf(fabsf(denx[wid * 32 + crow(i, h)]), 1.f);
  __syncthreads();
  if (dir == 1) {
#pragma unroll
    for (int dvb = 0; dvb < 6; ++dvb)
#pragma unroll
      for (int i = 0; i < 16; ++i) HB[(32 * rb + crow(i, h)) * 193 + 32 * dvb + r] = o[dvb][i] * rden[i];
  }
  __syncthreads();
  if (dir == 0) {
#pragma unroll
    for (int dvb = 0; dvb < 6; ++dvb)
#pragma unroll
      for (int i = 0; i < 16; ++i) { LAS float* hp = HB + (32 * rb + crow(i, h)) * 193 + 32 * dvb + r; *hp = o[dvb][i] * rden[i] + *hp; }
  }
  __syncthreads();
  {
    const float* gout = a.g_out + (size_t)l * 768 + hd * 192; const float g0 = gout[lane], g1 = gout[lane + 64], g2 = gout[lane + 128];
    bf16_t opv[16][3];
#pragma unroll
    for (int rr = 0; rr < 16; ++rr) { const size_t t = (size_t)T0 + 16 * wid + rr;
#pragma unroll
      for (int cc = 0; cc < 3; ++cc) opv[rr][cc] = PROJ[t * CINP + OFF_MO + hd * 192 + lane + 64 * cc]; }
#pragma unroll
    for (int rr = 0; rr < 16; ++rr) { const int row = 16 * wid + rr; const size_t t = (size_t)T0 + row;
      const float v0 = HB[row * 193 + lane], v1 = HB[row * 193 + lane + 64], v2 = HB[row * 193 + lane + 128];
      const float rs = rsqrtf(wave_sum(v0 * v0 + v1 * v1 + v2 * v2) * (1.f / 192.f) + EPS);
      bf16_t* yo = YMIX + t * DM + 1280 + hd * 192 + lane;
      yo[0] = f2bf(v0 * rs * g0 / (1.f + __expf(-bf2f(opv[rr][0])))); yo[64] = f2bf(v1 * rs * g1 / (1.f + __expf(-bf2f(opv[rr][1])))); yo[128] = f2bf(v2 * rs * g2 / (1.f + __expf(-bf2f(opv[rr][2])))); }
  }
  __syncthreads();
}

constexpr int NPH_L = 13, NPH = NL * NPH_L + 1;
__global__ void __launch_bounds__(512, 2) fwd_kernel(Args a) {
    extern __shared__ __attribute__((aligned(16))) unsigned char lds_raw[];
    LAS unsigned char* lds = (LAS unsigned char*)lds_raw; LAS char* ldsg = (LAS char*)lds_raw;
    const int wv = 0; const int tid = threadIdx.x;
#define G obid_((int)gridDim.x)
#define bid obid_((int)blockIdx.x)
    const bool use_bar = (a.ph_hi - a.ph_lo) > 1;
    XcdBarrier bar; bar.bar = WSP(unsigned, WS_CTL); bar.x = 0; bar.st = (volatile LAS unsigned*)(lds + LDS_BARW); bar.wv = wv;
    if (use_bar) {
        if (tid == 0) { *(LAS u32x4*)(lds + LDS_BARW) = (u32x4){0u, 0u, 0u, 0u}; }
        __syncthreads();
        bar = xcd_barrier_post(WSP(unsigned, WS_CTL), (volatile LAS unsigned*)(lds + LDS_BARW), wv);
    }
#ifndef ONLY_K
#define ONLY_K -1
#endif
#define IN(k) ((ONLY_K < 0 || ((k) % NPH_L) == ONLY_K) && a.ph_lo <= (k) && (k) < a.ph_hi)
#define SEAM(k) do { if (IN(k) && IN((k) + 1)) xcd_barrier(bar); } while (0)
#define REPS(k) ((DUP_K == (k)) ? 2 : 1)
#define SUBREP(id) for (int sr_ = 0; sr_ < ((DUP_K == (id)) ? 2 : 1); ++sr_)
#define DUPLOOP(k) for (int rep_ = 0; rep_ < REPS(k); ++rep_, (rep_ < REPS(k) ? xcd_barrier(bar) : (void)0))
    for (int l = 0; l < NL; ++l) {
        const int pb = l * NPH_L;
        if (IN(pb + 0)) DUPLOOP(0) { SUBREP(27) { phase_cvt_a(a, l, lds, wv); phase_cvt_router(a, l, wv); } SUBREP(28) phase_norm1(a, l, l == 0 ? 0 : 1, wv); if (l == 0) phase_rope(a, wv); }
        SEAM(pb + 0);
        if (IN(pb + 1)) DUPLOOP(1) { pg8::Gemm g{WSP(bf16_t, WS_XN), WSP(bf16_t, A_WIN), DM, DM, DM, 1, 0}; pg8::StaticOrder S; S.init(S_, N_EARLY, G, bid);
            pg8::EpiBf16 E{WSP(bf16_t, A_PROJ), CINP, 0x7fffffff}; pg8::gemm_phase<false>(lds, g, S, E, wv); }
        SEAM(pb + 1);
        if (IN(pb + 2)) DUPLOOP(2) phase_p3a(a, l, wv);
        SEAM(pb + 2);
        if (IN(pb + 3)) DUPLOOP(3) {
            const int g_ = G, b_ = bid; const bool bal = (g_ == 256);
            { pg8::Gemm g{WSP(bf16_t, WS_XN), WSP(bf16_t, A_WIN) + (size_t)N_EARLY * DM, DM, DM, DM, 1, 0}; pg8::StaticOrder S; S.init(S_, N_LATE, bal ? 160 : g_, bal ? (b_ < 160 ? b_ : -1) : b_);
              pg8::EpiBf16 E{WSP(bf16_t, A_PROJ) + N_EARLY, CINP, 0x7fffffff}; pg8::gemm_phase<false>(lds, g, S, E, wv); }
            { pg8::Gemm g{WSP(bf16_t, A_CQKV), WSP(bf16_t, A_BD1), 512, 512, 512, 1, 0}; pg8::StaticOrder S;
              if (!bal) S.init(S_, 1792, g_, b_); else if (b_ >= 160) S.init(S_, 1792, 96, b_ - 160, 0, 2); else S.init(S_, 1792, 256, b_ < 32 ? b_ : -1, 192, 1);
              pg8::EpiBf16 E{WSP(bf16_t, A_RAW), 1792, 0x7fffffff}; pg8::gemm_phase<false>(lds, g, S, E, wv); }
            { pg8::Gemm g{WSP(bf16_t, A_UC), WSP(bf16_t, A_BD2), 768, 768, 384, 3, 192};   pg8::StaticOrder S;
              if (!bal) S.init(S_, 1536, g_, g_ - 1 - b_); else S.init(S_, 1536, 96, b_ >= 160 ? b_ - 160 : -1, 0, 2);
              pg8::EpiBf16 E{WSP(bf16_t, A_MLQK), 1536, 0x7fffffff}; pg8::gemm_phase<false>(lds, g, S, E, wv); }
        }
        SEAM(pb + 3);
        if (IN(pb + 4)) DUPLOOP(4) { phase_p3c(a, l, rep_ == 0, wv); SUBREP(25) for (int u = bid; u < 256; u += G) ml_m1_unit(a, u >> 6, u & 63, ldsg, wv); }
        SEAM(pb + 4);
        if (IN(pb + 5)) DUPLOOP(5) {
            SUBREP(22) phase_ml_scan(a, wv);
            const bool nomax = mla::bound_ok(a.g_q + l * 96, a.g_k + l * 96, lane_id());
            SUBREP(20) for (int u = bid; u < 256; u += G) { const int hq = u & 7, qb = u >> 3;
                const bf16_t* Qp = WSP(bf16_t, A_QM) + (size_t)qb * 256 * 768 + hq * 96; const bf16_t* Kp = WSP(bf16_t, A_KM) + hq * 96; const bf16_t* Vp = WSP(bf16_t, A_RAW) + 768 + hq * 128 + 64;
                bf16_t* Op = WSP(bf16_t, A_YMIX) + (size_t)qb * 256 * DM + hq * 64;
                if (nomax) mla::attn_unit<true>(Qp, Kp, Vp, Op, S_, ldsg, wv); else mla::attn_unit<false>(Qp, Kp, Vp, Op, S_, ldsg, wv); }
            if constexpr (DUP_K >= 41 && DUP_K <= 49) for (int u = bid; u < 256; u += G) { const int hq = u & 7, qb = u >> 3;
                mla::attn_unit<true, (DUP_K >= 41 && DUP_K <= 49) ? DUP_K - 40 : 0>(WSP(bf16_t, A_QM) + (size_t)qb * 256 * 768 + hq * 96, WSP(bf16_t, A_KM) + hq * 96, WSP(bf16_t, A_RAW) + 768 + hq * 128 + 64, nullptr, S_, ldsg, wv); }
            SUBREP(21) phase_dilated(a, ldsg, wv);
        }
        SEAM(pb + 5);
        if (IN(pb + 6)) DUPLOOP(6) { SUBREP(26) for (int u = bid; u < 256; u += G) ml_m3_unit(a, l, u >> 6, u & 63, ldsg, wv); SUBREP(29) phase_dilcomb(a, wv); }
        SEAM(pb + 6);
        if (IN(pb + 7)) DUPLOOP(7) { pg8::Gemm g{WSP(bf16_t, A_YMIX), WSP(bf16_t, A_WOUT), DM, DM, DM, 1, 0}; pg8::StaticOrder S; S.init(S_, DM, G, bid);
            pg8::EpiBf16 E{WSP(bf16_t, WS_XB), DM, 0x7fffffff}; pg8::gemm_phase<false>(lds, g, S, E, wv); }
        SEAM(pb + 7);
        if (IN(pb + 8)) DUPLOOP(8) { SUBREP(23) phase_router(a, l, ldsg, wv); }
        SEAM(pb + 8);
        if (IN(pb + 9)) DUPLOOP(9) { phase_lists(a, ldsg, wv); SUBREP(24) phase_cvt_b(a, l, lds, (int)gridDim.x > 32 ? 16 : 0, wv); }
        SEAM(pb + 9);
        if (IN(pb + 11)) DUPLOOP(11) {
            unsigned* pcnt = WSP(unsigned, WS_CTL) + 4096 + l * (80 * 64);
            { pg8::Gemm g{WSP(bf16_t, WS_XN), WSP(bf16_t, B_W1), DM, DM, DM, 1, 0}; pg8::MoeOrder S{WSP(int, WS_TSTART), WSP(int, WS_TILES), 4, G, bid};
              pg8::EpiMoe1 E{WSP(bf16_t, B_H), WSP(float, WS_SLOTW), WSP(float, WS_SLOTR), pcnt}; pg8::gemm_phase<true, true>(lds, g, S, E, wv, WSP(int, WS_PERM)); }
            { pg8::Gemm g{WSP(bf16_t, B_H), WSP(bf16_t, B_W2), 512, 512, 512, 1, 0}; pg8::MoeOrder2 S{WSP(int, WS_TSTART), WSP(int, WS_TILES), pcnt, WSP(unsigned, WS_CTL) + XB_TMO, G, bid};
              pg8::EpiBf16 E{WSP(bf16_t, B_YS), DM, 7}; pg8::gemm_phase<false, true>(lds, g, S, E, wv); }
        }
        SEAM(pb + 12);
    }
    if (IN(NPH - 1)) phase_norm1(a, 0, 2, wv);
#undef IN
#undef SEAM
#undef G
#undef bid
}

extern "C" void kernel_launch(void* const* d_in, const int* in_sizes, int n_in, void* d_out, int out_size, void* d_ws, size_t ws_size, hipStream_t stream) {
    static int grid = 0;
    if (grid == 0) {
        if (n_in != 28 || out_size != S_ * DM || ws_size < WS_END) { fprintf(stderr, "kernel_launch: shape/workspace mismatch: n_in %d out %d ws %zu (need %zu)\n", n_in, out_size, ws_size, (size_t)WS_END); grid = -1; return; }
        int dev = 0, cus = 0;
        if (hipGetDevice(&dev) != hipSuccess || hipDeviceGetAttribute(&cus, hipDeviceAttributeMultiprocessorCount, dev) != hipSuccess) { grid = -1; return; }
        if (hipFuncSetAttribute((const void*)fwd_kernel, hipFuncAttributeMaxDynamicSharedMemorySize, LDS_BYTES) != hipSuccess) { fprintf(stderr, "kernel_launch: hipFuncSetAttribute failed\n"); grid = -1; return; }
        int per_cu = 0;
        if (hipOccupancyMaxActiveBlocksPerMultiprocessor(&per_cu, (const void*)fwd_kernel, 512, LDS_BYTES) != hipSuccess || per_cu < 1) fprintf(stderr, "kernel_launch: occupancy query reports %d\n", per_cu);
        (void)hipGetLastError();
        grid = cus;
    }
    if (grid < 0) return;
    (void)hipMemsetAsync((char*)d_ws + WS_CTL, 0, CTL_BYTES, stream);
    Args a{};
    a.x = (const float*)d_in[0]; a.pos = (const int*)d_in[1]; a.rel_bias = (const float*)d_in[2]; a.norm_mix = (const float*)d_in[3]; a.w_in = (const float*)d_in[4];
    a.g_cq = (const float*)d_in[5]; a.w_uq = (const float*)d_in[6]; a.g_ckv = (const float*)d_in[7]; a.w_ukv = (const float*)d_in[8]; a.g_q = (const float*)d_in[9]; a.g_k = (const float*)d_in[10];
    a.dg_q = (const float*)d_in[11]; a.dg_k = (const float*)d_in[12]; a.conv_w = (const float*)d_in[13]; a.conv_b = (const float*)d_in[14]; a.ml_wq = (const float*)d_in[15]; a.ml_wk = (const float*)d_in[16];
    a.gate_bias = (const float*)d_in[17]; a.g_out = (const float*)d_in[18]; a.w_out = (const float*)d_in[19]; a.norm_ffn = (const float*)d_in[20]; a.wg = (const float*)d_in[21]; a.bg = (const float*)d_in[22];
    a.we = (const float*)d_in[23]; a.be = (const float*)d_in[24]; a.w_gate = (const float*)d_in[25]; a.w_up = (const float*)d_in[26]; a.w_down = (const float*)d_in[27];
    a.out = (float*)d_out; a.ws = (unsigned char*)d_ws;
#if MK_MULTI
    for (int ph = 0; ph < NPH; ++ph) { a.ph_lo = ph; a.ph_hi = ph + 1; hipLaunchKernelGGL(fwd_kernel, dim3(grid), dim3(512), LDS_BYTES, stream, a); }
#else
    a.ph_lo = 0; a.ph_hi = NPH; hipLaunchKernelGGL(fwd_kernel, dim3(grid), dim3(512), LDS_BYTES, stream, a);
#endif
    const hipError_t le = hipPeekAtLastError();
    if (le != hipSuccess) fprintf(stderr, "kernel_launch: launch failed: %s\n", hipGetErrorName(le));
}
```

```cpp
#include <hip/hip_runtime.h>
#include <cstdio>
#include <cstdint>

#ifndef MK_MULTI
#define MK_MULTI 0
#endif

#ifndef DUP_K
#define DUP_K -1
#endif
#define DEV __device__ __forceinline__
#define LAS __attribute__((address_space(3)))
typedef unsigned short bf16_t;
typedef short bf16x8 __attribute__((ext_vector_type(8)));
typedef short s16x4 __attribute__((ext_vector_type(4)));
typedef float f32x4 __attribute__((ext_vector_type(4)));
typedef float f32x2 __attribute__((ext_vector_type(2)));
__device__ __forceinline__ f32x2 mk2(float a, float b) { f32x2 r; r[0] = a; r[1] = b; return r; }
typedef float f32x16 __attribute__((ext_vector_type(16)));
typedef unsigned u32x4 __attribute__((ext_vector_type(4)));
typedef unsigned u32x2 __attribute__((ext_vector_type(2)));

constexpr int S_ = 8192, DM = 2048, CIN = 5168, CINP = 5376, NL = 2;
constexpr int OFF_CQ = 0, OFF_CKV = 384, OFF_KR = 512, OFF_DQ = 544, OFF_DK = 1312, OFF_DV = 2080, OFF_MU = 2848, OFF_MG = 4000, OFF_MO = 4480, N_EARLY = 4096, N_LATE = 1280;
__host__ __device__ constexpr int off_mv(int hd) { return hd < 2 ? 3616 + hd * 192 : 4096 + (hd - 2) * 192; }
__host__ __device__ constexpr int win_src_col(int n) { return n < 4000 ? n : (n < 4016 ? n + 1152 : (n < 4096 ? -1 : (n < 5248 ? n - 96 : -1))); }
constexpr float EPS = 1e-6f;
constexpr float LOG2E = 1.4426950408889634f, LN2 = 0.6931471805599453f;
constexpr int MAXSLOT = 20480;

constexpr size_t al256(size_t x) { return (x + 255) / 256 * 256; }
constexpr size_t WS_CTL = 0, CTL_BYTES = 65536;
constexpr size_t WS_XB = WS_CTL + CTL_BYTES;
constexpr size_t WS_XN = WS_XB + (size_t)S_ * DM * 4;
constexpr size_t WS_COS = WS_XN + (size_t)S_ * DM * 2;
constexpr size_t WS_SIN = WS_COS + (size_t)S_ * 16 * 4;
constexpr size_t WS_KR = WS_SIN + (size_t)S_ * 16 * 4;
constexpr size_t WS_GLI = WS_KR + (size_t)S_ * 32 * 4;
constexpr size_t WS_GLF = WS_GLI + (size_t)8 * S_ * 4;
constexpr size_t WS_EID = WS_GLF + (size_t)8 * S_ * 4;
constexpr size_t WS_WGT = WS_EID + (size_t)S_ * 8;
constexpr size_t WS_SLOTOF = WS_WGT + (size_t)S_ * 8;
constexpr size_t WS_PERM = WS_SLOTOF + (size_t)S_ * 8;
constexpr size_t WS_SLOTW = WS_PERM + (size_t)MAXSLOT * 4;
constexpr size_t WS_SLOTR = WS_SLOTW + (size_t)MAXSLOT * 4;
constexpr size_t WS_RSTD = WS_SLOTR + (size_t)MAXSLOT * 4;
constexpr size_t WS_TSTART = WS_RSTD + (size_t)S_ * 4;
constexpr size_t WS_TILES = WS_TSTART + 256;
constexpr size_t WS_CD = al256(WS_TILES + 3 * 96 * 4);
constexpr size_t WS_WR3 = al256(WS_CD + 2 * 4 * 64 * 32 * 4);
constexpr size_t WS_ARENA = al256(WS_WR3 + (size_t)8 * 20 * 64 * 16);
constexpr size_t A_WIN = WS_ARENA;
constexpr size_t A_WOUT = A_WIN + (size_t)CINP * DM * 2;
constexpr size_t A_BD1 = A_WOUT + (size_t)DM * DM * 2;
constexpr size_t A_BD2 = A_BD1 + (size_t)1792 * 512 * 2;
constexpr size_t A_PROJ = A_BD2 + (size_t)1536 * 768 * 2;
constexpr size_t A_CQKV = A_PROJ + (size_t)S_ * CINP * 2;
constexpr size_t A_UC = A_CQKV + (size_t)S_ * 512 * 2;
constexpr size_t A_RAW = A_UC + (size_t)S_ * 768 * 2;
constexpr size_t A_MLQK = A_RAW + (size_t)S_ * 1792 * 2;
constexpr size_t A_QM = A_MLQK + (size_t)S_ * 1536 * 2;
constexpr size_t A_KM = A_QM + (size_t)S_ * 768 * 2;
constexpr size_t A_DPART = A_KM + (size_t)S_ * 768 * 2;
constexpr size_t A_DLSE = A_DPART + (size_t)3 * S_ * 768 * 2;
constexpr size_t A_DS = A_DLSE + (size_t)3 * S_ * 12 * 4;
constexpr size_t A_DN = A_DS + (size_t)512 * 36864 * 4;
constexpr size_t A_ST = A_DN + (size_t)512 * 192 * 4;
constexpr size_t A_SN = A_ST + (size_t)512 * 36864 * 2;
constexpr size_t A_YMIX = A_SN + (size_t)512 * 192 * 4;
constexpr size_t A_END = A_YMIX + (size_t)S_ * DM * 2;
constexpr size_t B_W1 = WS_ARENA;
constexpr size_t B_W2 = B_W1 + (size_t)16384 * 2048 * 2;
constexpr size_t B_APERM = B_W2 + (size_t)32768 * 512 * 2;
constexpr size_t B_H = B_APERM + (size_t)MAXSLOT * 2048 * 2;
constexpr size_t B_YS = B_H + (size_t)MAXSLOT * 512 * 2;
constexpr size_t B_END = B_YS + (size_t)MAXSLOT * 2048 * 2;
static_assert(B_YS >= A_PROJ, "YS must not overlap the next layer's converted weights (written while YS is still read)");
constexpr size_t WS_END = (A_END > B_END ? A_END : B_END);

constexpr int LDS_BYTES = 147456;
constexpr int LDS_BARW = LDS_BYTES - 64;

DEV int lane_id() { return (int)__builtin_amdgcn_mbcnt_hi(~0u, __builtin_amdgcn_mbcnt_lo(~0u, 0u)); }
DEV float bf2f(bf16_t b) { return __uint_as_float(((unsigned)b) << 16); }
DEV bf16_t f2bf(float f) { unsigned u = __float_as_uint(f); u += 0x7FFFu + ((u >> 16) & 1u); return (bf16_t)(u >> 16); }
DEV unsigned cvtpk(float lo, float hi) { unsigned r; asm volatile("v_cvt_pk_bf16_f32 %0, %1, %2" : "=v"(r) : "v"(lo), "v"(hi)); return r; }
DEV f32x4 ld_h4(const float* resid, const bf16_t* delta, size_t off) { f32x4 v = *(const f32x4*)(resid + off); const u32x2 d = *(const u32x2*)(delta + off);
    v[0] += __uint_as_float(d.x << 16); v[1] += __uint_as_float(d.x & 0xffff0000u); v[2] += __uint_as_float(d.y << 16); v[3] += __uint_as_float(d.y & 0xffff0000u); return v; }
DEV f32x4 ld_h4nt(const float* resid, const bf16_t* delta, size_t off) { f32x4 v = __builtin_nontemporal_load((const f32x4*)(resid + off)); const u32x2 d = __builtin_nontemporal_load((const u32x2*)(delta + off));
    v[0] += __uint_as_float(d.x << 16); v[1] += __uint_as_float(d.x & 0xffff0000u); v[2] += __uint_as_float(d.y << 16); v[3] += __uint_as_float(d.y & 0xffff0000u); return v; }
DEV float2 ld_bf2(const bf16_t* p) { const unsigned u = *(const unsigned*)p; return make_float2(__uint_as_float(u << 16), __uint_as_float(u & 0xffff0000u)); }
DEV void st_bf2(bf16_t* p, float a, float b) { *(unsigned*)p = cvtpk(a, b); }
template <int CTRL> DEV float dpp_f(float v) { return __builtin_bit_cast(float, __builtin_amdgcn_mov_dpp(__builtin_bit_cast(int, v), CTRL, 0xF, 0xF, true)); }
DEV float sum_g8(float v)  { v += dpp_f<0xB1>(v); v += dpp_f<0x4E>(v); v += dpp_f<0x141>(v); return v; }
DEV float sum_g16(float v) { v = sum_g8(v); v += dpp_f<0x140>(v); return v; }
DEV float wave_sum(float v) {
    v = sum_g16(v);
    { auto r = __builtin_amdgcn_permlane16_swap(__float_as_uint(v), __float_as_uint(v), false, false); v = __uint_as_float(r[0]) + __uint_as_float(r[1]); }
    { auto r = __builtin_amdgcn_permlane32_swap(__float_as_uint(v), __float_as_uint(v), false, false); v = __uint_as_float(r[0]) + __uint_as_float(r[1]); }
    return v;
}
DEV int otid(int wv) { (void)wv; int t = threadIdx.x; asm volatile("" : "+v"(t)); return t; }
DEV u32x4 zero4() { unsigned z = 0u; asm volatile("" : "+v"(z)); return (u32x4){z, z, z, z}; }
DEV int obid_(int v) { asm volatile("" : "+s"(v)); return v; }
DEV int crow(int r, int hi) { return (r & 3) + 8 * (r >> 2) + 4 * hi; }
DEV int ld_agent_i(const int* p) { return __hip_atomic_load(p, __ATOMIC_RELAXED, __HIP_MEMORY_SCOPE_AGENT); }
DEV float ld_agent_f(const float* p) { return __hip_atomic_load(p, __ATOMIC_RELAXED, __HIP_MEMORY_SCOPE_AGENT); }
#define MFMA32(a, b, c) __builtin_amdgcn_mfma_f32_32x32x16_bf16((a), (b), (c), 0, 0, 0)
#define SBAR() __builtin_amdgcn_sched_barrier(0)
#define PK4(P, BASE, OUT) do { unsigned a0_ = cvtpk(P[BASE + 0], P[BASE + 1]), a1_ = cvtpk(P[BASE + 2], P[BASE + 3]);   \
    unsigned b0_ = cvtpk(P[BASE + 4], P[BASE + 5]), b1_ = cvtpk(P[BASE + 6], P[BASE + 7]);                              \
    auto r0_ = __builtin_amdgcn_permlane32_swap(a0_, b0_, false, false); auto r1_ = __builtin_amdgcn_permlane32_swap(a1_, b1_, false, false); \
    u32x4 w_ = {r0_[0], r1_[0], r0_[1], r1_[1]}; OUT = __builtin_bit_cast(bf16x8, w_); } while (0)

#define XB_TMO      128
#define XB_XCNT(j)  (256  + 64 * (j))
#define XB_XSUB(j)  (1280 + 64 * (j))
#define XB_XGEN(j)  (2304 + 64 * (j))
#define XB_TOP      3328
#define XB_TOPGEN   3392
#define XCD_BAR_WORDS 3456
#define XB_XDONE(j) (3456 + 32 * (j))
#define XB_SPIN_CAP (1u << 18)
__device__ __forceinline__ unsigned xb_ld(unsigned* p)              { return __hip_atomic_load(p, __ATOMIC_RELAXED, __HIP_MEMORY_SCOPE_AGENT); }
__device__ __forceinline__ unsigned xb_add(unsigned* p, unsigned v) { return __hip_atomic_fetch_add(p, v, __ATOMIC_RELAXED, __HIP_MEMORY_SCOPE_AGENT); }
__device__ __forceinline__ unsigned xb_xcc_id() { return (unsigned)__builtin_amdgcn_s_getreg((3 << 11) | 20) & 0xFu; }
#define XB_SPIN(cond, bar) do { unsigned _sp = 0; while (cond) { __builtin_amdgcn_s_sleep(1); \
    if ((++_sp & 255u) == 0u) { if (xb_ld(&(bar)[XB_TMO])) break; if (_sp > XB_SPIN_CAP) { atomicAdd(&(bar)[XB_TMO], 1u); break; } } } } while (0)
struct XcdBarrier { unsigned* bar; unsigned x; volatile LAS unsigned* st; int wv; };
__device__ __forceinline__ XcdBarrier xcd_barrier_post(unsigned* bar, volatile LAS unsigned* st, int wv) {
    XcdBarrier b; b.bar = bar; b.x = xb_xcc_id(); b.st = st; b.wv = wv;
    if (threadIdx.x == 0) (void)xb_add(&bar[XB_XCNT(b.x)], 1u);
    return b;
}
__device__ __forceinline__ void xcd_barrier_complete(unsigned* bar, unsigned x, unsigned& nloc, unsigned& nx, unsigned& msk) {
    const unsigned G = gridDim.x * gridDim.y * gridDim.z;
    unsigned sum, cnt, mine, sp = 0u;
    for (;;) {
        sum = 0u; cnt = 0u; mine = 0u; msk = 0u;
#pragma unroll
        for (unsigned j = 0; j < 16; ++j) { const unsigned c = xb_ld(&bar[XB_XCNT(j)]); sum += c; cnt += (c > 0u) ? 1u : 0u; msk |= (c > 0u) ? (1u << j) : 0u; mine = (j == x) ? c : mine; }
        if (sum == G) break;
        __builtin_amdgcn_s_sleep(1);
        if ((++sp & 255u) == 0u) { if (xb_ld(&bar[XB_TMO])) break; if (sp > XB_SPIN_CAP) { atomicAdd(&bar[XB_TMO], 1u); break; } }
    }
    nloc = mine > 0u ? mine : 1u; nx = cnt > 0u ? cnt : 1u;
}
__device__ __forceinline__ void xcd_barrier_arrive(const XcdBarrier& b) {
    asm volatile("s_waitcnt vmcnt(0)" ::: "memory");
    __syncthreads();
    if (threadIdx.x == 0) {
        unsigned* bar = b.bar;
        __builtin_amdgcn_s_waitcnt(0);
        unsigned nloc = b.st[0], nx = b.st[1], msk = b.st[2];
        if (nloc == 0u) { xcd_barrier_complete(bar, b.x, nloc, nx, msk); b.st[0] = nloc; b.st[1] = nx; b.st[2] = msk; }
        const unsigned old = xb_add(&bar[XB_XSUB(b.x)], 1u);
        const unsigned gen = old / nloc;
        b.st[3] = gen;
        if (old + 1u == (gen + 1u) * nloc) {
            __builtin_amdgcn_fence(__ATOMIC_RELEASE, "agent");
            asm volatile("s_waitcnt vmcnt(0)" ::: "memory");
            (void)xb_add(&bar[XB_XDONE(b.x)], 1u);
        }
        asm volatile("buffer_inv sc1" ::: "memory");
    }
}
__device__ __forceinline__ void xcd_barrier_wait(const XcdBarrier& b, const unsigned master = 0u) {
    if (threadIdx.x < 64) {
        unsigned* bar = b.bar;
        asm volatile("s_waitcnt lgkmcnt(0)" ::: "memory");
        const unsigned gen = (unsigned)__builtin_amdgcn_readfirstlane((int)b.st[3]), msk = (unsigned)__builtin_amdgcn_readfirstlane((int)b.st[2]);
        if (blockIdx.x == master) {
            unsigned j = threadIdx.x & 15u; asm volatile("" : "+v"(j));
            const bool used = (msk >> j) & 1u;
            unsigned sp = 0u;
            for (;;) {
                const bool ok = !used || (xb_ld(&bar[XB_XDONE(j)]) > gen);
                if (__all(ok)) break;
                __builtin_amdgcn_s_sleep(1);
                if ((++sp & 255u) == 0u) { if (__any(xb_ld(&bar[XB_TMO]) != 0u)) break; if (sp > XB_SPIN_CAP) { if (threadIdx.x == 0) atomicAdd(&bar[XB_TMO], 1u); break; } }
            }
            if (threadIdx.x < 16 && used) (void)xb_add(&bar[XB_XGEN(j)], 1u);
        }
        if (threadIdx.x == 0) {
            XB_SPIN(xb_ld(&bar[XB_XGEN(b.x)]) == gen, bar);
            asm volatile("s_waitcnt vmcnt(0)" ::: "memory");
        }
    }
    __syncthreads();
}
__device__ __forceinline__ void xcd_barrier(const XcdBarrier& b) { xcd_barrier_arrive(b); xcd_barrier_wait(b); }

namespace pg8 {
constexpr int BM = 256, BK = 64, HALF = 128, HTB = HALF * BK * 2, STAGE_BYTES = 8 * HTB, NXCD = 8, WGM = 8;
__host__ __device__ __forceinline__ int lds_byte(int r, int c) { const int st = (r >> 4) * 2 + (c >> 5), rr = r & 15, cc = c & 31, ob = rr * 64 + cc * 2; return st * 1024 + (ob ^ (((ob >> 9) & 1) << 5)); }
__host__ __device__ __forceinline__ void stage_rc(int b, int& R, int& C) { const int st = b / 1024, sb = b % 1024, swz = sb ^ (((sb >> 9) & 1) << 5); R = (st >> 1) * 16 + swz / 64; C = (st & 1) * 32 + (swz % 64) / 2; }
__host__ __device__ __forceinline__ int perm32(int rho) { const int n = rho >> 4, i = rho & 15; return 8 * (i >> 2) + 4 * n + (i & 3); }
struct Unit { int pm, pn; int half; };
struct Gemm { const bf16_t* A; const bf16_t* Bt; int lda, ldb, K; int kmod, kstride; };
struct StaticOrder {
    int nM, nN, nwg, G, c, l0, maxi;
    __device__ void init(int M, int N, int G_, int c_, int l0_ = 0, int maxi_ = 0x7fffffff) { nM = M / BM; nN = N / BM; nwg = nM * nN; G = G_; c = c_; l0 = l0_; maxi = maxi_; }
    __device__ bool next(int i, Unit& u) const {
        if (i >= maxi || c < 0) return false;
        const long L = (long)l0 + (long)i * G + c; if (L >= nwg) return false;
        int wgid = (int)L; { const int q = nwg / NXCD, r = nwg % NXCD, xcd = wgid % NXCD, off = wgid / NXCD; wgid = (xcd < r ? xcd * (q + 1) : r * (q + 1) + (xcd - r) * q) + off; }
        const int nig = WGM * nN, gid = wgid / nig, fm = gid * WGM, gsz = (nM - fm) < WGM ? (nM - fm) : WGM;
        u.pm = fm + ((wgid % nig) % gsz); u.pn = (wgid % nig) / gsz; u.half = 0; return true;
    }
    __device__ __forceinline__ void a_ready(const Unit&) const {}
};
struct MoeOrder {
    const int* tstart; const int* tiles; int nct, G, c; int T;
    __device__ bool next(int i, Unit& u) const {
        const int total = T;
        const long L = (long)i * G + c; if (L >= (long)total * nct) return false;
        const int q = (int)(L / nct), ct = (int)(L % nct), w = ld_agent_i(tiles + q), p = w & 255, e = (w >> 8) & 255;
        u.pm = p; u.pn = e * nct + ct; u.half = w >> 16; return true;
    }
    __device__ __forceinline__ void a_ready(const Unit&) const {}
};
struct MoeOrder2 {
    const int* tstart; const int* tiles; unsigned* cnt; unsigned* tmo; int G, c; int T;
    __device__ bool next(int i, Unit& u) const {
        const int n1 = 4 * T, nh = n1 > G ? (n1 - G < G ? n1 - G : G - 1) : 0;
        if (c < nh) return false;
        const long L = (long)i * (G - nh) + (c - nh); if (L >= (long)T * 8) return false;
        const int q = (int)(L >> 3), ct = (int)(L & 7), w = ld_agent_i(tiles + q), p = w & 255, e = (w >> 8) & 255;
        u.pm = p; u.pn = e * 8 + ct; u.half = w >> 16; return true;
    }
    __device__ __forceinline__ void a_ready(const Unit& u) const {
        if (threadIdx.x < 64) {
            unsigned sp = 0;
            while ((unsigned)__builtin_amdgcn_readfirstlane(__hip_atomic_load(cnt + 64 * u.pm, __ATOMIC_RELAXED, __HIP_MEMORY_SCOPE_AGENT)) < 32u) {
                __builtin_amdgcn_s_sleep(2);
                if ((++sp & 255u) == 0u) { if (__hip_atomic_load(tmo, __ATOMIC_RELAXED, __HIP_MEMORY_SCOPE_AGENT)) break; if (sp > (1u << 20)) { atomicAdd(tmo, 1u); break; } } }
            __builtin_amdgcn_fence(__ATOMIC_ACQUIRE, "agent");
            asm volatile("s_waitcnt vmcnt(0)" ::: "memory");
        }
        asm volatile("" ::: "memory"); __builtin_amdgcn_s_barrier(); asm volatile("" ::: "memory");
    }
};
struct EpiBf16 {
    static constexpr bool PERM = true;
    __device__ __forceinline__ void done(const Unit&) const {}
    bf16_t* O; int ldc; int pnmask;
    __device__ __forceinline__ void operator()(const f32x4 (&acc)[2][2][4][2], const Unit& u, int wr, int wc, int fr, int fq) const {
        const int row0 = u.pm * BM + wr * 64 + fr; const int col0 = (u.pn & pnmask) * BM + wc * 32 + 8 * fq;
#pragma unroll
        for (int ai = 0; ai < 2; ++ai)
#pragma unroll
            for (int m = 0; m < 4; ++m) { bf16_t* rowp = O + (size_t)(row0 + ai * HALF + m * 16) * ldc + col0;
#pragma unroll
                for (int bj = 0; bj < 2; ++bj) { const f32x4 v0 = acc[ai][bj][m][0], v1 = acc[ai][bj][m][1];
                    u32x4 w; w.x = cvtpk(v0[0], v0[1]); w.y = cvtpk(v0[2], v0[3]); w.z = cvtpk(v1[0], v1[1]); w.w = cvtpk(v1[2], v1[3]);
                    *(u32x4*)(rowp + bj * HALF) = w; } }
    }
};
struct EpiResid {
    static constexpr bool PERM = false;
    __device__ __forceinline__ void done(const Unit&) const {}
    float* C; const float* R; int ldc;
    __device__ __forceinline__ void operator()(const f32x4 (&acc)[2][2][4][2], const Unit& u, int wr, int wc, int fr, int fq) const {
        const int row0 = u.pm * BM + wr * 64 + fr, col0 = u.pn * BM + wc * 32 + 4 * fq;
#pragma unroll
        for (int ai = 0; ai < 2; ++ai)
#pragma unroll
            for (int m = 0; m < 4; ++m) { const size_t off = (size_t)(row0 + ai * HALF + m * 16) * ldc + col0;
#pragma unroll
                for (int bj = 0; bj < 2; ++bj)
#pragma unroll
                    for (int n = 0; n < 2; ++n) { const f32x4 rv = *(const f32x4*)(R + off + bj * HALF + n * 16); *(f32x4*)(C + off + bj * HALF + n * 16) = acc[ai][bj][m][n] + rv; } }
    }
};
struct EpiMoe1 {
    static constexpr bool PERM = false;
    bf16_t* H; const float* slotw; const float* slotr; unsigned* cnt;
    __device__ __forceinline__ void done(const Unit& u) const {
        if (cnt) { asm volatile("s_waitcnt vmcnt(0)" ::: "memory"); if (lane_id() == 0) __hip_atomic_fetch_add(cnt + 64 * u.pm, 1u, __ATOMIC_RELAXED, __HIP_MEMORY_SCOPE_AGENT); } }
    __device__ __forceinline__ void operator()(const f32x4 (&acc)[2][2][4][2], const Unit& u, int wr, int wc, int fr, int fq) const {
        const int row0 = u.pm * BM + wr * 64 + fr; const int ct = u.pn & 3;
        const __amdgpu_buffer_rsrc_t rsrc = __builtin_amdgcn_make_buffer_rsrc((void*)H, (short)0, MAXSLOT * 512 * 2, 0x00020000);
#pragma unroll
        for (int ai = 0; ai < 2; ++ai)
#pragma unroll
            for (int m = 0; m < 4; ++m) { const int row = row0 + ai * HALF + m * 16; const float w = slotw[row], rs = slotr[row]; u32x4 o;
#pragma unroll
                for (int bj = 0; bj < 2; ++bj) { const f32x4 g = acc[ai][bj][m][0], up = acc[ai][bj][m][1]; float hv[4];
#pragma unroll
                    for (int j = 0; j < 4; ++j) { const float gj = g[j] * rs; hv[j] = gj * __builtin_amdgcn_rcpf(1.0f + __expf(-gj)) * (up[j] * rs) * w; }
                    o[2 * bj] = cvtpk(hv[0], hv[1]); o[2 * bj + 1] = cvtpk(hv[2], hv[3]); }
                __builtin_amdgcn_raw_buffer_store_b128(o, rsrc, (row * 512 + ct * 128 + wc * 32 + 8 * fq) * 2, 0, 16); }
    }
};

template <bool GATHER = false, bool HALFSKIP = false, class Epi, class Sched>
__device__ __forceinline__ void gemm_phase(LAS unsigned char* lds, const Gemm g, const Sched& S, const Epi& E, int wv, const int* perm = nullptr) {
    const int tid = otid(wv), wid = __builtin_amdgcn_readfirstlane(tid >> 6), lane = tid & 63, wr = wid >> 2, wc = wid & 3, fr = lane & 15, fq = lane >> 4;
    const int K = g.K, nt = K / BK;
    unsigned voffA[2], voffB[2]; int rA[2], cA2[2];
#pragma unroll
    for (int i = 0; i < 2; ++i) { int R, C; stage_rc(tid * 16 + i * 8192, R, C); const int Rb = Epi::PERM ? ((R & ~31) + perm32(R & 31)) : R; rA[i] = R; cA2[i] = C * 2;
        voffA[i] = (unsigned)(R * g.lda + C) * 2u; voffB[i] = (unsigned)(Rb * g.ldb + C) * 2u; }
    const size_t kstep = (size_t)(BK * 2);
    const size_t hstepA = (size_t)HALF * g.lda * 2, hstepB = (size_t)HALF * g.ldb * 2;
    const size_t tstepA = 2 * hstepA, tstepB = 2 * hstepB;
    const unsigned ldsw = (unsigned)wid * 1024u;
    const int aoff = lds_byte(wr * 64 + fr, fq * 8), boff = lds_byte(wc * 32 + fr, fq * 8);
#define PG8_SA(b, h) (((b) * 2 + (h)) * HTB)
#define PG8_SB(b, h) ((4 + (b) * 2 + (h)) * HTB)
#define PG8_STAGE(bufoff, gbase, voff) do { _Pragma("unroll") for (int _i = 0; _i < 2; ++_i) \
        __builtin_amdgcn_global_load_lds((const unsigned*)((const char*)(gbase) + (voff)[_i]), (LAS unsigned*)(lds + (bufoff) + ldsw + _i * 8192), 16, 0, 0); } while (0)
#define PG8_STAGE_A(bufoff, h, kb, nx) do { if constexpr (GATHER) { _Pragma("unroll") for (int _i = 0; _i < 2; ++_i) \
        __builtin_amdgcn_global_load_lds((const unsigned*)((const char*)g.A + (kb) + ((nx) ? vN[h][_i] : vC[h][_i])), (LAS unsigned*)(lds + (bufoff) + ldsw + _i * 8192), 16, 0, 0); } \
        else { PG8_STAGE(bufoff, ((nx) ? nA : cA) + (h) * hstepA + (kb), voffA); } } while (0)
#define PG8_VOFF(v, u) do { _Pragma("unroll") for (int _h = 0; _h < 2; ++_h) _Pragma("unroll") for (int _i = 0; _i < 2; ++_i) \
        v[_h][_i] = (unsigned)perm[(u).pm * BM + _h * HALF + rA[_i]] * (unsigned)(g.lda * 2) + (unsigned)cA2[_i]; } while (0)
#define PG8_LDA(dst, b, h) do { _Pragma("unroll") for (int m = 0; m < 4; ++m) _Pragma("unroll") for (int k = 0; k < 2; ++k) dst[m][k] = *(const LAS bf16x8*)(lds + PG8_SA(b, h) + aoff + m * 2048 + k * 1024); } while (0)
#define PG8_LDB(dst, b, h) do { _Pragma("unroll") for (int n = 0; n < 2; ++n) _Pragma("unroll") for (int k = 0; k < 2; ++k) dst[n][k] = *(const LAS bf16x8*)(lds + PG8_SB(b, h) + boff + n * 2048 + k * 1024); } while (0)
#define PG8_MMA(ai, bj, At, Bt) do { __builtin_amdgcn_s_setprio(1); _Pragma("unroll") for (int m = 0; m < 4; ++m) _Pragma("unroll") for (int n = 0; n < 2; ++n) _Pragma("unroll") for (int k = 0; k < 2; ++k) \
        acc[ai][bj][m][n] = __builtin_amdgcn_mfma_f32_16x16x32_bf16(Bt[n][k], At[m][k], acc[ai][bj][m][n], 0, 0, 0); __builtin_amdgcn_s_setprio(0); } while (0)
#define PG8_WAIT_V(n) asm volatile("s_waitcnt vmcnt(" #n ")" ::: "memory")
#define PG8_WAIT_L(n) asm volatile("s_waitcnt lgkmcnt(" #n ")" ::: "memory")
#define PG8_BAR __builtin_amdgcn_s_barrier()
#define PG8_SCHED __builtin_amdgcn_sched_barrier(0)
    Unit cur, nxt; int ui = 0;
    if (!S.next(0, cur)) return;
    f32x4 acc[2][2][4][2];
#pragma unroll
    for (int a = 0; a < 2; ++a)
#pragma unroll
        for (int b = 0; b < 2; ++b)
#pragma unroll
            for (int m = 0; m < 4; ++m)
#pragma unroll
                for (int n = 0; n < 2; ++n) acc[a][b][m][n] = (f32x4){0.f, 0.f, 0.f, 0.f};
    bf16x8 At[4][2], B0[2][2], B1[2][2];
    unsigned vC[2][2] = {{0u, 0u}, {0u, 0u}}, vN[2][2] = {{0u, 0u}, {0u, 0u}};
    S.a_ready(cur);
    if constexpr (GATHER) PG8_VOFF(vC, cur);
    const char* cA = (const char*)g.A + (GATHER ? (size_t)0 : (size_t)cur.pm * tstepA) + (size_t)((cur.pn % g.kmod) * g.kstride) * 2; const char* cB = (const char*)g.Bt + (size_t)cur.pn * tstepB + (size_t)((cur.pn % g.kmod) * g.kstride) * 2; const char* nA = cA;
    PG8_STAGE(PG8_SB(0, 0), cB, voffB); PG8_STAGE_A(PG8_SA(0, 0), 0, (size_t)0, false); PG8_STAGE(PG8_SB(0, 1), cB + hstepB, voffB); PG8_STAGE_A(PG8_SA(0, 1), 1, (size_t)0, false);
    if (wr == 1) PG8_BAR;
    PG8_WAIT_V(4); PG8_BAR;
    PG8_STAGE(PG8_SB(1, 0), cB + kstep, voffB); PG8_STAGE_A(PG8_SA(1, 0), 0, kstep, false); PG8_STAGE(PG8_SB(1, 1), cB + hstepB + kstep, voffB);
    PG8_WAIT_V(6); PG8_BAR;
    for (;;) {
        const bool has_next = S.next(ui + 1, nxt);
        if constexpr (GATHER) { if (has_next) PG8_VOFF(vN, nxt); else { vN[0][0] = vC[0][0]; vN[0][1] = vC[0][1]; vN[1][0] = vC[1][0]; vN[1][1] = vC[1][1]; } }
        const size_t nko = has_next ? (size_t)((nxt.pn % g.kmod) * g.kstride) * 2 : 0;
        nA = (has_next && !GATHER) ? (const char*)g.A + (size_t)nxt.pm * tstepA + nko : cA; const char* nB = has_next ? (const char*)g.Bt + (size_t)nxt.pn * tstepB + nko : cB;
        for (int t = 0; t < nt; t += 2) {
            const bool last = (t == nt - 2);
            if (last && has_next) S.a_ready(nxt);
            const size_t k1 = (size_t)(t + 1) * kstep, k2 = last ? (size_t)0 : (size_t)(t + 2) * kstep, k3 = k2 + kstep;
            const char* b2 = last ? nB : cB + (size_t)(t + 2) * kstep; const char* b3 = b2 + kstep;
            PG8_LDB(B0, 0, 0); PG8_SCHED; PG8_LDA(At, 0, 0); PG8_STAGE_A(PG8_SA(1, 1), 1, k1, false);
            PG8_WAIT_L(8); PG8_BAR; PG8_WAIT_L(0); PG8_MMA(0, 0, At, B0); PG8_BAR; PG8_SCHED;
            PG8_LDB(B1, 0, 1); PG8_STAGE(PG8_SB(0, 0), b2, voffB);
            PG8_BAR; PG8_WAIT_L(0); PG8_MMA(0, 1, At, B1); PG8_BAR;
            PG8_LDA(At, 0, 1); PG8_STAGE_A(PG8_SA(0, 0), 0, k2, last);
            PG8_BAR; PG8_WAIT_L(0); if (!(HALFSKIP && cur.half)) PG8_MMA(1, 0, At, B0); PG8_BAR; PG8_SCHED;
            PG8_STAGE(PG8_SB(0, 1), b2 + hstepB, voffB);
            PG8_WAIT_V(6); PG8_BAR; if (!(HALFSKIP && cur.half)) PG8_MMA(1, 1, At, B1); PG8_BAR;
            PG8_LDB(B0, 1, 0); PG8_SCHED; PG8_LDA(At, 1, 0); PG8_STAGE_A(PG8_SA(0, 1), 1, k2, last);
            PG8_WAIT_L(8); PG8_BAR; PG8_WAIT_L(0); PG8_MMA(0, 0, At, B0); PG8_BAR; PG8_SCHED;
            PG8_LDB(B1, 1, 1); PG8_STAGE(PG8_SB(1, 0), b3, voffB);
            PG8_BAR; PG8_WAIT_L(0); PG8_MMA(0, 1, At, B1); PG8_BAR;
            PG8_LDA(At, 1, 1); PG8_STAGE_A(PG8_SA(1, 0), 0, k3, last);
            PG8_BAR; PG8_WAIT_L(0); if (!(HALFSKIP && cur.half)) PG8_MMA(1, 0, At, B0); PG8_BAR; PG8_SCHED;
            PG8_STAGE(PG8_SB(1, 1), b3 + hstepB, voffB);
            PG8_WAIT_V(6); PG8_BAR; if (!(HALFSKIP && cur.half)) PG8_MMA(1, 1, At, B1); PG8_BAR;
        }
        E(acc, cur, wr, wc, fr, fq); E.done(cur);
        if (!has_next) break;
#pragma unroll
        for (int a = 0; a < 2; ++a)
#pragma unroll
            for (int b = 0; b < 2; ++b)
#pragma unroll
                for (int m = 0; m < 4; ++m)
#pragma unroll
                    for (int n = 0; n < 2; ++n) acc[a][b][m][n] = (f32x4){0.f, 0.f, 0.f, 0.f};
        cur = nxt; cA = nA; cB = nB; ++ui;
        if constexpr (GATHER) { vC[0][0] = vN[0][0]; vC[0][1] = vN[0][1]; vC[1][0] = vN[1][0]; vC[1][1] = vN[1][1]; }
    }
    PG8_WAIT_V(0);
    if (wr == 0) PG8_BAR;
    PG8_BAR;
#undef PG8_SA
#undef PG8_SB
#undef PG8_STAGE
#undef PG8_STAGE_A
#undef PG8_VOFF
#undef PG8_LDA
#undef PG8_LDB
#undef PG8_MMA
#undef PG8_WAIT_V
#undef PG8_WAIT_L
#undef PG8_BAR
#undef PG8_SCHED
}
}

struct Args {
    const float* x; const int* pos; const float* rel_bias; const float* norm_mix; const float* w_in; const float* g_cq; const float* w_uq; const float* g_ckv; const float* w_ukv;
    const float* g_q; const float* g_k; const float* dg_q; const float* dg_k; const float* conv_w; const float* conv_b; const float* ml_wq; const float* ml_wk; const float* gate_bias;
    const float* g_out; const float* w_out; const float* norm_ffn; const float* wg; const float* bg; const float* we; const float* be; const float* w_gate; const float* w_up; const float* w_down;
    float* out; unsigned char* ws; int ph_lo, ph_hi;
};
typedef __attribute__((address_space(1))) unsigned char gchar_t;
DEV gchar_t* ows(const Args& a) { gchar_t* p = (gchar_t*)a.ws; asm volatile("" : "+s"(p)); return p; }
#define WSP(T, off) ((T*)(ows(a) + (off)))

__constant__ unsigned char c_bucket[3][129] = {
{11,11,11,11,11,11,11,11,11,11,11,11,11,11,11,10,10,10,10,10,10,10,10,10,10,10,10,10,10,10,10,10,10,10,10,10,10,10,9,9,9,9,9,9,9,9,9,9,9,9,8,8,8,8,8,8,8,7,6,5,4,3,2,1,0,17,18,19,20,21,22,23,24,24,24,24,24,24,24,25,25,25,25,25,25,25,25,25,25,25,25,26,26,26,26,26,26,26,26,26,26,26,26,26,26,26,26,26,26,26,26,26,26,26,27,27,27,27,27,27,27,27,27,27,27,27,27,27,27},
{13,13,13,13,13,13,13,13,13,13,13,13,13,13,13,13,13,13,13,13,13,13,13,12,12,12,12,12,12,12,12,12,12,12,12,12,12,12,12,12,12,12,11,11,11,11,11,11,11,11,11,11,10,10,10,10,10,10,9,9,9,8,8,4,0,20,24,24,25,25,25,26,26,26,26,26,26,27,27,27,27,27,27,27,27,27,27,28,28,28,28,28,28,28,28,28,28,28,28,28,28,28,28,28,28,28,29,29,29,29,29,29,29,29,29,29,29,29,29,29,29,29,29,29,29,29,29,29,29},
{15,15,15,15,15,15,15,15,15,15,15,15,15,15,15,15,15,15,15,15,15,15,15,15,15,15,15,15,15,15,14,14,14,14,14,14,14,14,14,14,14,14,14,14,14,13,13,13,13,13,13,13,13,13,12,12,12,12,12,11,11,10,10,9,0,25,26,26,27,27,28,28,28,28,28,29,29,29,29,29,29,29,29,29,30,30,30,30,30,30,30,30,30,30,30,30,30,30,30,31,31,31,31,31,31,31,31,31,31,31,31,31,31,31,31,31,31,31,31,31,31,31,31,31,31,31,31,31,31}};

DEV void cvt_item(const float* src, size_t ldsrc, int k0, int n0, int nvalid, bf16_t* dst, size_t lddst, int drow0, int dcol0, bool mode16, float scale, LAS float* scr, int lane, bool remap = false) {
    if (src) {
        f32x4 v[16];
        const int c4 = lane & 15, rq = lane >> 4; const int sn = remap ? win_src_col(n0 + c4 * 4) : n0 + c4 * 4; const bool ok = sn >= 0 && sn < nvalid;
#pragma unroll
        for (int i = 0; i < 16; ++i) v[i] = ok ? __builtin_nontemporal_load((const f32x4*)(src + (size_t)(k0 + i * 4 + rq) * ldsrc + sn)) : __builtin_bit_cast(f32x4, zero4());
#pragma unroll
        for (int i = 0; i < 16; ++i) { LAS float* d = scr + (i * 4 + rq) * 65 + c4 * 4; d[0] = v[i][0] * scale; d[1] = v[i][1] * scale; d[2] = v[i][2] * scale; d[3] = v[i][3] * scale; }
    }
    asm volatile("s_waitcnt lgkmcnt(0)" ::: "memory");
    const int c = lane & 7;
#pragma unroll
    for (int j = 0; j < 8; ++j) { const int n = (lane >> 3) + 8 * j; const LAS float* s = scr + (8 * c) * 65 + n;
        u32x4 o = zero4();
        if (src) { o.x = cvtpk(s[0 * 65], s[1 * 65]); o.y = cvtpk(s[2 * 65], s[3 * 65]); o.z = cvtpk(s[4 * 65], s[5 * 65]); o.w = cvtpk(s[6 * 65], s[7 * 65]); }
        const int dr = drow0 + (mode16 ? (((n >> 2) & 1) * 128 + (n >> 5) * 32 + ((n >> 3) & 3) * 4 + (n & 3)) : n);
        *(u32x4*)(dst + (size_t)dr * lddst + dcol0 + 8 * c) = o; }
    asm volatile("s_waitcnt lgkmcnt(0)" ::: "memory");
}
DEV void phase_cvt_a(const Args& a, int l, LAS unsigned char* lds, int wv) {
    const int wid = __builtin_amdgcn_readfirstlane(otid(wv) >> 6), lane = otid(wv) & 63;
    LAS float* scr = (LAS float*)(lds + wid * 16640);
    const int gw = blockIdx.x * 8 + wid, NGW = gridDim.x * 8;
    constexpr int I_IN = 84 * 32, I_OUT = 32 * 32, I_BD1 = 28 * 8, I_BD2 = 24 * 12, NIT = I_IN + I_OUT + I_BD1 + I_BD2;
    bf16_t* WinT = WSP(bf16_t, A_WIN); bf16_t* WoutT = WSP(bf16_t, A_WOUT); bf16_t* BD1 = WSP(bf16_t, A_BD1); bf16_t* BD2 = WSP(bf16_t, A_BD2);
    for (int it = gw; it < NIT; it += NGW) {
        int r = it;
        if (r < I_IN) { const int nb = r % 84, kb = r / 84;
            cvt_item(a.w_in + (size_t)l * DM * CIN, CIN, kb * 64, nb * 64, CIN, WinT, DM, nb * 64, kb * 64, false, 1.f, scr, lane, true); continue; } r -= I_IN;
        if (r < I_OUT) { const int nb = r % 32, kb = r / 32;
            cvt_item(a.w_out + (size_t)l * DM * DM, DM, kb * 64, nb * 64, DM, WoutT, DM, nb * 64, kb * 64, false, 1.f, scr, lane); continue; } r -= I_OUT;
        if (r < I_BD1) { const int nb = r % 28, kb = r / 28;
            const float* src = nullptr; size_t lds_ = 0; int k0 = 0, n0 = 0, nv = 0;
            if (nb < 12) { if (kb < 6) { src = a.w_uq + (size_t)l * 384 * 768; lds_ = 768; k0 = kb * 64; n0 = nb * 64; nv = 768; } }
            else { if (kb >= 6) { src = a.w_ukv + (size_t)l * 128 * 1024; lds_ = 1024; k0 = (kb - 6) * 64; n0 = (nb - 12) * 64; nv = 1024; } }
            cvt_item(src, lds_, k0, n0, nv, BD1, 512, nb * 64, kb * 64, false, 1.f, scr, lane); continue; } r -= I_BD1;
        { const int nb = r % 24, kb = r / 24;
            const int n = nb * 64, which = n / 768, np = n % 768, hd = np / 192, e0 = np % 192, hk = kb / 3;
            const float* src = nullptr; int k0 = 0;
            if (hk == hd) { src = (which ? a.ml_wk : a.ml_wq) + ((size_t)l * 4 + hd) * 192 * 192; k0 = (kb % 3) * 64; }
            cvt_item(src, 192, k0, e0, 192, BD2, 768, nb * 64, kb * 64, false, which ? 0.07216878364870322f : 1.f, scr, lane); }
    }
}
DEV void phase_cvt_router(const Args& a, int l, int wv) {
    f32x4* WR3 = WSP(f32x4, WS_WR3); const float* wg = a.wg + (size_t)l * DM * 4; const float* we = a.we + (size_t)l * DM * 16;
    for (int it = blockIdx.x * 512 + otid(wv); it < 8 * 20 * 64; it += gridDim.x * 512) { const int ln = it & 63, q = (it >> 6) % 20, i = it / (64 * 20), c = q / 5, qq = q % 5, e = (i * 64 + ln) * 4 + c;
        WR3[it] = (qq == 0) ? *(const f32x4*)(wg + (size_t)e * 4) : *(const f32x4*)(we + (size_t)e * 16 + (qq - 1) * 4); }
}
DEV void phase_cvt_b(const Args& a, int l, LAS unsigned char* lds, int b0, int wv) {
    const int wid = __builtin_amdgcn_readfirstlane(otid(wv) >> 6), lane = otid(wv) & 63;
    LAS float* scr = (LAS float*)(lds + wid * 16640);
    if ((int)blockIdx.x < b0) return;
    const int gw = ((int)blockIdx.x - b0) * 8 + wid, NGW = ((int)gridDim.x - b0) * 8;
    constexpr int I_W1 = 16 * 2 * 8 * 32, I_W2 = 16 * 32 * 8;
    bf16_t* W1 = WSP(bf16_t, B_W1); bf16_t* W2 = WSP(bf16_t, B_W2);
    for (int it = gw; it < I_W1 + I_W2; it += NGW) {
        int r = it;
        if (r < I_W1) { const int fb = r % 8; r /= 8; const int kb = r % 32; r /= 32; const int mat = r % 2, e = r / 2;
            const float* src = (mat ? a.w_up : a.w_gate) + ((size_t)l * 16 + e) * 2048 * 512;
            cvt_item(src, 512, kb * 64, fb * 64, 512, W1, 2048, e * 1024 + (fb >> 1) * 256 + (fb & 1) * 64 + mat * 16, kb * 64, true, 1.f, scr, lane); continue; } r -= I_W1;
        { const int nb = r % 32; r /= 32; const int kb = r % 8, e = r / 8;
            const float* src = a.w_down + ((size_t)l * 16 + e) * 512 * 2048;
            cvt_item(src, 2048, kb * 64, nb * 64, 2048, W2, 512, e * 2048 + nb * 64, kb * 64, false, 1.f, scr, lane); }
    }
}

__constant__ float c_invfreq[16] = {1.0f, 0.5623413f, 0.31622776f, 0.17782794f, 0.1f, 0.056234132f, 0.031622775f, 0.017782794f, 0.01f, 0.0056234132f, 0.0031622776f, 0.0017782794f, 0.001f, 0.00056234133f, 0.00031622776f, 0.00017782794f};
DEV void phase_rope(const Args& a, int wv) {
    float* COS = WSP(float, WS_COS); float* SIN = WSP(float, WS_SIN);
    for (int i = blockIdx.x * 512 + otid(wv); i < S_ * 16; i += gridDim.x * 512) {
        const int t = i >> 4, f = i & 15;
        const float ang = (float)a.pos[t] * c_invfreq[f];
        const double rev = (double)ang * 0.15915494309189535;
        const float fr = (float)(rev - __builtin_rint(rev));
        COS[i] = __builtin_amdgcn_cosf(fr); SIN[i] = __builtin_amdgcn_sinf(fr);
    }
}

DEV void phase_norm1(const Args& a, int l, int mode, int wv) {
    const int wid = __builtin_amdgcn_readfirstlane(otid(wv) >> 6), lane = otid(wv) & 63;
    const float* src = mode == 2 ? (const float*)a.out : a.x; const bf16_t* DLT = WSP(bf16_t, WS_XB);
    const bf16_t* YS = WSP(bf16_t, B_YS); const int* SLOTOF = WSP(int, WS_SLOTOF); bf16_t* XN = WSP(bf16_t, WS_XN);
    const float* gain = a.norm_mix + (size_t)(mode == 2 ? 0 : l) * DM;
    const int nw = gridDim.x * 8;
    for (int row0 = blockIdx.x * 8 + wid; row0 < S_; row0 += 2 * nw) {
        f32x4 v[2][8]; int sl[2][2] = {{0, 0}, {0, 0}}; const int rws[2] = {row0, row0 + nw < S_ ? row0 + nw : row0};
        if (mode != 0) {
#pragma unroll
            for (int rr = 0; rr < 2; ++rr) { sl[rr][0] = ld_agent_i(SLOTOF + rws[rr] * 2); sl[rr][1] = ld_agent_i(SLOTOF + rws[rr] * 2 + 1); } }
#pragma unroll
        for (int rr = 0; rr < 2; ++rr)
#pragma unroll
            for (int i = 0; i < 8; ++i) v[rr][i] = (mode == 0) ? __builtin_nontemporal_load((const f32x4*)(src + (size_t)rws[rr] * DM + (i * 64 + lane) * 4)) : ld_h4nt(src, DLT, (size_t)rws[rr] * DM + (i * 64 + lane) * 4);
        if (mode != 0) {
#pragma unroll
            for (int rr = 0; rr < 2; ++rr) { const int row = rws[rr];
#pragma unroll
                for (int i = 0; i < 8; ++i) { const u32x2 y0 = __builtin_nontemporal_load((const u32x2*)(YS + (size_t)sl[rr][0] * DM + (i * 64 + lane) * 4)), y1 = __builtin_nontemporal_load((const u32x2*)(YS + (size_t)sl[rr][1] * DM + (i * 64 + lane) * 4));
                    v[rr][i][0] += __uint_as_float(y0.x << 16) + __uint_as_float(y1.x << 16); v[rr][i][1] += __uint_as_float(y0.x & 0xffff0000u) + __uint_as_float(y1.x & 0xffff0000u);
                    v[rr][i][2] += __uint_as_float(y0.y << 16) + __uint_as_float(y1.y << 16); v[rr][i][3] += __uint_as_float(y0.y & 0xffff0000u) + __uint_as_float(y1.y & 0xffff0000u);
                    if (mode == 2) __builtin_nontemporal_store(v[rr][i], (f32x4*)(a.out + (size_t)row * DM + (i * 64 + lane) * 4)); else *(f32x4*)(a.out + (size_t)row * DM + (i * 64 + lane) * 4) = v[rr][i]; } } }
        if (mode == 2) continue;
#pragma unroll
        for (int rr = 0; rr < 2; ++rr) { const int row = rws[rr]; float ss = 0.f;
#pragma unroll
            for (int i = 0; i < 8; ++i) ss += (v[rr][i][0] * v[rr][i][0] + v[rr][i][1] * v[rr][i][1]) + (v[rr][i][2] * v[rr][i][2] + v[rr][i][3] * v[rr][i][3]);
            const float rstd = rsqrtf(wave_sum(ss) * (1.f / DM) + EPS);
#pragma unroll
            for (int i = 0; i < 8; ++i) { const f32x4 g = *(const f32x4*)(gain + (i * 64 + lane) * 4); u32x2 o;
                o.x = cvtpk(v[rr][i][0] * rstd * g[0], v[rr][i][1] * rstd * g[1]); o.y = cvtpk(v[rr][i][2] * rstd * g[2], v[rr][i][3] * rstd * g[3]);
                *(u32x2*)(XN + (size_t)row * DM + (i * 64 + lane) * 4) = o; } }
    }
}

DEV float logsigmoidf(float x) { return fminf(x, 0.f) - __logf(1.f + __expf(-fabsf(x))); }

DEV void phase_p3a(const Args& a, int l, int wv) {
    const int wid = __builtin_amdgcn_readfirstlane(otid(wv) >> 6), lane = otid(wv) & 63, l16 = lane & 15;
    const bf16_t* PROJ = WSP(bf16_t, A_PROJ); bf16_t* CQKV = WSP(bf16_t, A_CQKV); bf16_t* UC = WSP(bf16_t, A_UC);
    float* KR = WSP(float, WS_KR); float* GLI = WSP(float, WS_GLI); float* GLF = WSP(float, WS_GLF);
    const float* COS = WSP(float, WS_COS); const float* SIN = WSP(float, WS_SIN);
    const float* gcq = a.g_cq + l * 384; const float* gckv = a.g_ckv + l * 128; const float* cw = a.conv_w + (size_t)l * 5 * 768; const float* cb = a.conv_b + l * 768; const float* gb = a.gate_bias + l * 16;
    float2 wcv[6][5], bv[6], gq2[3], gk2;
#pragma unroll
    for (int i = 0; i < 6; ++i) { const int ch = 2 * lane + 128 * i; bv[i] = *(const float2*)(cb + ch);
#pragma unroll
        for (int j = 0; j < 5; ++j) wcv[i][j] = *(const float2*)(cw + j * 768 + ch); }
#pragma unroll
    for (int i = 0; i < 3; ++i) gq2[i] = *(const float2*)(gcq + 2 * lane + 128 * i);
    gk2 = *(const float2*)(gckv + 2 * lane);
    const float gbias = gb[l16];
    for (int tq = blockIdx.x * 4; tq < S_ / 8; tq += gridDim.x * 4) for (int tj = 0; tj < 4; ++tj) { const int t = (tq + tj) * 8 + wid;
        const bf16_t* pr = PROJ + (size_t)t * CINP;
        float2 cq[3], u[6][5];
#pragma unroll
        for (int i = 0; i < 3; ++i) cq[i] = ld_bf2(pr + OFF_CQ + 2 * lane + 128 * i);
        const float2 ck = ld_bf2(pr + OFF_CKV + 2 * lane);
        const float x1 = bf2f(pr[OFF_KR + l16]), x2 = bf2f(pr[OFF_KR + 16 + l16]), cs = COS[t * 16 + l16], sn = SIN[t * 16 + l16];
        const float pre = bf2f(pr[OFF_MG + l16]) + gbias;
#pragma unroll
        for (int j = 0; j < 5; ++j) { const int tt = t + j - 2, tc = tt < 0 ? 0 : (tt >= S_ ? S_ - 1 : tt);
#pragma unroll
            for (int i = 0; i < 6; ++i) u[i][j] = ld_bf2(PROJ + (size_t)tc * CINP + OFF_MU + 2 * lane + 128 * i); }
        { float ss = 0.f;
#pragma unroll
          for (int i = 0; i < 3; ++i) ss += cq[i].x * cq[i].x + cq[i].y * cq[i].y;
          const float rq = rsqrtf(wave_sum(ss) * (1.f / 384.f) + EPS);
#pragma unroll
          for (int i = 0; i < 3; ++i) st_bf2(CQKV + (size_t)t * 512 + 2 * lane + 128 * i, cq[i].x * rq * gq2[i].x, cq[i].y * rq * gq2[i].y); }
        { const float rk = rsqrtf(wave_sum(ck.x * ck.x + ck.y * ck.y) * (1.f / 128.f) + EPS);
          st_bf2(CQKV + (size_t)t * 512 + 384 + 2 * lane, ck.x * rk * gk2.x, ck.y * rk * gk2.y); }
        if (lane < 16) { KR[t * 32 + lane] = x1 * cs - x2 * sn; KR[t * 32 + 16 + lane] = x1 * sn + x2 * cs; }
#pragma unroll
        for (int i = 0; i < 6; ++i) { float a0 = bv[i].x, a1 = bv[i].y;
#pragma unroll
            for (int j = 0; j < 5; ++j) { const int tt = t + j - 2; const float ok = (tt >= 0 && tt < S_) ? 1.f : 0.f; a0 += ok * u[i][j].x * wcv[i][j].x; a1 += ok * u[i][j].y * wcv[i][j].y; }
            a0 = a0 * __builtin_amdgcn_rcpf(1.f + __expf(-a0)); a1 = a1 * __builtin_amdgcn_rcpf(1.f + __expf(-a1));
            st_bf2(UC + (size_t)t * 768 + 2 * lane + 128 * i, a0, a1); }
        if (lane < 16) { const int dir = lane >> 3, isf = (lane >> 2) & 1, hd = lane & 3;
            if (!isf) GLI[(size_t)(dir * 4 + hd) * S_ + t] = pre; else GLF[(size_t)(dir * 4 + hd) * S_ + t] = logsigmoidf(pre); }
    }
}

constexpr float MLA_QSCALE = 0.10206207261596575f * 1.4426950408889634f;
DEV void phase_p3c(const Args& a, int l, bool do_dil, int wv) {
    const int wid = __builtin_amdgcn_readfirstlane(otid(wv) >> 6), lane = otid(wv) & 63, h8 = lane >> 3, l8 = lane & 7, hh = lane >> 4, l16 = lane & 15;
    bf16_t* PROJ = WSP(bf16_t, A_PROJ); const bf16_t* RAW = WSP(bf16_t, A_RAW); bf16_t* QM = WSP(bf16_t, A_QM); bf16_t* KM = WSP(bf16_t, A_KM);
    const float* KR = WSP(float, WS_KR); const float* COS = WSP(float, WS_COS); const float* SIN = WSP(float, WS_SIN);
    const float* gq = a.g_q + l * 96; const float* gk = a.g_k + l * 96; const float* dgq = a.dg_q + l * 64; const float* dgk = a.dg_k + l * 64;
    float gqn[8], gkn[8]; float2 gq1, gq2, gk1, gk2; f32x4 dq4, dk4;
#pragma unroll
    for (int j = 0; j < 8; ++j) { gqn[j] = gq[8 * l8 + j]; gkn[j] = gk[8 * l8 + j]; }
    gq1 = *(const float2*)(gq + 64 + 2 * l8); gq2 = *(const float2*)(gq + 80 + 2 * l8); gk1 = *(const float2*)(gk + 64 + 2 * l8); gk2 = *(const float2*)(gk + 80 + 2 * l8);
    dq4 = *(const f32x4*)(dgq + 4 * l16); dk4 = *(const f32x4*)(dgk + 4 * l16);
    for (int t = blockIdx.x * 8 + wid; t < S_; t += gridDim.x * 8) {
        const bf16_t* rq = RAW + (size_t)t * 1792; bf16_t* pr = PROJ + (size_t)t * CINP;
        const u32x4 qn = *(const u32x4*)(rq + h8 * 96 + 8 * l8); const float2 qx1 = ld_bf2(rq + h8 * 96 + 64 + 2 * l8), qx2 = ld_bf2(rq + h8 * 96 + 80 + 2 * l8);
        const u32x4 kn = *(const u32x4*)(rq + 768 + h8 * 128 + 8 * l8);
        const float2 cs = *(const float2*)(COS + t * 16 + 2 * l8), sn = *(const float2*)(SIN + t * 16 + 2 * l8);
        const float2 kr1 = *(const float2*)(KR + t * 32 + 2 * l8), kr2 = *(const float2*)(KR + t * 32 + 16 + 2 * l8);
        u32x2 dq[3], dk[3];
        if (do_dil) {
#pragma unroll
            for (int ps = 0; ps < 3; ++ps) { dq[ps] = *(const u32x2*)(pr + OFF_DQ + (ps * 4 + hh) * 64 + 4 * l16); dk[ps] = *(const u32x2*)(pr + OFF_DK + (ps * 4 + hh) * 64 + 4 * l16); } }
        { float v[8];
#pragma unroll
          for (int j = 0; j < 4; ++j) { v[2 * j] = __uint_as_float(qn[j] << 16); v[2 * j + 1] = __uint_as_float(qn[j] & 0xffff0000u); }
          const float o1x = qx1.x * cs.x - qx2.x * sn.x, o1y = qx1.y * cs.y - qx2.y * sn.y, o2x = qx1.x * sn.x + qx2.x * cs.x, o2y = qx1.y * sn.y + qx2.y * cs.y;
          float ss = o1x * o1x + o1y * o1y + o2x * o2x + o2y * o2y;
#pragma unroll
          for (int j = 0; j < 8; ++j) ss += v[j] * v[j];
          ss = sum_g8(ss);
          const float r = rsqrtf(ss * (1.f / 96.f) + EPS) * MLA_QSCALE;
          bf16_t* qo = QM + (size_t)t * 768 + h8 * 96; u32x4 w;
          w.x = cvtpk(v[0] * r * gqn[0], v[1] * r * gqn[1]); w.y = cvtpk(v[2] * r * gqn[2], v[3] * r * gqn[3]); w.z = cvtpk(v[4] * r * gqn[4], v[5] * r * gqn[5]); w.w = cvtpk(v[6] * r * gqn[6], v[7] * r * gqn[7]);
          *(u32x4*)(qo + 8 * l8) = w; st_bf2(qo + 64 + 2 * l8, o1x * r * gq1.x, o1y * r * gq1.y); st_bf2(qo + 80 + 2 * l8, o2x * r * gq2.x, o2y * r * gq2.y); }
        { float v[8];
#pragma unroll
          for (int j = 0; j < 4; ++j) { v[2 * j] = __uint_as_float(kn[j] << 16); v[2 * j + 1] = __uint_as_float(kn[j] & 0xffff0000u); }
          float ss = kr1.x * kr1.x + kr1.y * kr1.y + kr2.x * kr2.x + kr2.y * kr2.y;
#pragma unroll
          for (int j = 0; j < 8; ++j) ss += v[j] * v[j];
          ss = sum_g8(ss);
          const float r = rsqrtf(ss * (1.f / 96.f) + EPS);
          bf16_t* ko = KM + (size_t)t * 768 + h8 * 96; u32x4 w;
          w.x = cvtpk(v[0] * r * gkn[0], v[1] * r * gkn[1]); w.y = cvtpk(v[2] * r * gkn[2], v[3] * r * gkn[3]); w.z = cvtpk(v[4] * r * gkn[4], v[5] * r * gkn[5]); w.w = cvtpk(v[6] * r * gkn[6], v[7] * r * gkn[7]);
          *(u32x4*)(ko + 8 * l8) = w; st_bf2(ko + 64 + 2 * l8, kr1.x * r * gk1.x, kr1.y * r * gk1.y); st_bf2(ko + 80 + 2 * l8, kr2.x * r * gk2.x, kr2.y * r * gk2.y); }
        if (do_dil) {
#pragma unroll
            for (int ps = 0; ps < 3; ++ps) {
                { const float x0 = __uint_as_float(dq[ps].x << 16), x1 = __uint_as_float(dq[ps].x & 0xffff0000u), x2 = __uint_as_float(dq[ps].y << 16), x3 = __uint_as_float(dq[ps].y & 0xffff0000u);
                  float ss = sum_g16(x0 * x0 + x1 * x1 + x2 * x2 + x3 * x3);
                  const float r = rsqrtf(ss * (1.f / 64.f) + EPS); u32x2 w; w.x = cvtpk(x0 * r * dq4[0], x1 * r * dq4[1]); w.y = cvtpk(x2 * r * dq4[2], x3 * r * dq4[3]);
                  *(u32x2*)(pr + OFF_DQ + (ps * 4 + hh) * 64 + 4 * l16) = w; }
                { const float x0 = __uint_as_float(dk[ps].x << 16), x1 = __uint_as_float(dk[ps].x & 0xffff0000u), x2 = __uint_as_float(dk[ps].y << 16), x3 = __uint_as_float(dk[ps].y & 0xffff0000u);
                  float ss = sum_g16(x0 * x0 + x1 * x1 + x2 * x2 + x3 * x3);
                  const float r = rsqrtf(ss * (1.f / 64.f) + EPS); u32x2 w; w.x = cvtpk(x0 * r * dk4[0], x1 * r * dk4[1]); w.y = cvtpk(x2 * r * dk4[2], x3 * r * dk4[3]);
                  *(u32x2*)(pr + OFF_DK + (ps * 4 + hh) * 64 + 4 * l16) = w; } } }
    }
}

DEV void phase_router(const Args& a, int l, LAS char* lds, int wv, const XcdBarrier pend, const bool do_wait) {
    const int wid = __builtin_amdgcn_readfirstlane(otid(wv) >> 6), lane = otid(wv) & 63, tid = otid(wv);
    const float* RS = (l == 0) ? a.x : (const float*)a.out; const bf16_t* DLT = WSP(bf16_t, WS_XB); bf16_t* HN = WSP(bf16_t, WS_XN); int* EID = WSP(int, WS_EID); float* WGT = WSP(float, WS_WGT);
    const float* gain = a.norm_ffn + (size_t)l * DM; const f32x4* WR3 = WSP(f32x4, WS_WR3); const float* bg = a.bg + l * 4; const float* be = a.be + l * 16;
    LAS f32x4* WL = (LAS f32x4*)lds;
    const __amdgpu_buffer_rsrc_t rsW = __builtin_amdgcn_make_buffer_rsrc((void*)WR3, (short)0, 10240 * 16, 0x00020000);
    const int ntrip = (S_ / 32 + (int)gridDim.x - 1) / (int)gridDim.x;
    for (int trip = 0; trip < ntrip; ++trip) { const int row0 = ((blockIdx.x + trip * gridDim.x) * 8 + wid) * 4; const bool live = row0 < S_;
        if (trip > 0) __syncthreads();
#pragma unroll
        for (int b = 0; b < 2; ++b) { f32x4 wst[9];
#pragma unroll
            for (int m = 0; m < 9; ++m) wst[m] = __builtin_bit_cast(f32x4, __builtin_amdgcn_raw_buffer_load_b128(rsW, tid * 16, 512 * 16 * (b * 9 + m), 0));
#pragma unroll
            for (int m = 0; m < 9; ++m) { const int idx = tid + 512 * (b * 9 + m); if (idx < 8960) WL[idx] = wst[m]; }
            SBAR(); }
        if (do_wait && trip == 0) xcd_barrier_wait(pend);
        float ss[4] = {0.f, 0.f, 0.f, 0.f};
        float lg[4][20];
#pragma unroll
        for (int rr = 0; rr < 4; ++rr)
#pragma unroll
            for (int j = 0; j < 20; ++j) lg[rr][j] = 0.f;
        __syncthreads();
#pragma unroll 1
        for (int i = 0; i < 8; ++i) { const int e0 = (i * 64 + lane) * 4;
            if (i == 1) { __syncthreads(); f32x4 wl7[3];
#pragma unroll
                for (int m = 0; m < 3; ++m) wl7[m] = __builtin_bit_cast(f32x4, __builtin_amdgcn_raw_buffer_load_b128(rsW, tid * 16, (8960 + 512 * m) * 16, 0));
#pragma unroll
                for (int m = 0; m < 3; ++m) { const int idx = tid + 512 * m; if (idx < 1280) WL[idx] = wl7[m]; } }
            if (i == 7) __syncthreads();
            if (live) {
            const f32x4 g = *(const f32x4*)(gain + e0);
            float hn[4][4];
#pragma unroll
            for (int rr = 0; rr < 4; ++rr) { const f32x4 v = ld_h4nt(RS, DLT, (size_t)(row0 + rr) * DM + e0);
                ss[rr] += (v[0] * v[0] + v[1] * v[1]) + (v[2] * v[2] + v[3] * v[3]);
#pragma unroll
                for (int c = 0; c < 4; ++c) hn[rr][c] = v[c] * g[c];
                u32x2 o; o.x = cvtpk(hn[rr][0], hn[rr][1]); o.y = cvtpk(hn[rr][2], hn[rr][3]); *(u32x2*)(HN + (size_t)(row0 + rr) * DM + e0) = o; }
#pragma unroll
            for (int c = 0; c < 4; ++c) { const f32x4 w4 = WL[((i % 7) * 20 + c * 5) * 64 + lane];
#pragma unroll
                for (int rr = 0; rr < 4; ++rr)
#pragma unroll
                    for (int j = 0; j < 4; ++j) lg[rr][j] += hn[rr][c] * w4[j];
#pragma unroll
                for (int q = 0; q < 4; ++q) { const f32x4 w16 = WL[((i % 7) * 20 + c * 5 + 1 + q) * 64 + lane];
#pragma unroll
                    for (int rr = 0; rr < 4; ++rr)
#pragma unroll
                        for (int j = 0; j < 4; ++j) lg[rr][4 + q * 4 + j] += hn[rr][c] * w16[j]; } } } }
        float rstd[4];
#pragma unroll
        for (int rr = 0; rr < 4; ++rr) rstd[rr] = rsqrtf(wave_sum(ss[rr]) * (1.f / DM) + EPS);
#pragma unroll
        for (int rr = 0; rr < 4; ++rr)
#pragma unroll
            for (int j = 0; j < 20; ++j) lg[rr][j] = wave_sum(lg[rr][j]) * rstd[rr];
        if (live && lane < 4) WSP(float, WS_RSTD)[row0 + lane] = lane == 0 ? rstd[0] : (lane == 1 ? rstd[1] : (lane == 2 ? rstd[2] : rstd[3]));
        if (live && lane < 4) {
            float lgs[20];
#pragma unroll
            for (int j = 0; j < 20; ++j) lgs[j] = lane == 0 ? lg[0][j] : (lane == 1 ? lg[1][j] : (lane == 2 ? lg[2][j] : lg[3][j]));
            const int row = row0 + lane;
            float gl[4]; int grp = 0; float gmax;
#pragma unroll
            for (int j = 0; j < 4; ++j) gl[j] = lgs[j] + bg[j];
            gmax = gl[0];
#pragma unroll
            for (int j = 1; j < 4; ++j) if (gl[j] > gmax) { gmax = gl[j]; grp = j; }
            float den = 0.f;
#pragma unroll
            for (int j = 0; j < 4; ++j) den += expf(gl[j] - gmax);
            const float pgrp = 1.f / den;
            float el[4];
#pragma unroll
            for (int j = 0; j < 4; ++j) { float sv = 0.f;
#pragma unroll
                for (int q = 0; q < 4; ++q) sv = (grp == q) ? (lgs[4 + q * 4 + j] + be[q * 4 + j]) : sv;
                el[j] = sv; }
            int i0 = 0; float v0 = el[0];
#pragma unroll
            for (int j = 1; j < 4; ++j) if (el[j] > v0) { v0 = el[j]; i0 = j; }
            int i1 = -1; float v1 = 0.f;
#pragma unroll
            for (int j = 0; j < 4; ++j) if (j != i0 && (i1 < 0 || el[j] > v1)) { v1 = el[j]; i1 = j; }
            const float e1 = expf(v1 - v0), inv = 1.f / (1.f + e1);
            EID[row * 2] = grp * 4 + i0; EID[row * 2 + 1] = grp * 4 + i1; WGT[row * 2] = inv * pgrp; WGT[row * 2 + 1] = e1 * inv * pgrp;
        }
    }
}

DEV void phase_lists(const Args& a, LAS char* lds, int wv) {
    if (blockIdx.x >= 16) return;
    const int e = blockIdx.x, tid = otid(wv), lane = tid & 63, wid = tid >> 6;
    LAS int* cnt = (LAS int*)lds; LAS int* ts = cnt + 16; LAS int* wtot = ts + 32;
    const int* EID = WSP(int, WS_EID); const float* WGT = WSP(float, WS_WGT); int* SLOTOF = WSP(int, WS_SLOTOF); int* PERM = WSP(int, WS_PERM); float* SLOTW = WSP(float, WS_SLOTW); int* TST = WSP(int, WS_TSTART); float* SLOTR = WSP(float, WS_SLOTR); const float* RSTD = WSP(float, WS_RSTD);
    if (tid < 16) cnt[tid] = 0;
    __syncthreads();
    int mine = 0;
    for (int i = 0; i < 16; ++i) { const int t = tid * 16 + i; const int e0 = EID[t * 2], e1 = EID[t * 2 + 1];
        __hip_atomic_fetch_add(&cnt[e0], 1, __ATOMIC_RELAXED, __HIP_MEMORY_SCOPE_WORKGROUP); __hip_atomic_fetch_add(&cnt[e1], 1, __ATOMIC_RELAXED, __HIP_MEMORY_SCOPE_WORKGROUP);
        mine += (e0 == e || e1 == e) ? 1 : 0; }
    int incl = mine;
#pragma unroll
    for (int o = 1; o < 64; o <<= 1) { const int y = __shfl_up(incl, o); if (lane >= o) incl += y; }
    if (lane == 63) wtot[wid] = incl;
    __syncthreads();
    if (tid == 0) { int acc = 0; for (int j = 0; j < 16; ++j) { ts[j] = acc; acc += (cnt[j] + 255) / 256; } ts[16] = acc;
        if (e == 0) { for (int j = 0; j <= 16; ++j) TST[j] = ts[j];
            int* TL = WSP(int, WS_TILES); int n = 0;
            for (int pass = 0; pass < 2; ++pass)
                for (int j = 0; j < 16; ++j) { const int nt = ts[j + 1] - ts[j];
                    for (int t = 0; t < nt; ++t) { const int p = ts[j] + t, rows = cnt[j] - 256 * t, hf = (rows <= 128) ? 1 : 0;
                        if (pass == 0) { TL[96 + p] = j; TL[192 + p] = hf; } if (hf == pass) TL[n++] = p | (j << 8) | (hf << 16); } } } }
    __syncthreads();
    int base = incl - mine; for (int w = 0; w < wid; ++w) base += wtot[w];
    const int start = ts[e] * 256, n_e = cnt[e], end = ts[e + 1] * 256;
    int slot = start + base;
    for (int i = 0; i < 16; ++i) { const int t = tid * 16 + i; const int e0 = EID[t * 2], e1 = EID[t * 2 + 1];
        if (e0 == e) { PERM[slot] = t; SLOTW[slot] = WGT[t * 2]; SLOTR[slot] = RSTD[t]; SLOTOF[t * 2] = slot; ++slot; }
        else if (e1 == e) { PERM[slot] = t; SLOTW[slot] = WGT[t * 2 + 1]; SLOTR[slot] = RSTD[t]; SLOTOF[t * 2 + 1] = slot; ++slot; } }
    for (int s = start + n_e + tid; s < end; s += 512) { PERM[s] = 0; SLOTW[s] = 0.f; SLOTR[s] = 0.f; }
}
DEV void phase_gather(const Args& a, int wv) {
    const int wid = __builtin_amdgcn_readfirstlane(otid(wv) >> 6), lane = otid(wv) & 63;
    const int* PERM = WSP(int, WS_PERM); const bf16_t* HN = WSP(bf16_t, WS_XN); bf16_t* AP = WSP(bf16_t, B_APERM);
    const int rows = ld_agent_i(WSP(int, WS_TSTART) + 16) * 256;
    for (int r = blockIdx.x * 8 + wid; r < rows; r += gridDim.x * 8) { const int t = PERM[r];
        const u32x4* s = (const u32x4*)(HN + (size_t)t * DM); u32x4* d = (u32x4*)(AP + (size_t)r * DM);
#pragma unroll
        for (int i = 0; i < 4; ++i) d[lane + 64 * i] = s[lane + 64 * i]; }
}

DEV int v_st2(int k, int c) { const int kk = (k & ~0xC) | ((k & 4) << 1) | ((k & 8) >> 1); return ((kk >> 3) * 2 + (c >> 5)) * 512 + ((kk & 7) * 32 + (c & 31)) * 2; }
DEV int v_rd_base(int lane) { return ((lane & 3) << 3) | (((lane >> 2) & 3) << 6) | (((lane >> 4) & 1) << 5) | (((lane >> 5) & 1) << 8); }
template <int OFF> DEV s16x4 tr_read(int vb) { s16x4 r; asm volatile("ds_read_b64_tr_b16 %0, %1 offset:%2" : "=&v"(r) : "v"(vb), "i"(OFF) : "memory"); return r; }
template <int OFF> DEV s16x4 tr_rd(const LAS char* b) { return __builtin_amdgcn_ds_read_tr16_b64_v4i16((LAS s16x4*)(b + OFF)); }
#define PKV(L, H) (bf16x8){L[0], L[1], L[2], L[3], H[0], H[1], H[2], H[3]}

namespace mla {
constexpr int LDQ = 768, LDK = 768, LDV = 1792, LDO = 2048, KVBLK = 64, QBLK = 32;
constexpr float SCALE = 0.10206207261596575f, THR = 8.f;
constexpr int SHM_V = 8192, SHM_K = 16384;
#define KSWZ(row, colB) ((row) * 256 + ((colB) ^ (((row) & 15) << 4)))
template <bool NOMAX, int PRB = 0, bool EXPDONE = false> DEV void partialSM(f32x16& p0, f32x16& p1, float& m_reg, float& mn, float& alpha) {
  if constexpr (NOMAX) {
    mn = 0.f; alpha = 1.f;
    if constexpr (PRB != 2 && !EXPDONE) {
#pragma unroll
    for (int r = 0; r < 16; ++r) p0[r] = __builtin_amdgcn_exp2f(p0[r]); }
    return;
  }
  float pmax = p0[0];
#pragma unroll
  for (int r = 1; r < 16; ++r) pmax = fmaxf(pmax, p0[r]);
#pragma unroll
  for (int r = 0; r < 16; ++r) pmax = fmaxf(pmax, p1[r]);
  { auto rr = __builtin_amdgcn_permlane32_swap(__float_as_uint(pmax), __float_as_uint(pmax), false, false);
    pmax = fmaxf(__uint_as_float(rr[0]), __uint_as_float(rr[1])); }
  if (__builtin_expect(__all(pmax - m_reg <= THR * LOG2E), 1)) { mn = m_reg; alpha = 1.f; }
  else { mn = fmaxf(m_reg, pmax); alpha = __builtin_amdgcn_exp2f(m_reg - mn); m_reg = mn; }
#pragma unroll
  for (int r = 0; r < 16; ++r) p0[r] = p0[r] - mn;
#pragma unroll
  for (int r = 0; r < 16; ++r) p1[r] = p1[r] - mn;
#pragma unroll
  for (int r = 0; r < 16; ++r) p0[r] = __builtin_amdgcn_exp2f(p0[r]);
}
DEV void finishSM(f32x16& p0, f32x16& p1, float alpha, float& l_reg, bf16x8& pa0, bf16x8& pa1, bf16x8& pa2, bf16x8& pa3) {
#pragma unroll
  for (int r = 0; r < 16; ++r) p1[r] = __builtin_amdgcn_exp2f(p1[r]);
  f32x2 ps2 = {0.f, 0.f};
#pragma unroll
  for (int r = 0; r < 16; r += 2) ps2 += mk2(p0[r], p0[r + 1]);
#pragma unroll
  for (int r = 0; r < 16; r += 2) ps2 += mk2(p1[r], p1[r + 1]);
  float ps = ps2[0] + ps2[1];
  { auto rr = __builtin_amdgcn_permlane32_swap(__float_as_uint(ps), __float_as_uint(ps), false, false);
    ps = __uint_as_float(rr[0]) + __uint_as_float(rr[1]); }
  l_reg = l_reg * alpha + ps;
  PK4(p0, 0, pa0); PK4(p0, 8, pa1); PK4(p1, 0, pa2); PK4(p1, 8, pa3);
}
DEV void qkt(f32x16& p0, f32x16& p1, const LAS char* Ks, const bf16x8* qr, int r32, int hi) {
  p0 = f32x16{}; p1 = f32x16{};
  bf16x8 b0 = *(const LAS bf16x8*)(Ks + KSWZ(r32, hi * 16)), b1 = *(const LAS bf16x8*)(Ks + KSWZ(32 + r32, hi * 16));
#pragma unroll
  for (int d0 = 0; d0 < 6; ++d0) {
    bf16x8 n0 = b0, n1 = b1;
    if (d0 + 1 < 6) { const int cb = ((d0 + 1) * 16 + hi * 8) * 2; n0 = *(const LAS bf16x8*)(Ks + KSWZ(r32, cb)); n1 = *(const LAS bf16x8*)(Ks + KSWZ(32 + r32, cb)); }
    SBAR();
    p0 = MFMA32(b0, qr[d0], p0); p1 = MFMA32(b1, qr[d0], p1);
    SBAR();
    b0 = n0; b1 = n1; }
}
template <int PRB = 0> DEV void qkt_fin(f32x16& n0, f32x16& n1, const LAS char* Ks, const bf16x8* qr, int r32, int hi, bf16x8 b0, bf16x8 b1,
                 f32x16& p0, f32x16& p1, float alpha, float& l_reg, bf16x8& pa0, bf16x8& pa1, bf16x8& pa2, bf16x8& pa3) {
  n0 = f32x16{}; n1 = f32x16{};
  bf16x8 c0, c1;
  f32x2 ps2; float ps;
#define QF_STEP(D0, CUR0, CUR1, NXT0, NXT1, WORK) do { \
    if ((D0) + 1 < 6) { const int cb_ = (((D0) + 1) * 16 + hi * 8) * 2; NXT0 = *(const LAS bf16x8*)(Ks + KSWZ(r32, cb_)); NXT1 = *(const LAS bf16x8*)(Ks + KSWZ(32 + r32, cb_)); } \
    SBAR(); if constexpr (PRB != 5) { n0 = MFMA32(CUR0, qr[D0], n0); n1 = MFMA32(CUR1, qr[D0], n1); } else { asm volatile("" :: "v"(CUR0), "v"(CUR1)); } WORK; SBAR(); } while (0)
  QF_STEP(0, b0, b1, c0, c1, { _Pragma("unroll") for (int r = 0; r < 6; ++r) p1[r] = (PRB == 2) ? p1[r] : __builtin_amdgcn_exp2f(p1[r]); });
  QF_STEP(1, c0, c1, b0, b1, { _Pragma("unroll") for (int r = 6; r < 12; ++r) p1[r] = (PRB == 2) ? p1[r] : __builtin_amdgcn_exp2f(p1[r]); });
  QF_STEP(2, b0, b1, c0, c1, { _Pragma("unroll") for (int r = 12; r < 16; ++r) p1[r] = (PRB == 2) ? p1[r] : __builtin_amdgcn_exp2f(p1[r]); ps2 = mk2(p0[0], p0[1]); _Pragma("unroll") for (int r = 2; r < 8; r += 2) ps2 += mk2(p0[r], p0[r + 1]); });
  QF_STEP(3, c0, c1, b0, b1, { _Pragma("unroll") for (int r = 8; r < 16; r += 2) ps2 += mk2(p0[r], p0[r + 1]); _Pragma("unroll") for (int r = 0; r < 8; r += 2) ps2 += mk2(p1[r], p1[r + 1]); });
  QF_STEP(4, b0, b1, c0, c1, { _Pragma("unroll") for (int r = 8; r < 16; r += 2) ps2 += mk2(p1[r], p1[r + 1]); ps = ps2[0] + ps2[1];
      { auto rr = __builtin_amdgcn_permlane32_swap(__float_as_uint(ps), __float_as_uint(ps), false, false); ps = __uint_as_float(rr[0]) + __uint_as_float(rr[1]); }
      l_reg = l_reg * alpha + ps; PK4(p0, 0, pa0); PK4(p0, 8, pa1); });
  QF_STEP(5, c0, c1, b0, b1, { PK4(p1, 0, pa2); PK4(p1, 8, pa3); });
#undef QF_STEP
}
constexpr int v_rd_off(int d0, int ks, int half) { return d0 * 512 + ks * 2048 + half * 1024; }
template <int D0, int BO = 0, int PRB = 0> DEV void pv_one(f32x16& od, int vb, bf16x8 pa0, bf16x8 pa1, bf16x8 pa2, bf16x8 pa3) {
  const s16x4 l0 = tr_read<BO + v_rd_off(D0, 0, 0)>(vb), h0 = tr_read<BO + v_rd_off(D0, 0, 1)>(vb), l1 = tr_read<BO + v_rd_off(D0, 1, 0)>(vb), h1 = tr_read<BO + v_rd_off(D0, 1, 1)>(vb);
  const s16x4 l2 = tr_read<BO + v_rd_off(D0, 2, 0)>(vb), h2 = tr_read<BO + v_rd_off(D0, 2, 1)>(vb), l3 = tr_read<BO + v_rd_off(D0, 3, 0)>(vb), h3 = tr_read<BO + v_rd_off(D0, 3, 1)>(vb);
  asm volatile("s_waitcnt lgkmcnt(0)" ::: "memory"); SBAR();
  if constexpr (PRB != 5) { od = MFMA32(pa0, PKV(l0, h0), od); od = MFMA32(pa1, PKV(l1, h1), od); od = MFMA32(pa2, PKV(l2, h2), od); od = MFMA32(pa3, PKV(l3, h3), od); }
  else asm volatile("" :: "v"(l0), "v"(h0), "v"(l1), "v"(h1), "v"(l2), "v"(h2), "v"(l3), "v"(h3), "v"(pa0), "v"(pa1), "v"(pa2), "v"(pa3));
}
#define KFR(Ks_, D_, A_, B_) do { const int cb_ = ((D_) * 16 + hi * 8) * 2; A_ = *(const LAS bf16x8*)((Ks_) + KSWZ(r32, cb_)); B_ = *(const LAS bf16x8*)((Ks_) + KSWZ(32 + r32, cb_)); } while (0)
#define VRD8(VF, D0, BO) do { VF[0] = tr_rd<(BO) + v_rd_off(D0, 0, 0)>(vbp); VF[1] = tr_rd<(BO) + v_rd_off(D0, 0, 1)>(vbp); VF[2] = tr_rd<(BO) + v_rd_off(D0, 1, 0)>(vbp); VF[3] = tr_rd<(BO) + v_rd_off(D0, 1, 1)>(vbp); \
    VF[4] = tr_rd<(BO) + v_rd_off(D0, 2, 0)>(vbp); VF[5] = tr_rd<(BO) + v_rd_off(D0, 2, 1)>(vbp); VF[6] = tr_rd<(BO) + v_rd_off(D0, 3, 0)>(vbp); VF[7] = tr_rd<(BO) + v_rd_off(D0, 3, 1)>(vbp); } while (0)
template <int PRB, int VBO> DEV void qkt_fin2(f32x16& n0, f32x16& n1, const LAS char* Ks, const bf16x8* qr, int r32, int hi, bf16x8 f0a, bf16x8 f0b, bf16x8 f1a, bf16x8 f1b, const LAS char* vbp, s16x4* vf0,
                 f32x16& p0, f32x16& p1, float alpha, float& l_reg, bf16x8& pa0, bf16x8& pa1, bf16x8& pa2, bf16x8& pa3) {
  n0 = f32x16{}; n1 = f32x16{};
  bf16x8 ga = f0a, gb = f0b; f32x2 ps2; float ps;
#define QF2(D0, CA, CB, NA, NB, PRE, WA, WB) do { if constexpr (PRB < 7) { if ((D0) + 2 < 6) KFR(Ks, (D0) + 2, NA, NB); PRE; } else { asm volatile("" : "+v"(NA), "+v"(NB)); } \
    SBAR(); if constexpr (PRB != 5) n0 = MFMA32(CA, qr[D0], n0); else asm volatile("" :: "v"(CA)); WA; SBAR(); \
    if constexpr (PRB != 5) n1 = MFMA32(CB, qr[D0], n1); else asm volatile("" :: "v"(CB)); WB; SBAR(); } while (0)
#define EX_(r) p1[r] = (PRB == 2 || PRB == 8) ? p1[r] : __builtin_amdgcn_exp2f(p1[r])
  QF2(0, f0a, f0b, ga, gb, {}, { EX_(0); EX_(1); EX_(2); }, { EX_(3); EX_(4); EX_(5); });
  QF2(1, f1a, f1b, f0a, f0b, { VRD8(vf0, 0, VBO); }, { EX_(6); EX_(7); EX_(8); }, { EX_(9); EX_(10); EX_(11); });
  QF2(2, ga, gb, f1a, f1b, {}, { EX_(12); EX_(13); EX_(14); EX_(15); }, { ps2 = mk2(p0[0], p0[1]); _Pragma("unroll") for (int r = 2; r < 8; r += 2) ps2 += mk2(p0[r], p0[r + 1]); });
  QF2(3, f0a, f0b, ga, gb, {}, { _Pragma("unroll") for (int r = 8; r < 16; r += 2) ps2 += mk2(p0[r], p0[r + 1]); }, { _Pragma("unroll") for (int r = 0; r < 8; r += 2) ps2 += mk2(p1[r], p1[r + 1]); });
  QF2(4, f1a, f1b, f0a, f0b, {}, { _Pragma("unroll") for (int r = 8; r < 16; r += 2) ps2 += mk2(p1[r], p1[r + 1]); ps = ps2[0] + ps2[1];
      { auto rr = __builtin_amdgcn_permlane32_swap(__float_as_uint(ps), __float_as_uint(ps), false, false); ps = __uint_as_float(rr[0]) + __uint_as_float(rr[1]); }
      l_reg = l_reg * alpha + ps; }, { PK4(p0, 0, pa0); PK4(p0, 8, pa1); });
  QF2(5, ga, gb, f0a, f0b, {}, { PK4(p1, 0, pa2); }, { PK4(p1, 8, pa3); });
#undef QF2
#undef EX_
}
template <bool NOMAX, int PRB, int VBO> DEV void pv2(f32x16& o0, f32x16& o1, const LAS char* vbp, const s16x4* vf0, bf16x8 pa0, bf16x8 pa1, bf16x8 pa2, bf16x8 pa3, f32x16& pn0) {
  s16x4 vf1[8]; if constexpr (PRB < 7) { VRD8(vf1, 1, VBO); } else { _Pragma("unroll") for (int i = 0; i < 8; ++i) { vf1[i] = vf0[i]; asm volatile("" : "+v"(vf1[i])); } }
#define EX2(r) do { if constexpr (NOMAX && PRB != 2 && PRB != 8) { pn0[r] = __builtin_amdgcn_exp2f(pn0[r]); pn0[(r) + 1] = __builtin_amdgcn_exp2f(pn0[(r) + 1]); } } while (0)
#define PVM(OD, PA, L, H, R) do { SBAR(); if constexpr (PRB != 5) OD = MFMA32(PA, PKV(L, H), OD); else asm volatile("" :: "v"(L), "v"(H), "v"(PA)); EX2(R); SBAR(); } while (0)
  PVM(o0, pa0, vf0[0], vf0[1], 0); PVM(o0, pa1, vf0[2], vf0[3], 2); PVM(o0, pa2, vf0[4], vf0[5], 4); PVM(o0, pa3, vf0[6], vf0[7], 6);
  PVM(o1, pa0, vf1[0], vf1[1], 8); PVM(o1, pa1, vf1[2], vf1[3], 10); PVM(o1, pa2, vf1[4], vf1[5], 12); PVM(o1, pa3, vf1[6], vf1[7], 14);
#undef PVM
#undef EX2
}
template <bool NOMAX, int PRB = 0> DEV void attn_unit(const bf16_t* __restrict__ Qb, const bf16_t* __restrict__ Kh, const bf16_t* __restrict__ Vh, bf16_t* __restrict__ Ob, int seq, LAS char* lds, int wv) {
  const int tid = otid(wv), wid = tid >> 6, lane = tid & 63, r32 = lane & 31, hi = lane >> 5;
  LAS char* K_lds = lds; LAS char* V_lds = lds + 4 * SHM_K;
  LAS float* ws = (LAS float*)(lds + 4 * SHM_V + 4 * SHM_K) + wid * 64; LAS float* li_l = ws; LAS float* al_l = ws + 32;
  float m_reg = -1e30f, l_reg = 0; f32x16 o[2] = {}; bf16x8 qr[6];
  const bf16_t* Qw = Qb + (long)(wid * QBLK + r32) * LDQ + hi * 8;
#pragma unroll
  for (int d0 = 0; d0 < 6; ++d0) qr[d0] = *reinterpret_cast<const bf16x8*>(Qw + d0 * 16);
  const int vrow = tid >> 3, vc8 = (tid & 7) * 8, kc1 = tid, kc2 = 512 + (tid & 255);
  const int kr1 = kc1 / 12, kch1 = kc1 % 12, kr2 = kc2 / 12, kch2 = kc2 % 12;
  const int vst = v_st2(vrow, vc8), kst1 = KSWZ(kr1, kch1 * 16), kst2 = KSWZ(kr2, kch2 * 16);
  const bf16_t* vsrc = Vh + (long)vrow * LDV + vc8; const bf16_t* ksrc1 = Kh + (long)kr1 * LDK + kch1 * 8; const bf16_t* ksrc2 = Kh + (long)kr2 * LDK + kch2 * 8;
  const int vb0 = (int)(unsigned)(uintptr_t)V_lds + v_rd_base(lane);
  struct { bf16x8 vs, k1, k2; } sr_[3];
  const __amdgpu_buffer_rsrc_t rsK = __builtin_amdgcn_make_buffer_rsrc((void*)Kh, (short)0, 0x40000000, 0x00020000), rsV = __builtin_amdgcn_make_buffer_rsrc((void*)Vh, (short)0, 0x40000000, 0x00020000);
  const int vgo = (vrow * LDV + vc8) * 2, kgo1 = (kr1 * LDK + kch1 * 8) * 2, kgo2 = (kr2 * LDK + kch2 * 8) * 2;
#define SLOAD(i, t_) do { sr_[i].vs = __builtin_bit_cast(bf16x8, __builtin_amdgcn_raw_buffer_load_b128(rsV, vgo, (t_) * (KVBLK * LDV * 2), 0)); \
    sr_[i].k1 = __builtin_bit_cast(bf16x8, __builtin_amdgcn_raw_buffer_load_b128(rsK, kgo1, (t_) * (KVBLK * LDK * 2), 0)); sr_[i].k2 = __builtin_bit_cast(bf16x8, __builtin_amdgcn_raw_buffer_load_b128(rsK, kgo2, (t_) * (KVBLK * LDK * 2), 0)); } while (0)
#define SWRITE(b, i) do { *(LAS bf16x8*)(V_lds + (b) * SHM_V + vst) = sr_[i].vs; *(LAS bf16x8*)(K_lds + (b) * SHM_K + kst1) = sr_[i].k1; *(LAS bf16x8*)(K_lds + (b) * SHM_K + kst2) = sr_[i].k2; } while (0)
#define SWAIT() asm volatile("s_waitcnt vmcnt(3)" ::: "memory")
#define RESC(a_) do { if (!NOMAX && __any((a_) < 1.f)) { if (hi == 0) al_l[r32] = (a_); asm volatile("s_waitcnt lgkmcnt(0)" ::: "memory"); \
    _Pragma("unroll") for (int d = 0; d < 2; ++d) _Pragma("unroll") for (int r = 0; r < 16; ++r) o[d][r] *= al_l[crow(r, hi)]; } } while (0)
#define PVD(B_) do { pv_one<0, (B_) * SHM_V, PRB>(o[0], vb0, pa0, pa1, pa2, pa3); pv_one<1, (B_) * SHM_V, PRB>(o[1], vb0, pa0, pa1, pa2, pa3); } while (0)
  f32x16 pA0, pA1, pB0, pB1; float mnA, mnB, alA, alB; bf16x8 pa0, pa1, pa2, pa3; constexpr int NT = S_ / KVBLK;
  constexpr int SE = 0, SO = 1;
  SLOAD(SE, 0); SLOAD(SO, 1); SLOAD(2, 2);
  asm volatile("s_waitcnt vmcnt(0)" ::: "memory"); SWRITE(0, SE); SWRITE(1, SO); SWRITE(2, 2);
  SLOAD(SO, 3);
  __syncthreads();
  qkt(pA0, pA1, K_lds, qr, r32, hi); partialSM<NOMAX>(pA0, pA1, m_reg, mnA, alA);
  const LAS char* vbp = V_lds + v_rd_base(lane);
#define KPRE(buf) do { KFR(K_lds + (buf) * SHM_K, 0, pre0, pre1); KFR(K_lds + (buf) * SHM_K, 1, pre2, pre3); } while (0)
  bf16x8 pre0, pre1, pre2, pre3; KPRE(1);
  s16x4 vf0[8];
#define HALF(T, BP, BC, B1, BW, PN0, PN1, PO0, PO1, MNN, ALN, ALO, SL, SW, DOLOAD, DOWRITE) do { \
    SBAR(); qkt_fin2<PRB, (BP) * SHM_V>(PN0, PN1, K_lds + (BC) * SHM_K, qr, r32, hi, pre0, pre1, pre2, pre3, vbp, vf0, PO0, PO1, ALO, l_reg, pa0, pa1, pa2, pa3); SBAR(); \
    if (DOLOAD && PRB != 4 && PRB < 7) SLOAD(SL, (T) + 3); SBAR(); \
    pv2<NOMAX, PRB, (BP) * SHM_V>(o[0], o[1], vbp, vf0, pa0, pa1, pa2, pa3, PN0); partialSM<NOMAX, PRB, true>(PN0, PN1, m_reg, MNN, ALN); \
    if constexpr (PRB < 7) { SWAIT(); if (DOWRITE && PRB != 4) SWRITE(BW, SW); KPRE(B1); } \
    RESC(ALN); if constexpr (PRB != 3 && PRB < 7) __syncthreads(); } while (0)
  static_assert(NT % 4 == 0 && NT >= 8, "tile loop is unrolled by four");
  for (int j = 1; j + 6 < NT; j += 4) {
    HALF(j,     0, 1, 2, 3, pB0, pB1, pA0, pA1, mnB, alB, alA, SE, SO, true, true);
    HALF(j + 1, 1, 2, 3, 0, pA0, pA1, pB0, pB1, mnA, alA, alB, SO, SE, true, true);
    HALF(j + 2, 2, 3, 0, 1, pB0, pB1, pA0, pA1, mnB, alB, alA, SE, SO, true, true);
    HALF(j + 3, 3, 0, 1, 2, pA0, pA1, pB0, pB1, mnA, alA, alB, SO, SE, true, true);
  }
  HALF(NT - 3, 0, 1, 2, 3, pB0, pB1, pA0, pA1, mnB, alB, alA, SE, SO, false, true);
  HALF(NT - 2, 1, 2, 3, 0, pA0, pA1, pB0, pB1, mnA, alA, alB, SO, SE, false, false);
  SBAR(); qkt(pB0, pB1, K_lds + 3 * SHM_K, qr, r32, hi);
  finishSM(pA0, pA1, alA, l_reg, pa0, pa1, pa2, pa3); SBAR();
  PVD(2); partialSM<NOMAX>(pB0, pB1, m_reg, mnB, alB);
  RESC(alB);
  finishSM(pB0, pB1, alB, l_reg, pa0, pa1, pa2, pa3); SBAR();
  PVD(3);
#undef HALF
#undef KPRE
  if constexpr (PRB != 0) { asm volatile("" :: "v"(o[0]), "v"(o[1]), "v"(l_reg)); __syncthreads(); return; }
  if (hi == 0) li_l[r32] = l_reg; asm volatile("s_waitcnt lgkmcnt(0)" ::: "memory");
  float rli[16];
#pragma unroll
  for (int r = 0; r < 16; ++r) rli[r] = __builtin_amdgcn_rcpf(li_l[crow(r, hi)]);
  bf16_t* Ow = Ob + (long)(wid * QBLK) * LDO;
#pragma unroll
  for (int r = 0; r < 16; ++r) { const int orow = crow(r, hi);
#pragma unroll
    for (int d0 = 0; d0 < 2; ++d0) Ow[(long)orow * LDO + d0 * 32 + r32] = f2bf(o[d0][r] * rli[r]); }
  __syncthreads();
#undef SLOAD
#undef SWRITE
#undef SWAIT
#undef RESC
#undef PVD
}
DEV bool bound_ok(const float* gq, const float* gk, int lane) {
  float bq = fmaxf(fabsf(gq[lane]), lane < 32 ? fabsf(gq[64 + lane]) : 0.f), bk = fmaxf(fabsf(gk[lane]), lane < 32 ? fabsf(gk[64 + lane]) : 0.f);
#pragma unroll
  for (int o = 1; o < 64; o <<= 1) { bq = fmaxf(bq, __shfl_xor(bq, o)); bk = fmaxf(bk, __shfl_xor(bk, o)); }
  return 9.797958971f * bq * bk * 1.01f * LOG2E <= 64.f;
}
}

DEV int kswz128(int row, int cb) { return row * 128 + (cb ^ (((row >> 1) & 7) << 4)); }
struct DilU { int p, hd, res, B, d, nsub; };
DEV DilU dil_decode(int u) { DilU x; x.p = u / 384; const int v = u % 384, w = v % 32; x.hd = v / 32; const int nb = (x.p == 0) ? 32 : (x.p == 1 ? 8 : 2);
  x.res = w / nb; x.B = w % nb; x.d = (x.p == 0) ? 1 : (x.p == 1 ? 4 : 16); x.nsub = S_ / x.d; return x; }
DEV void dil_load(const bf16_t* PROJ, const DilU& x, int tid, u32x4 (&st)[12]) {
  const int r0 = tid >> 4, ch = tid & 15, j0 = 256 * x.B - 64 + r0;
  const int col = (ch < 8) ? (OFF_DK + x.hd * 64 + ch * 8) : (OFF_DV + x.hd * 64 + (ch - 8) * 8);
  const bf16_t* gp = PROJ + ((long)x.res + (long)x.d * j0) * CINP + col; const long gs = (long)32 * x.d * CINP;
#pragma unroll
  for (int i = 0; i < 12; ++i) { const int jj = j0 + 32 * i; u32x4 v = zero4(); if (jj >= 0 && jj < x.nsub) v = *(const u32x4*)(gp + i * gs); st[i] = v; }
}
DEV void dil_loadq(const bf16_t* PROJ, const DilU& x, int wid, int r32, int hi, bf16x8 (&qr)[4]) {
  const long tokq = (long)x.res + (long)x.d * (256 * x.B + 32 * wid + r32);
#pragma unroll
  for (int d0 = 0; d0 < 4; ++d0) qr[d0] = *reinterpret_cast<const bf16x8*>(PROJ + tokq * CINP + OFF_DQ + x.hd * 64 + d0 * 16 + hi * 8);
}
DEV void phase_dilated(const Args& a, LAS char* lds, int wv) {
  const int tid = otid(wv), wid = tid >> 6, lane = tid & 63, r32 = lane & 31, hi = lane >> 5; const int G = gridDim.x;
  const bf16_t* PROJ = WSP(bf16_t, A_PROJ);
  LAS char* KI = lds; LAS char* VI = lds + 49152; LAS float* wsf = (LAS float*)(lds + 98304) + wid * 64; LAS float* biasall = (LAS float*)(lds + 98304 + 2048); LAS float* bshift = (LAS float*)(lds + 98304 + 2048 + 19008);
  for (int i = tid; i < 36 * 129; i += 512) { const int ph = i / 129, k = i % 129; biasall[ph * 132 + k] = a.rel_bias[(int)c_bucket[ph / 12][k] * 12 + (ph % 12)] * LOG2E; }
  int u = blockIdx.x; if (u >= 1152) return;
  u32x4 st[12];
  { const DilU x0 = dil_decode(u); dil_load(PROJ, x0, tid, st); }
  for (; u < 1152; u += G) {
    const DilU x = dil_decode(u); const int p = x.p, hd = x.hd, res = x.res, B = x.B, d = x.d, nsub = x.nsub;
    bf16_t* DPART = WSP(bf16_t, A_DPART) + (size_t)p * S_ * 768; float* DLSE = WSP(float, A_DLSE) + (size_t)p * S_ * 12;
    bf16x8 qr[4]; dil_loadq(PROJ, x, wid, r32, hi, qr);
    { const LAS float* bsrc = biasall + (p * 12 + hd) * 132;
      for (int i = tid; i < 800; i += 512) { const int sh = i / 200, j = i % 200, k = j + sh - 32; bshift[i] = ((unsigned)k <= 128u) ? bsrc[k] : 0.f; } }
    { const int r0 = tid >> 4, ch = tid & 15;
      LAS char* lb = (ch < 8) ? (KI + kswz128(r0, ch * 16)) : (VI + v_st2(r0, (ch - 8) * 8));
#pragma unroll
      for (int i = 0; i < 12; ++i) *(LAS u32x4*)(lb + i * 4096) = st[i]; }
    asm volatile("s_waitcnt lgkmcnt(0)\n\ts_barrier" ::: "memory");
    asm volatile("" : "+v"(qr[0]), "+v"(qr[1]), "+v"(qr[2]), "+v"(qr[3]));
    if (u + G < 1152) { const DilU xn = dil_decode(u + G); dil_load(PROJ, xn, tid, st); }
    const int j0 = 256 * B - 64;
    constexpr float C = 0.125f * LOG2E;
    float m, l; f32x16 o[2];
    const int vbase = (int)(unsigned)(uintptr_t)VI + v_rd_base(lane) + 2 * wid * 2048;
    for (int rp_ = 0; rp_ < ((DUP_K == 30) ? 2 : 1); ++rp_) {
    f32x16 sc[5]; bf16x8 kfa[4], kfb[4]; float mx = -INFINITY;
#define DIL_KRD(dst, kb_) do { _Pragma("unroll") for (int d0 = 0; d0 < 4; ++d0) dst[d0] = *(const LAS bf16x8*)(KI + kswz128(32 * wid + 32 * (kb_) + r32, (d0 * 16 + hi * 8) * 2)); } while (0)
#define DIL_QK(src, kb_) do { sc[kb_] = f32x16{}; _Pragma("unroll") for (int d0 = 0; d0 < 4; ++d0) sc[kb_] = MFMA32(src[d0], qr[d0], sc[kb_]); } while (0)
#define DIL_TR(kb_) do { _Pragma("unroll") for (int g = 0; g < 4; ++g) { const f32x4 bq_ = *(const LAS f32x4*)(bbase_ + (32 * (kb_) + 8 * g) * 4); \
      _Pragma("unroll") for (int e = 0; e < 4; ++e) { const int i = 4 * g + e; const bool valid = (unsigned)(32 * (kb_) + 8 * g + e - lo_) <= (unsigned)w_;        \
        const float t_ = fmaf(sc[kb_][i], C, bq_[e]); sc[kb_][i] = valid ? t_ : -INFINITY; mx = fmaxf(mx, sc[kb_][i]); } } } while (0)
    int rq_ = r32 - 4 * hi, jq_ = j0 + 32 * wid + 4 * hi; asm volatile("" : "+v"(rq_), "+v"(jq_));
    const int lo_ = max(rq_, -jq_), w_ = min(rq_ + 128, nsub - 1 - jq_) - lo_;
    const int sh_ = (32 - rq_) & 3; const LAS char* bbase_ = (const LAS char*)bshift + sh_ * 800 + (32 - rq_ - sh_) * 4;
    DIL_KRD(kfa, 0); SBAR();
    DIL_KRD(kfb, 1); DIL_QK(kfa, 0); SBAR();
    DIL_KRD(kfa, 2); DIL_QK(kfb, 1); DIL_TR(0); SBAR();
    DIL_KRD(kfb, 3); DIL_QK(kfa, 2); DIL_TR(1); SBAR();
    DIL_KRD(kfa, 4); DIL_QK(kfb, 3); DIL_TR(2); SBAR();
    DIL_QK(kfa, 4); DIL_TR(3); SBAR();
    DIL_TR(4); SBAR();
#undef DIL_KRD
#undef DIL_QK
#undef DIL_TR
    mx = fmaxf(mx, __shfl_xor(mx, 32));
    float ps = 0.f;
#pragma unroll
    for (int kb = 0; kb < 5; ++kb)
#pragma unroll
      for (int i = 0; i < 16; ++i) { sc[kb][i] = __builtin_amdgcn_exp2f(sc[kb][i] - mx); ps += sc[kb][i]; }
    ps += __shfl_xor(ps, 32);
    m = mx; l = ps; o[0] = f32x16{}; o[1] = f32x16{};
    s16x4 va[8], vb8[8];
#define DIL_VRD(dst, kb_) do { const int vb_ = vbase + (kb_) * 4096; dst[0] = tr_read<0>(vb_); dst[1] = tr_read<1024>(vb_); dst[2] = tr_read<2048>(vb_); dst[3] = tr_read<3072>(vb_); \
      dst[4] = tr_read<512>(vb_); dst[5] = tr_read<1536>(vb_); dst[6] = tr_read<2560>(vb_); dst[7] = tr_read<3584>(vb_); } while (0)
#define DIL_PV(src, kb_) do { bf16x8 pa0_, pa1_; PK4(sc[kb_], 0, pa0_); PK4(sc[kb_], 8, pa1_); \
      o[0] = MFMA32(PKV(src[0], src[1]), pa0_, o[0]); o[0] = MFMA32(PKV(src[2], src[3]), pa1_, o[0]); o[1] = MFMA32(PKV(src[4], src[5]), pa0_, o[1]); o[1] = MFMA32(PKV(src[6], src[7]), pa1_, o[1]); } while (0)
#define DIL_WAIT() do { asm volatile("s_waitcnt lgkmcnt(0)" ::: "memory"); SBAR(); } while (0)
    DIL_VRD(va, 0); DIL_WAIT(); DIL_VRD(vb8, 1); DIL_PV(va, 0); DIL_WAIT(); DIL_VRD(va, 2); DIL_PV(vb8, 1); DIL_WAIT(); DIL_VRD(vb8, 3); DIL_PV(va, 2); DIL_WAIT(); DIL_VRD(va, 4); DIL_PV(vb8, 3); DIL_WAIT(); DIL_PV(va, 4);
#undef DIL_VRD
#undef DIL_PV
#undef DIL_WAIT
    }
    { const long tokq = (long)res + (long)d * (256 * B + 32 * wid + r32);
      DLSE[(size_t)hd * S_ + (size_t)res * nsub + (256 * B + 32 * wid + r32)] = (m + __log2f(l)) * LN2;
      const float rl = __builtin_amdgcn_rcpf(l);
#pragma unroll
      for (int d0 = 0; d0 < 2; ++d0) {
#pragma unroll
        for (int i = 0; i < 16; ++i) o[d0][i] *= rl;
        bf16x8 c0_, c1_; PK4(o[d0], 0, c0_); PK4(o[d0], 8, c1_);
        *(bf16x8*)(DPART + tokq * 768 + hd * 64 + d0 * 32 + 8 * hi) = c0_; *(bf16x8*)(DPART + tokq * 768 + hd * 64 + d0 * 32 + 16 + 8 * hi) = c1_; } }
    asm volatile("s_waitcnt lgkmcnt(0)\n\ts_barrier" ::: "memory");
  }
}
DEV void phase_dilcomb(const Args& a, int wv) {
  const int wid = __builtin_amdgcn_readfirstlane(otid(wv) >> 6), lane = otid(wv) & 63;
  const bf16_t* DPART = WSP(bf16_t, A_DPART); const float* DLSE = WSP(float, A_DLSE); bf16_t* YMIX = WSP(bf16_t, A_YMIX);
  const int nw = gridDim.x * 8;
  for (int t0 = blockIdx.x * 8 + wid; t0 < S_; t0 += 2 * nw) {
    const int ts[2] = {t0, t0 + nw < S_ ? t0 + nw : t0};
    float lv[2][6][3]; unsigned ov[2][6][3];
#pragma unroll
    for (int q = 0; q < 2; ++q) { const int t = ts[q];
#pragma unroll
      for (int i = 0; i < 6; ++i) { const int c = 2 * lane + 128 * i, hd = c >> 6;
        lv[q][i][0] = DLSE[(size_t)hd * S_ + t]; lv[q][i][1] = DLSE[(size_t)(12 + hd) * S_ + (size_t)(t & 3) * (S_ / 4) + (t >> 2)]; lv[q][i][2] = DLSE[(size_t)(24 + hd) * S_ + (size_t)(t & 15) * (S_ / 16) + (t >> 4)];
        ov[q][i][0] = *(const unsigned*)(DPART + (size_t)t * 768 + c); ov[q][i][1] = *(const unsigned*)(DPART + ((size_t)S_ + t) * 768 + c); ov[q][i][2] = *(const unsigned*)(DPART + ((size_t)2 * S_ + t) * 768 + c); } }
#pragma unroll
    for (int q = 0; q < 2; ++q) { const int t = ts[q];
#pragma unroll
      for (int i = 0; i < 6; ++i) { const int c = 2 * lane + 128 * i; const float l0 = lv[q][i][0], l1 = lv[q][i][1], l2 = lv[q][i][2];
        const float mx = fmaxf(l0, fmaxf(l1, l2)), e0 = __expf(l0 - mx), e1 = __expf(l1 - mx), e2 = __expf(l2 - mx), inv = __builtin_amdgcn_rcpf(e0 + e1 + e2);
        const unsigned u0 = ov[q][i][0], u1 = ov[q][i][1], u2 = ov[q][i][2];
        const float2 o0 = make_float2(__uint_as_float(u0 << 16), __uint_as_float(u0 & 0xffff0000u)), o1 = make_float2(__uint_as_float(u1 << 16), __uint_as_float(u1 & 0xffff0000u)), o2 = make_float2(__uint_as_float(u2 << 16), __uint_as_float(u2 & 0xffff0000u));
        st_bf2(YMIX + (size_t)t * DM + 512 + c, (e0 * o0.x + e1 * o1.x + e2 * o2.x) * inv, (e0 * o0.y + e1 * o1.y + e2 * o2.y) * inv); } }
  }
}

constexpr int ML_ROWB = 272;
DEV float ml_tables(const float* GLI, const float* GLF, int dir, int hd, int T0, int lane, LAS float* Bt, LAS float* Et, LAS float* gt) {
  const size_t base = (size_t)(dir * 4 + hd) * S_ + T0 + 2 * lane;
  const float lf0 = GLF[base], lf1 = GLF[base + 1], li0 = GLI[base], li1 = GLI[base + 1];
  const float ps = lf0 + lf1; float incl = ps;
#pragma unroll
  for (int o = 1; o < 64; o <<= 1) { const float y = __shfl_up(incl, o); if (lane >= o) incl += y; }
  const float excl = incl - ps, total = __shfl(incl, 63);
  float b0, b1;
  if (dir == 0) { b0 = excl + lf0; b1 = incl; }
  else { b0 = total - excl; b1 = total - (excl + lf0); }
  if (Bt) { Bt[2 * lane] = b0; Bt[2 * lane + 1] = b1; Et[2 * lane] = li0 - b0; Et[2 * lane + 1] = li1 - b1; }
  if (gt) { gt[2 * lane] = __expf(total - b0 + li0); gt[2 * lane + 1] = __expf(total - b1 + li1); }
  return total;
}
DEV void ml_stage_vt(const bf16_t* PROJ, int hd, int T0, LAS char* VT, int tid) {
#pragma unroll
  for (int i = 0; i < 6; ++i) { const int idx = tid + 512 * i, s = idx & 127, ch = idx >> 7;
    const bf16x8 v = *reinterpret_cast<const bf16x8*>(PROJ + (size_t)(T0 + s) * CINP + off_mv(hd) + ch * 8);
#pragma unroll
    for (int j = 0; j < 8; ++j) *(LAS short*)(VT + (ch * 8 + j) * ML_ROWB + s * 2) = v[j]; }
}
DEV void ml_m1_unit(const Args& a, int hd, int c, LAS char* lds, int wv) {
  const int tid = otid(wv), wid = tid >> 6, lane = tid & 63, r = lane & 31, h = lane >> 5, T0 = c * 128;
  const bf16_t* PROJ = WSP(bf16_t, A_PROJ); const bf16_t* MLQK = WSP(bf16_t, A_MLQK); const float* GLI = WSP(float, WS_GLI); const float* GLF = WSP(float, WS_GLF);
  bf16_t* DS = WSP(bf16_t, A_DS); float* DN = WSP(float, A_DN); float* CD = WSP(float, WS_CD);
  LAS char* VT = lds; LAS char* GKT = lds + 192 * ML_ROWB; LAS float* gt = (LAS float*)(lds + 2 * 192 * ML_ROWB);
  if (wid < 2) { const float total = ml_tables(GLI, GLF, wid, hd, T0, lane, nullptr, nullptr, gt + wid * 128); if (lane == 0) CD[((wid * 4 + hd) * 64 + c) * 32] = __expf(total); }
  ml_stage_vt(PROJ, hd, T0, VT, tid);
  __syncthreads();
  for (int dir = 0; dir < 2; ++dir) {
#pragma unroll
    for (int i = 0; i < 6; ++i) { const int idx = tid + 512 * i, s = idx & 127, ch = idx >> 7; const float g = gt[dir * 128 + s];
      const bf16x8 v = *reinterpret_cast<const bf16x8*>(MLQK + (size_t)(T0 + s) * 1536 + 768 + hd * 192 + ch * 8);
#pragma unroll
      for (int j = 0; j < 8; ++j) *(LAS bf16_t*)(GKT + (ch * 8 + j) * ML_ROWB + s * 2) = f2bf(bf2f((bf16_t)v[j]) * g); }
    __syncthreads();
    const size_t ub = (size_t)((dir * 4 + hd) * 64 + c);
    if (tid < 192) { float sum = 0.f; const LAS char* rowp = GKT + tid * ML_ROWB;
      for (int s = 0; s < 128; s += 2) { const unsigned u = *(const LAS unsigned*)(rowp + s * 2); sum += __uint_as_float(u << 16) + __uint_as_float(u & 0xffff0000u); }
      DN[ub * 192 + tid] = sum; }
    for (int tile = wid; tile < 36; tile += 8) { const int dvb = tile / 6, dkb = tile % 6; f32x16 acc = {};
#pragma unroll
      for (int ks = 0; ks < 8; ++ks) { const bf16x8 av = *(const LAS bf16x8*)(VT + (32 * dvb + r) * ML_ROWB + (16 * ks + 8 * h) * 2);
        const bf16x8 bk = *(const LAS bf16x8*)(GKT + (32 * dkb + r) * ML_ROWB + (16 * ks + 8 * h) * 2); acc = MFMA32(av, bk, acc); }
#pragma unroll
      for (int i = 0; i < 16; ++i) DS[(ub * 192 + 32 * dvb + crow(i, h)) * 192 + 32 * dkb + r] = f2bf(acc[i]); }
    __syncthreads();
  }
}
DEV void phase_ml_scan(const Args& a, int wv) {
  const bf16_t* DS = WSP(bf16_t, A_DS); const float* DN = WSP(float, A_DN); const float* CD = WSP(float, WS_CD); bf16_t* ST = WSP(bf16_t, A_ST); float* SN = WSP(float, A_SN);
  constexpr int NE4 = 8 * 36864 / 4, NN = 8 * 192;
  const int nb_ = (int)gridDim.x, per_ = (((NE4 + NN + nb_ - 1) / nb_) + 63) & ~63, e0_ = (int)blockIdx.x * per_;
  for (int e = e0_ + otid(wv); e < e0_ + per_ && e < NE4 + NN; e += 512) {
    if (e < NE4) { const int dh = e / 9216, idx = (e % 9216) * 4, dir = dh >> 2; const size_t base = (size_t)dh * 64 * 36864 + idx; float S0 = 0.f, S1 = 0.f, S2 = 0.f, S3 = 0.f;
#pragma unroll
      for (int hf = 0; hf < 2; ++hf) {
        u32x2 d[32]; float cd[32];
#pragma unroll
        for (int st = 0; st < 32; ++st) { const int s2 = hf * 32 + st, c = dir ? 63 - s2 : s2; d[st] = __builtin_nontemporal_load((const u32x2*)(DS + base + (size_t)c * 36864)); cd[st] = __uint_as_float(__builtin_amdgcn_readfirstlane(__float_as_uint(CD[(dh * 64 + c) * 32]))); }
#pragma unroll
        for (int st = 0; st < 32; ++st) { const int s2 = hf * 32 + st, c = dir ? 63 - s2 : s2;
          u32x2 w; w.x = cvtpk(S0, S1); w.y = cvtpk(S2, S3); *(u32x2*)(ST + base + (size_t)c * 36864) = w;
          S0 = cd[st] * S0 + __uint_as_float(d[st].x << 16); S1 = cd[st] * S1 + __uint_as_float(d[st].x & 0xffff0000u); S2 = cd[st] * S2 + __uint_as_float(d[st].y << 16); S3 = cd[st] * S3 + __uint_as_float(d[st].y & 0xffff0000u); } } }
    else { const int e2 = e - NE4, dh = e2 / 192, idx = e2 % 192, dir = dh >> 2; const size_t base = (size_t)dh * 64 * 192 + idx; float Sv = 0.f;
#pragma unroll 8
      for (int st = 0; st < 64; ++st) { const int c = dir ? 63 - st : st; SN[base + (size_t)c * 192] = Sv; Sv = CD[(dh * 64 + c) * 32] * Sv + DN[base + (size_t)c * 192]; } }
  }
}
DEV void ml_m3_unit(const Args& a, int l, int hd, int c, LAS char* lds, int wv) {
  const int tid = otid(wv), wid = tid >> 6, lane = tid & 63, r = lane & 31, h = lane >> 5, T0 = c * 128;
  const int dir = wid >> 2, rb = wid & 3;
  const bf16_t* PROJ = WSP(bf16_t, A_PROJ); const bf16_t* MLQK = WSP(bf16_t, A_MLQK); const float* GLI = WSP(float, WS_GLI); const float* GLF = WSP(float, WS_GLF);
  const bf16_t* ST = WSP(bf16_t, A_ST); const float* SN = WSP(float, A_SN); bf16_t* YMIX = WSP(bf16_t, A_YMIX);
  constexpr int KROWB = 400;
  LAS char* KL = lds; LAS char* VT = lds + 128 * KROWB; LAS float* tab = (LAS float*)(lds + 128 * KROWB + 192 * ML_ROWB);
  LAS float* Btab = tab; LAS float* Etab = tab + 256; LAS float* nv = tab + 512; LAS float* denx = tab + 512 + 384;
  LAS float* HB = (LAS float*)lds;
  if (wid < 2) (void)ml_tables(GLI, GLF, wid, hd, T0, lane, Btab + wid * 128, Etab + wid * 128, nullptr);
  else if (tid - 128 < 384) { const int i = tid - 128, d2 = i / 192, dk = i % 192; nv[i] = SN[(size_t)((d2 * 4 + hd) * 64 + c) * 192 + dk]; }
#pragma unroll
  for (int i = 0; i < 6; ++i) { const int idx = tid + 512 * i, s = idx / 24, ch = idx % 24;
    *(LAS bf16x8*)(KL + s * KROWB + ch * 16) = *reinterpret_cast<const bf16x8*>(MLQK + (size_t)(T0 + s) * 1536 + 768 + hd * 192 + ch * 8); }
  ml_stage_vt(PROJ, hd, T0, VT, tid);
  bf16x8 qf[12];
#pragma unroll
  for (int k = 0; k < 12; ++k) qf[k] = *reinterpret_cast<const bf16x8*>(MLQK + (size_t)(T0 + 32 * rb + r) * 1536 + hd * 192 + 16 * k + 8 * h);
  __syncthreads();
  const float Bt = Btab[dir * 128 + 32 * rb + r];
  f32x16 o[6] = {}; float den = 0.f;
  constexpr int SLROW = 208;
  LAS char* SL = lds;
  u32x4 stg[9];
#define ST_LOAD(H0) do { _Pragma("unroll") for (int m = 0; m < 9; ++m) { const int idx = tid + 512 * m, d_ = idx / 2304, rem = idx % 2304, dv_ = rem / 12, ch = rem % 12; \
      stg[m] = *reinterpret_cast<const u32x4*>(ST + (size_t)((d_ * 4 + hd) * 64 + c) * 36864 + dv_ * 192 + 96 * (H0) + ch * 8); } } while (0)
#define ST_WRITE() do { int tw_ = tid; asm volatile("" : "+v"(tw_));        \
    _Pragma("unroll") for (int m = 0; m < 9; ++m) { const int idx = tw_ + 512 * m, d_ = idx / 2304, rem = idx % 2304, dv_ = rem / 12, ch = rem % 12; \
      *(LAS u32x4*)(SL + (d_ * 192 + dv_) * SLROW + ch * 16) = stg[m]; } } while (0)
  ST_LOAD(0);
  const int sb_lo = dir ? rb : 0, sb_hi = dir ? 3 : rb;
  for (int sb = sb_lo; sb <= sb_hi; ++sb) {
    f32x16 p = {};
#pragma unroll
    for (int k = 0; k < 12; ++k) { const bf16x8 kf = *(const LAS bf16x8*)(KL + (32 * sb + r) * KROWB + (16 * k + 8 * h) * 2); p = MFMA32(kf, qf[k], p); }
#pragma unroll
    for (int i = 0; i < 16; ++i) { const int sl = crow(i, h); const float w = __builtin_amdgcn_exp2f((Bt + Etab[dir * 128 + 32 * sb + sl]) * LOG2E);
      const bool keep = (sb != rb) || (dir ? (sl >= r) : (sl <= r));
      p[i] = keep ? p[i] * w : 0.f; den += p[i]; }
    bf16x8 pa0, pa1; PK4(p, 0, pa0); PK4(p, 8, pa1);
#pragma unroll
    for (int dvb = 0; dvb < 6; ++dvb) { const LAS char* vrow = VT + (32 * dvb + r) * ML_ROWB + (32 * sb + 8 * h) * 2;
      const bf16x8 b0 = *(const LAS bf16x8*)(vrow), b1 = *(const LAS bf16x8*)(vrow + 32);
      o[dvb] = MFMA32(pa0, b0, o[dvb]); o[dvb] = MFMA32(pa1, b1, o[dvb]); }
  }
  {
    const float ef = __builtin_amdgcn_exp2f(Bt * LOG2E); float deni = 0.f;
    __syncthreads();
    ST_WRITE(); ST_LOAD(1);
    __syncthreads();
#pragma unroll
    for (int half = 0; half < 2; ++half) {
      if (half == 1) { __syncthreads(); ST_WRITE(); __syncthreads(); }
#pragma unroll
      for (int kk = 0; kk < 6; ++kk) { const int k = half * 6 + kk; u32x4 w4 = __builtin_bit_cast(u32x4, qf[k]); float f[8];
#pragma unroll
        for (int j = 0; j < 4; ++j) { f[2 * j] = __uint_as_float(w4[j] << 16) * ef; f[2 * j + 1] = __uint_as_float(w4[j] & 0xffff0000u) * ef; }
#pragma unroll
        for (int j = 0; j < 8; ++j) deni += f[j] * nv[dir * 192 + 16 * k + 8 * h + j];
        u32x4 q4; q4.x = cvtpk(f[0], f[1]); q4.y = cvtpk(f[2], f[3]); q4.z = cvtpk(f[4], f[5]); q4.w = cvtpk(f[6], f[7]);
        const bf16x8 qs = __builtin_bit_cast(bf16x8, q4);
#pragma unroll
        for (int dvb = 0; dvb < 6; ++dvb) { const bf16x8 sf = *(const LAS bf16x8*)(SL + (dir * 192 + 32 * dvb + r) * SLROW + (16 * kk + 8 * h) * 2); o[dvb] = MFMA32(qs, sf, o[dvb]); } } }
    den += deni;
  }
#undef ST_LOAD
#undef ST_WRITE
  den += __shfl_xor(den, 32);
  if (h == 0) denx[wid * 32 + r] = den;
  asm volatile("s_waitcnt lgkmcnt(0)" ::: "memory");
  float rden[16];
#pragma unroll
  for (int i = 0; i < 16; ++i) rden[i] = __builtin_amdgcn_rcpf(fmaxf(fabsf(denx[wid * 32 + crow(i, h)]), 1.f));
  __syncthreads();
  if (dir == 1) {
#pragma unroll
    for (int dvb = 0; dvb < 6; ++dvb)
#pragma unroll
      for (int i = 0; i < 16; ++i) HB[(32 * rb + crow(i, h)) * 193 + 32 * dvb + r] = o[dvb][i] * rden[i];
  }
  __syncthreads();
  if (dir == 0) {
#pragma unroll
    for (int dvb = 0; dvb < 6; ++dvb)
#pragma unroll
      for (int i = 0; i < 16; ++i) { LAS float* hp = HB + (32 * rb + crow(i, h)) * 193 + 32 * dvb + r; *hp = o[dvb][i] * rden[i] + *hp; }
  }
  __syncthreads();
  {
    const float* gout = a.g_out + (size_t)l * 768 + hd * 192; const float g0 = gout[lane], g1 = gout[lane + 64], g2 = gout[lane + 128];
    bf16_t opv[16][3];
#pragma unroll
    for (int rr = 0; rr < 16; ++rr) { const size_t t = (size_t)T0 + 16 * wid + rr;
#pragma unroll
      for (int cc = 0; cc < 3; ++cc) opv[rr][cc] = PROJ[t * CINP + OFF_MO + hd * 192 + lane + 64 * cc]; }
#pragma unroll
    for (int rr = 0; rr < 16; ++rr) { const int row = 16 * wid + rr; const size_t t = (size_t)T0 + row;
      const float v0 = HB[row * 193 + lane], v1 = HB[row * 193 + lane + 64], v2 = HB[row * 193 + lane + 128];
      const float rs = rsqrtf(wave_sum(v0 * v0 + v1 * v1 + v2 * v2) * (1.f / 192.f) + EPS);
      bf16_t* yo = YMIX + t * DM + 1280 + hd * 192 + lane;
      yo[0] = f2bf(v0 * rs * g0 * __builtin_amdgcn_rcpf(1.f + __expf(-bf2f(opv[rr][0])))); yo[64] = f2bf(v1 * rs * g1 * __builtin_amdgcn_rcpf(1.f + __expf(-bf2f(opv[rr][1])))); yo[128] = f2bf(v2 * rs * g2 * __builtin_amdgcn_rcpf(1.f + __expf(-bf2f(opv[rr][2])))); }
  }
  __syncthreads();
}

constexpr int NPH_L = 13, NPH = NL * NPH_L + 1;
__global__ void __launch_bounds__(512, 2) fwd_kernel(Args a) {
    extern __shared__ __attribute__((aligned(16))) unsigned char lds_raw[];
    LAS unsigned char* lds = (LAS unsigned char*)lds_raw; LAS char* ldsg = (LAS char*)lds_raw;
    const int wv = 0; const int tid = threadIdx.x;
#define G obid_((int)gridDim.x)
#define bid obid_((int)blockIdx.x)
    const bool use_bar = (a.ph_hi - a.ph_lo) > 1;
    XcdBarrier bar; bar.bar = WSP(unsigned, WS_CTL); bar.x = 0; bar.st = (volatile LAS unsigned*)(lds + LDS_BARW); bar.wv = wv;
    if (use_bar) {
        if (tid == 0) { *(LAS u32x4*)(lds + LDS_BARW) = (u32x4){0u, 0u, 0u, 0u}; }
        __syncthreads();
        bar = xcd_barrier_post(WSP(unsigned, WS_CTL), (volatile LAS unsigned*)(lds + LDS_BARW), wv);
    }
#ifndef ONLY_K
#define ONLY_K -1
#endif
#define IN(k) ((ONLY_K < 0 || ((k) % NPH_L) == ONLY_K) && a.ph_lo <= (k) && (k) < a.ph_hi)
#define SEAM(k) do { if (IN(k) && IN((k) + 1)) xcd_barrier(bar); } while (0)
#define SEAM_ARRIVE(k) do { if (IN(k) && IN((k) + 1)) xcd_barrier_arrive(bar); } while (0)
#define SEAM_WAIT(k, m) do { if (IN(k) && IN((k) + 1)) xcd_barrier_wait(bar, (m)); } while (0)
#define REPS(k) ((DUP_K == (k)) ? 2 : 1)
#define SUBREP(id) for (int sr_ = 0; sr_ < ((DUP_K == (id)) ? 2 : 1); ++sr_)
#define DUPLOOP(k) for (int rep_ = 0; rep_ < REPS(k); ++rep_, (rep_ < REPS(k) ? xcd_barrier(bar) : (void)0))
    for (int l = 0; l < NL; ++l) {
        const int pb = l * NPH_L;
        if (IN(pb + 0)) DUPLOOP(0) { SUBREP(27) { phase_cvt_a(a, l, lds, wv); phase_cvt_router(a, l, wv); } SUBREP(28) phase_norm1(a, l, l == 0 ? 0 : 1, wv); if (l == 0) phase_rope(a, wv); }
        SEAM(pb + 0);
        if (IN(pb + 1)) DUPLOOP(1) { pg8::Gemm g{WSP(bf16_t, WS_XN), WSP(bf16_t, A_WIN), DM, DM, DM, 1, 0}; pg8::StaticOrder S; S.init(S_, N_EARLY, G, bid);
            pg8::EpiBf16 E{WSP(bf16_t, A_PROJ), CINP, 0x7fffffff}; pg8::gemm_phase<false>(lds, g, S, E, wv); }
        SEAM(pb + 1);
        if (IN(pb + 2)) DUPLOOP(2) phase_p3a(a, l, wv);
        SEAM_ARRIVE(pb + 2);
        if (!IN(pb + 3)) SEAM_WAIT(pb + 2, 0u);
        if (IN(pb + 3)) DUPLOOP(3) {
            const int g_ = G, b_ = bid; const bool bal = (g_ == 256);
            { pg8::Gemm g{WSP(bf16_t, WS_XN), WSP(bf16_t, A_WIN) + (size_t)N_EARLY * DM, DM, DM, DM, 1, 0}; pg8::StaticOrder S; S.init(S_, N_LATE, bal ? 160 : g_, bal ? (b_ < 160 ? b_ : -1) : b_);
              pg8::EpiBf16 E{WSP(bf16_t, A_PROJ) + N_EARLY, CINP, 0x7fffffff}; pg8::gemm_phase<false>(lds, g, S, E, wv); }
            if (rep_ == 0) SEAM_WAIT(pb + 2, (unsigned)G - 1u);
            { pg8::Gemm g{WSP(bf16_t, A_CQKV), WSP(bf16_t, A_BD1), 512, 512, 512, 1, 0}; pg8::StaticOrder S;
              if (!bal) S.init(S_, 1792, g_, b_); else if (b_ >= 160) S.init(S_, 1792, 96, b_ - 160, 0, 2); else S.init(S_, 1792, 256, b_ < 32 ? b_ : -1, 192, 1);
              pg8::EpiBf16 E{WSP(bf16_t, A_RAW), 1792, 0x7fffffff}; pg8::gemm_phase<false>(lds, g, S, E, wv); }
            { pg8::Gemm g{WSP(bf16_t, A_UC), WSP(bf16_t, A_BD2), 768, 768, 384, 3, 192};   pg8::StaticOrder S;
              if (!bal) S.init(S_, 1536, g_, g_ - 1 - b_); else S.init(S_, 1536, 96, b_ >= 160 ? b_ - 160 : -1, 0, 2);
              pg8::EpiBf16 E{WSP(bf16_t, A_MLQK), 1536, 0x7fffffff}; pg8::gemm_phase<false>(lds, g, S, E, wv); }
        }
        SEAM(pb + 3);
        if (IN(pb + 4)) DUPLOOP(4) { phase_p3c(a, l, rep_ == 0, wv); SUBREP(25) for (int u = bid; u < 256; u += G) ml_m1_unit(a, u >> 6, u & 63, ldsg, wv); }
        SEAM(pb + 4);
        if (IN(pb + 5)) DUPLOOP(5) {
            SUBREP(22) phase_ml_scan(a, wv);
            const bool nomax = mla::bound_ok(a.g_q + l * 96, a.g_k + l * 96, lane_id());
            SUBREP(20) for (int u = bid; u < 256; u += G) { const int hq = u & 7, qb = u >> 3;
                const bf16_t* Qp = WSP(bf16_t, A_QM) + (size_t)qb * 256 * 768 + hq * 96; const bf16_t* Kp = WSP(bf16_t, A_KM) + hq * 96; const bf16_t* Vp = WSP(bf16_t, A_RAW) + 768 + hq * 128 + 64;
                bf16_t* Op = WSP(bf16_t, A_YMIX) + (size_t)qb * 256 * DM + hq * 64;
                if (nomax) mla::attn_unit<true>(Qp, Kp, Vp, Op, S_, ldsg, wv); else mla::attn_unit<false>(Qp, Kp, Vp, Op, S_, ldsg, wv); }
            if constexpr (DUP_K >= 41 && DUP_K <= 49) for (int u = bid; u < 256; u += G) { const int hq = u & 7, qb = u >> 3;
                mla::attn_unit<true, (DUP_K >= 41 && DUP_K <= 49) ? DUP_K - 40 : 0>(WSP(bf16_t, A_QM) + (size_t)qb * 256 * 768 + hq * 96, WSP(bf16_t, A_KM) + hq * 96, WSP(bf16_t, A_RAW) + 768 + hq * 128 + 64, nullptr, S_, ldsg, wv); }
            SUBREP(21) phase_dilated(a, ldsg, wv);
        }
        SEAM(pb + 5);
        if (IN(pb + 6)) DUPLOOP(6) { SUBREP(26) for (int u = bid; u < 256; u += G) ml_m3_unit(a, l, u >> 6, u & 63, ldsg, wv); SUBREP(29) phase_dilcomb(a, wv); }
        SEAM(pb + 6);
        if (IN(pb + 7)) DUPLOOP(7) { pg8::Gemm g{WSP(bf16_t, A_YMIX), WSP(bf16_t, A_WOUT), DM, DM, DM, 1, 0}; pg8::StaticOrder S; S.init(S_, DM, G, bid);
            pg8::EpiBf16 E{WSP(bf16_t, WS_XB), DM, 0x7fffffff}; pg8::gemm_phase<false>(lds, g, S, E, wv); }
        SEAM_ARRIVE(pb + 7);
        if (!IN(pb + 8)) SEAM_WAIT(pb + 7, 0u);
        if (IN(pb + 8)) DUPLOOP(8) { SUBREP(23) phase_router(a, l, ldsg, wv, bar, rep_ == 0 && sr_ == 0 && IN(pb + 7)); }
        SEAM_ARRIVE(pb + 8);
        if (!IN(pb + 9)) SEAM_WAIT(pb + 8, 0u);
        if (IN(pb + 9)) DUPLOOP(9) { const int b0_ = (int)gridDim.x > 32 ? 16 : 0;
            const bool lister = bid < 16;
            if (rep_ == 0 && lister) SEAM_WAIT(pb + 8, 0u);
            phase_lists(a, ldsg, wv); SUBREP(24) phase_cvt_b(a, l, lds, b0_, wv);
            if (rep_ == 0 && !lister) SEAM_WAIT(pb + 8, 0u); }
        SEAM(pb + 9);
        if (IN(pb + 11)) DUPLOOP(11) {
            unsigned* pcnt = WSP(unsigned, WS_CTL) + 4096 + l * (80 * 64);
            const int bidx = (G % 8 == 0) ? (bid % 8) * (G / 8) + bid / 8 : bid;
            const int ntile_ = ld_agent_i(WSP(int, WS_TSTART) + 16);
            { pg8::Gemm g{WSP(bf16_t, WS_XN), WSP(bf16_t, B_W1), DM, DM, DM, 1, 0}; pg8::MoeOrder S{WSP(int, WS_TSTART), WSP(int, WS_TILES), 4, G, bidx, ntile_};
              pg8::EpiMoe1 E{WSP(bf16_t, B_H), WSP(float, WS_SLOTW), WSP(float, WS_SLOTR), pcnt}; pg8::gemm_phase<true, true>(lds, g, S, E, wv, WSP(int, WS_PERM)); }
            { pg8::Gemm g{WSP(bf16_t, B_H), WSP(bf16_t, B_W2), 512, 512, 512, 1, 0}; pg8::MoeOrder2 S{WSP(int, WS_TSTART), WSP(int, WS_TILES), pcnt, WSP(unsigned, WS_CTL) + XB_TMO, G, bidx, ntile_};
              pg8::EpiBf16 E{WSP(bf16_t, B_YS), DM, 7}; pg8::gemm_phase<false, true>(lds, g, S, E, wv); }
        }
        SEAM(pb + 12);
    }
    if (IN(NPH - 1)) phase_norm1(a, 0, 2, wv);
#undef IN
#undef SEAM
#undef G
#undef bid
}

extern "C" void kernel_launch(void* const* d_in, const int* in_sizes, int n_in, void* d_out, int out_size, void* d_ws, size_t ws_size, hipStream_t stream) {
    static int grid = 0;
    if (grid == 0) {
        if (n_in != 28 || out_size != S_ * DM || ws_size < WS_END) { fprintf(stderr, "kernel_launch: shape/workspace mismatch: n_in %d out %d ws %zu (need %zu)\n", n_in, out_size, ws_size, (size_t)WS_END); grid = -1; return; }
        int dev = 0, cus = 0;
        if (hipGetDevice(&dev) != hipSuccess || hipDeviceGetAttribute(&cus, hipDeviceAttributeMultiprocessorCount, dev) != hipSuccess) { grid = -1; return; }
        if (hipFuncSetAttribute((const void*)fwd_kernel, hipFuncAttributeMaxDynamicSharedMemorySize, LDS_BYTES) != hipSuccess) { fprintf(stderr, "kernel_launch: hipFuncSetAttribute failed\n"); grid = -1; return; }
        int per_cu = 0;
        if (hipOccupancyMaxActiveBlocksPerMultiprocessor(&per_cu, (const void*)fwd_kernel, 512, LDS_BYTES) != hipSuccess || per_cu < 1) fprintf(stderr, "kernel_launch: occupancy query reports %d\n", per_cu);
        (void)hipGetLastError();
        grid = cus;
    }
    if (grid < 0) return;
    (void)hipMemsetAsync((char*)d_ws + WS_CTL, 0, CTL_BYTES, stream);
    Args a{};
    a.x = (const float*)d_in[0]; a.pos = (const int*)d_in[1]; a.rel_bias = (const float*)d_in[2]; a.norm_mix = (const float*)d_in[3]; a.w_in = (const float*)d_in[4];
    a.g_cq = (const float*)d_in[5]; a.w_uq = (const float*)d_in[6]; a.g_ckv = (const float*)d_in[7]; a.w_ukv = (const float*)d_in[8]; a.g_q = (const float*)d_in[9]; a.g_k = (const float*)d_in[10];
    a.dg_q = (const float*)d_in[11]; a.dg_k = (const float*)d_in[12]; a.conv_w = (const float*)d_in[13]; a.conv_b = (const float*)d_in[14]; a.ml_wq = (const float*)d_in[15]; a.ml_wk = (const float*)d_in[16];
    a.gate_bias = (const float*)d_in[17]; a.g_out = (const float*)d_in[18]; a.w_out = (const float*)d_in[19]; a.norm_ffn = (const float*)d_in[20]; a.wg = (const float*)d_in[21]; a.bg = (const float*)d_in[22];
    a.we = (const float*)d_in[23]; a.be = (const float*)d_in[24]; a.w_gate = (const float*)d_in[25]; a.w_up = (const float*)d_in[26]; a.w_down = (const float*)d_in[27];
    a.out = (float*)d_out; a.ws = (unsigned char*)d_ws;
#if MK_MULTI
    for (int ph = 0; ph < NPH; ++ph) { a.ph_lo = ph; a.ph_hi = ph + 1; hipLaunchKernelGGL(fwd_kernel, dim3(grid), dim3(512), LDS_BYTES, stream, a); }
#else
    a.ph_lo = 0; a.ph_hi = NPH; hipLaunchKernelGGL(fwd_kernel, dim3(grid), dim3(512), LDS_BYTES, stream, a);
#endif
    const hipError_t le = hipPeekAtLastError();
    if (le != hipSuccess) fprintf(stderr, "kernel_launch: launch failed: %s\n", hipGetErrorName(le));
}
```
